# Optimizing an MI355X kernel written in HIP

```python
import jax, jax.numpy as jnp
from jax import lax
import numpy as np

D_MODEL = 1024
BATCH = 4
SEQ = 4096
DEPTH = 4
DEC_BATCH = 16
DEC_SEQ = 2048
PAST_LEN = 128

ATT_HEADS = 16
ATT_KV_HEADS = 4
ATT_GROUP = ATT_HEADS // ATT_KV_HEADS
ATT_HEAD_DIM = 64
ATT_WIDTH = ATT_HEADS * ATT_HEAD_DIM
ATT_KV_WIDTH = ATT_KV_HEADS * ATT_HEAD_DIM
WINDOW = 128
ATT_BLOCK = 128
ROPE_THETA = 500000.0
ROPE_DIM = ATT_HEAD_DIM // 4
M_HEADS = 8
M_HEAD_DIM = 128
M_WIDTH = M_HEADS * M_HEAD_DIM
M_CHUNK = 128
CONV_K = 3
N_BRANCH = 2
NORM_EPS = 1e-6
NEG = -1e30

SPLITS = (ATT_WIDTH, ATT_KV_WIDTH, ATT_KV_WIDTH, ATT_WIDTH,
          M_WIDTH, M_WIDTH, M_WIDTH, M_WIDTH, M_WIDTH,
          M_HEADS, M_HEADS, M_HEADS, M_HEADS,
          N_BRANCH * D_MODEL)
IN_DIM = sum(SPLITS)

kernel_name = "hybrid_swa_mlstm_bidir_encoder"


def rmsnorm(x, g):
    xf = x.astype(jnp.float32)
    y = xf * lax.rsqrt(jnp.mean(xf * xf, axis=-1, keepdims=True) + NORM_EPS) * g.astype(jnp.float32)
    return y.astype(x.dtype)


def partial_rope(x):
    S = x.shape[1]
    half = ROPE_DIM // 2
    inv = jnp.power(jnp.float32(ROPE_THETA), -jnp.arange(half, dtype=jnp.float32) * 2.0 / ROPE_DIM)
    ang = jnp.arange(S, dtype=jnp.float32)[:, None] * inv[None, :]
    cos = jnp.cos(ang)[None, :, None, :]
    sin = jnp.sin(ang)[None, :, None, :]
    xf = x.astype(jnp.float32)
    x1 = xf[..., :half]
    x2 = xf[..., half:ROPE_DIM]
    out = jnp.concatenate([x1 * cos - x2 * sin, x2 * cos + x1 * sin, xf[..., ROPE_DIM:]], axis=-1)
    return out.astype(x.dtype)


def windowed_gqa_sink(q, k, v, sink):
    B, S = q.shape[0], q.shape[1]
    nb = S // ATT_BLOCK
    qb = q.reshape(B, nb, ATT_BLOCK, ATT_KV_HEADS, ATT_GROUP, ATT_HEAD_DIM)

    def band(t):
        tp = jnp.pad(t, ((0, 0), (ATT_BLOCK, ATT_BLOCK), (0, 0), (0, 0)))
        tp = tp.reshape(B, nb + 2, ATT_BLOCK, ATT_KV_HEADS, ATT_HEAD_DIM)
        return jnp.concatenate([tp[:, :-2], tp[:, 1:-1], tp[:, 2:]], axis=2)

    kb, vb = band(k), band(v)
    s = jnp.einsum("bnqhgd,bnkhd->bnhgqk", qb, kb).astype(jnp.float32) * (ATT_HEAD_DIM ** -0.5)
    blk = jnp.arange(nb)[:, None, None]
    qpos = blk * ATT_BLOCK + jnp.arange(ATT_BLOCK)[None, :, None]
    kpos = (blk - 1) * ATT_BLOCK + jnp.arange(3 * ATT_BLOCK)[None, None, :]
    valid = (jnp.abs(kpos - qpos) <= WINDOW) & (kpos >= 0) & (kpos < S)
    s = jnp.where(valid[None, :, None, None], s, NEG)
    sink_l = jnp.broadcast_to(sink.astype(jnp.float32).reshape(1, 1, ATT_KV_HEADS, ATT_GROUP, 1, 1), s.shape[:-1] + (1,))
    p = jax.nn.softmax(jnp.concatenate([s, sink_l], axis=-1), axis=-1)[..., :-1]
    o = jnp.einsum("bnhgqk,bnkhd->bnqhgd", p.astype(v.dtype), vb)
    return o.reshape(B, S, ATT_WIDTH)


def centred_conv(x, w):
    S = x.shape[1]
    pad = CONV_K // 2
    xp = jnp.pad(x, ((0, 0), (pad, pad), (0, 0)))
    out = xp[:, 0:S] * w[0]
    for j in range(1, CONV_K):
        out = out + xp[:, j:j + S] * w[j]
    return out


def mlstm_chunkwise(q, k, v, log_i, log_f):
    B, H, S, dk = q.shape
    dv = v.shape[-1]
    L = M_CHUNK
    nc = S // L

    def chunks(t):
        return jnp.moveaxis(t.reshape((B, H, nc, L) + t.shape[3:]), 2, 0)

    qc, kc, vc, lic, lfc = chunks(q), chunks(k), chunks(v), chunks(log_i), chunks(log_f)
    b = jnp.cumsum(lfc, axis=-1)
    lower = jnp.tril(jnp.ones((L, L), dtype=bool))
    log_d = jnp.where(lower, b[..., :, None] - b[..., None, :] + lic[..., None, :], NEG)
    g = b[..., -1:] - b + lic
    qk = jnp.einsum("nbhld,nbhsd->nbhls", qc, kc)

    def step(carry, inp):
        C, n, m = carry
        q_, k_, v_, ld, qk_, b_, g_ = inp
        m_inter = b_ + m[..., None]
        m_t = jnp.maximum(m_inter, ld.max(axis=-1))
        w_inter = jnp.exp(m_inter - m_t)
        p = jnp.exp(ld - m_t[..., None]) * qk_
        num = w_inter[..., None] * jnp.einsum("bhld,bhde->bhle", q_, C) + jnp.einsum("bhls,bhse->bhle", p, v_)
        den = w_inter * jnp.einsum("bhld,bhd->bhl", q_, n) + p.sum(axis=-1)
        h = num / jnp.maximum(jnp.abs(den), jnp.exp(-m_t))[..., None]
        b_last = b_[..., -1]
        m_new = jnp.maximum(b_last + m, g_.max(axis=-1))
        w_c = jnp.exp(b_last + m - m_new)
        w_k = jnp.exp(g_ - m_new[..., None])
        C = w_c[..., None, None] * C + jnp.einsum("bhl,bhld,bhle->bhde", w_k, k_, v_)
        n = w_c[..., None] * n + jnp.einsum("bhl,bhld->bhd", w_k, k_)
        return (C, n, m_new), h

    init = (jnp.zeros((B, H, dk, dv), jnp.float32), jnp.zeros((B, H, dk), jnp.float32),
            jnp.full((B, H), NEG, jnp.float32))
    _, h = lax.scan(step, init, (qc, kc, vc, log_d, qk, b, g))
    return jnp.moveaxis(h, 0, 2).reshape(B, H, S, dv)


def mlstm_bidir(q, k, v, i_f, f_f, i_b, f_b):
    def to_bhs(t):
        return jnp.moveaxis(t.astype(jnp.float32), 1, 2)

    def flip(t):
        return jnp.flip(t, axis=2)

    q, k, v = to_bhs(q), to_bhs(k) * (M_HEAD_DIM ** -0.5), to_bhs(v)
    h_fwd = mlstm_chunkwise(q, k, v, to_bhs(i_f), jax.nn.log_sigmoid(to_bhs(f_f)))
    h_bwd = flip(mlstm_chunkwise(flip(q), flip(k), flip(v), flip(to_bhs(i_b)),
                                 flip(jax.nn.log_sigmoid(to_bhs(f_b)))))
    return jnp.moveaxis(h_fwd + h_bwd, 2, 1)


def encoder_layer(x, norm_g, w_in, b_in, q_norm_g, k_norm_g, sink, conv_w, m_norm_g, w_att_out, w_m_out, w_out):
    dt = x.dtype
    B, S, _ = x.shape
    xn = rmsnorm(x, norm_g)
    proj = xn @ w_in + b_in
    idx = [int(i) for i in np.cumsum(SPLITS)[:-1]]
    (aq, ak, av, az, mq, mk, mv, mo, mz, i_f, f_f, i_b, f_b, gates) = jnp.split(proj, idx, axis=-1)

    aq = partial_rope(rmsnorm(aq.reshape(B, S, ATT_HEADS, ATT_HEAD_DIM), q_norm_g))
    ak = partial_rope(rmsnorm(ak.reshape(B, S, ATT_KV_HEADS, ATT_HEAD_DIM), k_norm_g))
    av = av.reshape(B, S, ATT_KV_HEADS, ATT_HEAD_DIM)
    att = windowed_gqa_sink(aq, ak, av, sink)
    branch_a = (att * jax.nn.silu(az)) @ w_att_out

    qk_m = jax.nn.silu(centred_conv(jnp.concatenate([mq, mk], axis=-1), conv_w))
    mq, mk = qk_m[..., :M_WIDTH], qk_m[..., M_WIDTH:]
    hs = (M_HEADS, M_HEAD_DIM)
    h = mlstm_bidir(mq.reshape(B, S, *hs), mk.reshape(B, S, *hs), mv.reshape(B, S, *hs), i_f, f_f, i_b, f_b)
    h = jax.nn.sigmoid(mo.astype(jnp.float32)).reshape(B, S, *hs) * h
    h = h * lax.rsqrt(jnp.mean(h * h, axis=-1, keepdims=True) + NORM_EPS) * m_norm_g.astype(jnp.float32).reshape(hs)
    h = h.reshape(B, S, M_WIDTH).astype(dt)
    branch_m = (h * jax.nn.silu(mz)) @ w_m_out

    gates = jax.nn.sigmoid(gates)
    merged = gates[..., :D_MODEL] * branch_a + gates[..., D_MODEL:] * branch_m
    return (x + merged @ w_out).astype(dt)


def trunk(x, norm_g, w_in, b_in, q_norm_g, k_norm_g, sink, conv_w, m_norm_g, w_att_out, w_m_out, w_out):
    for l in range(DEPTH):
        x = encoder_layer(x, norm_g[l], w_in[l], b_in[l], q_norm_g[l], k_norm_g[l], sink[l], conv_w[l],
                          m_norm_g[l], w_att_out[l], w_m_out[l], w_out[l])
    return x


def setup_inputs(seed: int = 0) -> dict:
    key = jax.random.key(seed)
    ks = jax.random.split(key, 16)
    f32 = jnp.float32
    nrm = jax.random.normal
    x_prompt = nrm(ks[0], (BATCH, SEQ, D_MODEL), f32)
    x_sample = nrm(ks[1], (DEC_BATCH, DEC_SEQ, D_MODEL), f32)
    norm_g = 1.0 + 0.02 * nrm(ks[2], (DEPTH, D_MODEL), f32)
    w_in = nrm(ks[3], (DEPTH, D_MODEL, IN_DIM), f32) * (D_MODEL ** -0.5)
    b_in = 0.01 * nrm(ks[4], (DEPTH, IN_DIM), f32)
    f_bias = jnp.linspace(3.0, 6.0, M_HEADS, dtype=f32) + 0.1 * nrm(ks[5], (DEPTH, 2, M_HEADS), f32)
    off_ff = sum(SPLITS[:10])
    off_fb = sum(SPLITS[:12])
    b_in = b_in.at[:, off_ff:off_ff + M_HEADS].set(f_bias[:, 0]).at[:, off_fb:off_fb + M_HEADS].set(f_bias[:, 1])
    q_norm_g = 1.0 + 0.02 * nrm(ks[6], (DEPTH, ATT_HEAD_DIM), f32)
    k_norm_g = 1.0 + 0.02 * nrm(ks[7], (DEPTH, ATT_HEAD_DIM), f32)
    sink = 0.5 * nrm(ks[8], (DEPTH, ATT_HEADS), f32)
    conv_w = nrm(ks[9], (DEPTH, CONV_K, 2 * M_WIDTH), f32) * (CONV_K ** -0.5)
    m_norm_g = 1.0 + 0.02 * nrm(ks[10], (DEPTH, M_WIDTH), f32)
    w_att_out = nrm(ks[11], (DEPTH, ATT_WIDTH, D_MODEL), f32) * (ATT_WIDTH ** -0.5)
    w_m_out = nrm(ks[12], (DEPTH, M_WIDTH, D_MODEL), f32) * (M_WIDTH ** -0.5)
    w_out = nrm(ks[13], (DEPTH, D_MODEL, D_MODEL), f32) * (D_MODEL ** -0.5)
    return {"x_prompt": x_prompt, "x_sample": x_sample, "norm_g": norm_g, "w_in": w_in, "b_in": b_in,
            "q_norm_g": q_norm_g, "k_norm_g": k_norm_g, "sink": sink, "conv_w": conv_w,
            "m_norm_g": m_norm_g, "w_att_out": w_att_out, "w_m_out": w_m_out, "w_out": w_out}


def reference(x_prompt, x_sample, norm_g, w_in, b_in, q_norm_g, k_norm_g, sink, conv_w, m_norm_g, w_att_out, w_m_out, w_out):
    y_prompt = trunk(x_prompt, norm_g, w_in, b_in, q_norm_g, k_norm_g, sink, conv_w, m_norm_g, w_att_out, w_m_out, w_out)
    y_sample = trunk(x_sample, norm_g, w_in, b_in, q_norm_g, k_norm_g, sink, conv_w, m_norm_g, w_att_out, w_m_out, w_out)
    return (y_prompt, y_sample)
```

```cpp
#include <hip/hip_runtime.h>
#include <hip/hip_cooperative_groups.h>
#include <cstdio>
#include <cstdint>
namespace cg = cooperative_groups;

#define LAS __attribute__((address_space(3)))
typedef unsigned short bf16_t;
typedef short bf16x8 __attribute__((ext_vector_type(8)));
typedef float f32x4 __attribute__((ext_vector_type(4)));
typedef float f32x16 __attribute__((ext_vector_type(16)));
typedef unsigned u32x4 __attribute__((ext_vector_type(4)));
typedef unsigned u32x2 __attribute__((ext_vector_type(2)));

constexpr int DM = 1024, DEPTH = 4, IN_DIM = 9760, NPHYS = 9984, NTILE_IN = 39;
constexpr int GM = 16384;
constexpr float NORM_EPS = 1e-6f;
constexpr float KSCALE = 0.08838834764831845f;

constexpr size_t MiB = 1u << 20;
constexpr size_t WS_MB = 0, WS_BAR = 512 * 1024;
constexpr size_t WS_ROPE = 1 * MiB;
constexpr size_t WS_BIAS = 2 * MiB;
constexpr size_t WS_WIN = 3 * MiB;
constexpr size_t WIN_BYTES = (size_t)NPHYS * DM * 2;
constexpr size_t WS_WA = 81 * MiB, WS_WM = 89 * MiB, WS_WO = 97 * MiB;
constexpr size_t WS_AZ = 105 * MiB;
constexpr size_t WS_Q = 137 * MiB, WS_K = 169 * MiB, WS_V = 177 * MiB;
constexpr size_t WS_MQ = 185 * MiB, WS_MK = 217 * MiB, WS_MV = 249 * MiB, WS_XN = 281 * MiB;
constexpr size_t WS_MO = 313 * MiB, WS_MZ = 345 * MiB, WS_GT = 377 * MiB, WS_IF = 441 * MiB;
constexpr size_t WS_QC = 443 * MiB, WS_KC = 475 * MiB, WS_KT = 507 * MiB, WS_VT = 539 * MiB;
constexpr size_t WS_SA = 571 * MiB, WS_SCM = 572 * MiB, WS_SB = 573 * MiB;
constexpr size_t WS_EA = 574 * MiB, WS_NP = 575 * MiB, WS_MP = 575 * MiB + 768 * 1024, WS_RS = 576 * MiB, WS_END = 577 * MiB;
constexpr size_t WS_HF = WS_MQ, WS_HB = WS_MK;
constexpr size_t WS_CP = WS_MV;
constexpr size_t WS_T = WS_QC, WS_MG = WS_KC;

constexpr int LDS_BYTES = 147456;

typedef __bf16 bf16v2_t __attribute__((ext_vector_type(2)));
typedef float f32v2_t __attribute__((ext_vector_type(2)));
__device__ __forceinline__ unsigned cvt_pk_bf16(float lo, float hi) { const f32v2_t v = {lo, hi}; return __builtin_bit_cast(unsigned, __builtin_convertvector(v, bf16v2_t)); }
__device__ __forceinline__ float bflo(unsigned w) { return __uint_as_float(w << 16); }
__device__ __forceinline__ float bfhi(unsigned w) { return __uint_as_float(w & 0xffff0000u); }
__device__ __forceinline__ float fexp(float x) { return __builtin_amdgcn_exp2f(x * 1.4426950408889634f); }
__device__ __forceinline__ int crow(int r, int hi) { return (r & 3) + 8 * (r >> 2) + 4 * hi; }
__device__ __forceinline__ int tid_opaque() { int t = threadIdx.x; asm volatile("" : "+v"(t)); return t; }
__device__ __forceinline__ float shfl_x(float v, int lane, int m) { return __int_as_float(__builtin_amdgcn_ds_bpermute((lane ^ m) << 2, __float_as_int(v))); }
__device__ __forceinline__ float shfl_u(float v, int lane, int o) { int src = lane - o; src = src < 0 ? lane : src; return __int_as_float(__builtin_amdgcn_ds_bpermute(src << 2, __float_as_int(v))); }
#define MFMA32(a, b, c) __builtin_amdgcn_mfma_f32_32x32x16_bf16((a), (b), (c), 0, 0, 0)

namespace pg8 {
constexpr int BM = 256, BK = 64, HALF = 128, HTB = HALF * BK * 2, STAGE_BYTES = 8 * HTB, NXCD = 8, WGM = 8;
__host__ __device__ __forceinline__ int lds_byte(int r, int c) { const int st = (r >> 4) * 2 + (c >> 5), rr = r & 15, cc = c & 31, ob = rr * 64 + cc * 2; return st * 1024 + (ob ^ (((ob >> 9) & 1) << 5)); }
__host__ __device__ __forceinline__ void stage_rc(int b, int& R, int& C) { const int st = b / 1024, sb = b % 1024, swz = sb ^ (((sb >> 9) & 1) << 5); R = (st >> 1) * 16 + swz / 64; C = (st & 1) * 32 + (swz % 64) / 2; }
__host__ __device__ __forceinline__ int perm32(int rho) { const int n = rho >> 4, i = rho & 15; return 8 * (i >> 2) + 4 * n + (i & 3); }

struct Unit { int pm, pn; };
struct Gemm { const bf16_t* A; const bf16_t* Bt; int M, N, K; };

struct StaticOrder {
    int nM, nN, nwg, G, c;
    __host__ __device__ void init(int M, int N, int G_, int c_) { nM = M / BM; nN = N / BM; nwg = nM * nN; G = G_; c = c_; }
    __host__ __device__ bool next(int i, Unit& u) const {
        const long L = (long)i * G + c; if (L >= nwg) return false;
        int wgid = (int)L; { const int q = nwg / NXCD, r = nwg % NXCD, xcd = wgid % NXCD, off = wgid / NXCD; wgid = (xcd < r ? xcd * (q + 1) : r * (q + 1) + (xcd - r) * q) + off; }
        const int nig = WGM * nN, gid = wgid / nig, fm = gid * WGM, gsz = (nM - fm) < WGM ? (nM - fm) : WGM;
        u.pm = fm + ((wgid % nig) % gsz); u.pn = (wgid % nig) / gsz; return true;
    }
    __device__ __forceinline__ void a_ready(const Unit&) const {}
    __device__ __forceinline__ void done(const Unit&) const {}
};

template <class Epi, class Sched, bool ALIGN_EPI = false, bool SP2 = false>
__device__ __forceinline__ void gemm_phase(LAS unsigned char* lds, const Gemm g, const Sched& S, const Epi& E) {
    const int tid = tid_opaque(), wid = __builtin_amdgcn_readfirstlane(tid >> 6), lane = tid & 63, wr = wid >> 2, wc = wid & 3, fr = lane & 15, fq = lane >> 4;
    const int K = g.K, nt = K / BK;
    unsigned voffA[2], voffB[2];
#pragma unroll
    for (int i = 0; i < 2; ++i) { int R, C; stage_rc(tid * 16 + i * 8192, R, C); const int Rb = Epi::PERM ? ((R & ~31) + perm32(R & 31)) : R;
        voffA[i] = (unsigned)(R * K + C) * 2u; voffB[i] = (unsigned)(Rb * K + C) * 2u; }
    const size_t kstep = (size_t)(BK * 2);
    const size_t hstep = (size_t)HALF * K * 2;
    const size_t tstep = 2 * hstep;
    const unsigned ldsw = (unsigned)wid * 1024u;
    const int aoff = lds_byte(wr * 64 + fr, fq * 8), boff = lds_byte(wc * 32 + fr, fq * 8);
#define PG8_SA(b, h) (((b) * 2 + (h)) * HTB)
#define PG8_SB(b, h) ((4 + (b) * 2 + (h)) * HTB)
#define PG8_STAGE(bufoff, gbase, voff) do { _Pragma("unroll") for (int _i = 0; _i < 2; ++_i) \
        __builtin_amdgcn_global_load_lds((const unsigned*)((const char*)(gbase) + (voff)[_i]), (LAS unsigned*)(lds + (bufoff) + ldsw + _i * 8192), 16, 0, 0); } while (0)
#define PG8_LDA(dst, b, h) do { _Pragma("unroll") for (int m = 0; m < 4; ++m) _Pragma("unroll") for (int k = 0; k < 2; ++k) dst[m][k] = *(const LAS bf16x8*)(lds + PG8_SA(b, h) + aoff + m * 2048 + k * 1024); } while (0)
#define PG8_LDB(dst, b, h) do { _Pragma("unroll") for (int n = 0; n < 2; ++n) _Pragma("unroll") for (int k = 0; k < 2; ++k) dst[n][k] = *(const LAS bf16x8*)(lds + PG8_SB(b, h) + boff + n * 2048 + k * 1024); } while (0)
#define PG8_MMA(ai, bj, At, Bt) do { __builtin_amdgcn_s_setprio(1); _Pragma("unroll") for (int m = 0; m < 4; ++m) _Pragma("unroll") for (int n = 0; n < 2; ++n) _Pragma("unroll") for (int k = 0; k < 2; ++k) \
        acc[ai][bj][m][n] = __builtin_amdgcn_mfma_f32_16x16x32_bf16(Bt[n][k], At[m][k], acc[ai][bj][m][n], 0, 0, 0); __builtin_amdgcn_s_setprio(0); } while (0)
#define PG8_WAIT_V(n) asm volatile("s_waitcnt vmcnt(" #n ")" ::: "memory")
#define PG8_WAIT_L(n) asm volatile("s_waitcnt lgkmcnt(" #n ")" ::: "memory")
#define PG8_BAR __builtin_amdgcn_s_barrier()
#define PG8_SCHED __builtin_amdgcn_sched_barrier(0)
    Unit cur, nxt; int ui = 0;
    if (!S.next(0, cur)) return;
    f32x4 acc[2][2][4][2];
#pragma unroll
    for (int a = 0; a < 2; ++a)
#pragma unroll
        for (int b = 0; b < 2; ++b)
#pragma unroll
            for (int m = 0; m < 4; ++m)
#pragma unroll
                for (int n = 0; n < 2; ++n) acc[a][b][m][n] = (f32x4){0.f, 0.f, 0.f, 0.f};
    bf16x8 At[4][2], B0[2][2], B1[2][2];
    const char* cA = (const char*)g.A + (size_t)cur.pm * tstep; const char* cB = (const char*)g.Bt + (size_t)cur.pn * tstep;
    S.a_ready(cur);
    if constexpr (SP2) {
        PG8_STAGE(PG8_SB(0, 0), cB, voffB); PG8_STAGE(PG8_SB(0, 1), cB + hstep, voffB); PG8_STAGE(PG8_SA(0, 0), cA, voffA); PG8_STAGE(PG8_SA(0, 1), cA + hstep, voffA);
        if (wr == 1) PG8_BAR;
        PG8_WAIT_V(2); PG8_BAR;
        PG8_STAGE(PG8_SB(1, 0), cB + kstep, voffB); PG8_STAGE(PG8_SA(1, 0), cA + kstep, voffA); PG8_STAGE(PG8_SB(1, 1), cB + hstep + kstep, voffB);
        PG8_WAIT_V(6); PG8_BAR;
    } else {
        PG8_STAGE(PG8_SB(0, 0), cB, voffB); PG8_STAGE(PG8_SA(0, 0), cA, voffA); PG8_STAGE(PG8_SB(0, 1), cB + hstep, voffB); PG8_STAGE(PG8_SA(0, 1), cA + hstep, voffA);
        if (wr == 1) PG8_BAR;
        PG8_WAIT_V(4); PG8_BAR;
        PG8_STAGE(PG8_SB(1, 0), cB + kstep, voffB); PG8_STAGE(PG8_SA(1, 0), cA + kstep, voffA); PG8_STAGE(PG8_SB(1, 1), cB + hstep + kstep, voffB);
        PG8_WAIT_V(6); PG8_BAR;
    }
    for (;;) {
        const bool has_next = S.next(ui + 1, nxt);
        const char* nA = has_next ? (const char*)g.A + (size_t)nxt.pm * tstep : cA; const char* nB = has_next ? (const char*)g.Bt + (size_t)nxt.pn * tstep : cB;
        for (int t = 0; t < nt; t += 2) {
            const bool last = (t == nt - 2);
            const char* a1 = cA + (size_t)(t + 1) * kstep;
            const char* a2 = last ? nA : cA + (size_t)(t + 2) * kstep; const char* b2 = last ? nB : cB + (size_t)(t + 2) * kstep;
            const char* a3 = a2 + kstep; const char* b3 = b2 + kstep;
            if (last && has_next) S.a_ready(nxt);
            if constexpr (SP2) {
            PG8_LDB(B0, 0, 0); PG8_LDB(B1, 0, 1); PG8_SCHED; PG8_LDA(At, 0, 0); PG8_STAGE(PG8_SA(1, 1), a1 + hstep, voffA);
            PG8_WAIT_V(8); PG8_WAIT_L(0); PG8_BAR; PG8_MMA(0, 0, At, B0); PG8_MMA(0, 1, At, B1); PG8_BAR; PG8_SCHED;
            PG8_LDA(At, 0, 1); PG8_STAGE(PG8_SB(0, 0), b2, voffB); PG8_STAGE(PG8_SB(0, 1), b2 + hstep, voffB); PG8_STAGE(PG8_SA(0, 0), a2, voffA);
            PG8_WAIT_V(8); PG8_WAIT_L(0); PG8_BAR; PG8_MMA(1, 0, At, B0); PG8_MMA(1, 1, At, B1); PG8_BAR; PG8_SCHED;
            PG8_LDB(B0, 1, 0); PG8_LDB(B1, 1, 1); PG8_SCHED; PG8_LDA(At, 1, 0); PG8_STAGE(PG8_SA(0, 1), a2 + hstep, voffA);
            PG8_WAIT_V(8); PG8_WAIT_L(0); PG8_BAR; PG8_MMA(0, 0, At, B0); PG8_MMA(0, 1, At, B1); PG8_BAR; PG8_SCHED;
            PG8_LDA(At, 1, 1); PG8_STAGE(PG8_SB(1, 0), b3, voffB); PG8_STAGE(PG8_SB(1, 1), b3 + hstep, voffB); PG8_STAGE(PG8_SA(1, 0), a3, voffA);
            PG8_WAIT_V(8); PG8_WAIT_L(0); PG8_BAR; PG8_MMA(1, 0, At, B0); PG8_MMA(1, 1, At, B1); PG8_BAR; PG8_SCHED;
            } else {
            PG8_LDB(B0, 0, 0); PG8_SCHED; PG8_LDA(At, 0, 0); PG8_STAGE(PG8_SA(1, 1), a1 + hstep, voffA);
            PG8_WAIT_L(8); PG8_BAR; PG8_WAIT_L(0); PG8_MMA(0, 0, At, B0); PG8_BAR; PG8_SCHED;
            PG8_LDB(B1, 0, 1); PG8_STAGE(PG8_SB(0, 0), b2, voffB);
            PG8_BAR; PG8_WAIT_L(0); PG8_MMA(0, 1, At, B1); PG8_BAR;
            PG8_LDA(At, 0, 1); PG8_STAGE(PG8_SA(0, 0), a2, voffA);
            PG8_BAR; PG8_WAIT_L(0); PG8_MMA(1, 0, At, B0); PG8_BAR; PG8_SCHED;
            PG8_STAGE(PG8_SB(0, 1), b2 + hstep, voffB);
            PG8_WAIT_V(6); PG8_BAR; PG8_MMA(1, 1, At, B1); PG8_BAR;
            PG8_LDB(B0, 1, 0); PG8_SCHED; PG8_LDA(At, 1, 0); PG8_STAGE(PG8_SA(0, 1), a2 + hstep, voffA);
            PG8_WAIT_L(8); PG8_BAR; PG8_WAIT_L(0); PG8_MMA(0, 0, At, B0); PG8_BAR; PG8_SCHED;
            PG8_LDB(B1, 1, 1); PG8_STAGE(PG8_SB(1, 0), b3, voffB);
            PG8_BAR; PG8_WAIT_L(0); PG8_MMA(0, 1, At, B1); PG8_BAR;
            PG8_LDA(At, 1, 1); PG8_STAGE(PG8_SA(1, 0), a3, voffA);
            PG8_BAR; PG8_WAIT_L(0); PG8_MMA(1, 0, At, B0); PG8_BAR; PG8_SCHED;
            PG8_STAGE(PG8_SB(1, 1), b3 + hstep, voffB);
            PG8_WAIT_V(6); PG8_BAR; PG8_MMA(1, 1, At, B1); PG8_BAR;
            }
        }
        if constexpr (ALIGN_EPI) { if (wr == 0) PG8_BAR; }
        E(acc, cur, wr, wc, fr, fq); S.done(cur);
        if (!has_next) break;
#pragma unroll
        for (int a = 0; a < 2; ++a)
#pragma unroll
            for (int b = 0; b < 2; ++b)
#pragma unroll
                for (int m = 0; m < 4; ++m)
#pragma unroll
                    for (int n = 0; n < 2; ++n) acc[a][b][m][n] = (f32x4){0.f, 0.f, 0.f, 0.f};
        cur = nxt; cA = nA; cB = nB; ++ui;
        if constexpr (ALIGN_EPI) { if (wr == 1) PG8_BAR; }
    }
    PG8_WAIT_V(0);
    if constexpr (!ALIGN_EPI) { if (wr == 0) PG8_BAR; }
    PG8_BAR;
#undef PG8_SA
#undef PG8_SB
#undef PG8_STAGE
#undef PG8_LDA
#undef PG8_LDB
#undef PG8_MMA
#undef PG8_WAIT_V
#undef PG8_WAIT_L
#undef PG8_BAR
#undef PG8_SCHED
}
}

__device__ __forceinline__ float row_rscale(const float* rs, int row) {
    const f32x4 a = *(const f32x4*)(rs + (size_t)row * 4);
    return __builtin_amdgcn_rsqf(((a[0] + a[1]) + (a[2] + a[3])) * (1.f / DM) + NORM_EPS);
}

struct EpiProj {
    static constexpr bool PERM = true;
    unsigned char* ws; const float* bias;
    __device__ __forceinline__ void operator()(const f32x4 (&acc)[2][2][4][2], const pg8::Unit& u, int wr, int wc, int fr, int fq) const {
        const int pn = u.pn;
        const int row0 = u.pm * 256 + wr * 64 + fr;
        const int pc0 = pn * 256 + wc * 32 + 8 * fq;
        float rscv[2][4];
#pragma unroll
        for (int ai = 0; ai < 2; ++ai)
#pragma unroll
            for (int m = 0; m < 4; ++m) rscv[ai][m] = row_rscale((const float*)(ws + WS_RS), row0 + ai * 128 + m * 16);
        if (false) {
        } else if (pn == 38) {
            if (wc == 0) {
                f32x4 bv[2];
#pragma unroll
                for (int n = 0; n < 2; ++n) bv[n] = *(const f32x4*)(bias + pc0 + 4 * n);
#pragma unroll
                for (int ai = 0; ai < 2; ++ai)
#pragma unroll
                    for (int m = 0; m < 4; ++m) {
                        const int row = row0 + ai * 128 + m * 16;
                        const float rsc = rscv[ai][m];
#pragma unroll
                        for (int n = 0; n < 2; ++n) {
                            f32x4 v = acc[ai][0][m][n] * rsc + bv[n];
                            if (fq & 1) {
#pragma unroll
                                for (int i = 0; i < 4; ++i) { const float ex = fexp(-fabsf(v[i])); const float l1 = ex < 0.01f ? ex * (1.f - ex * (0.5f - ex * 0.33333333f)) : __logf(1.f + ex); v[i] = fminf(v[i], 0.f) - l1; }
                            }
                            *(f32x4*)((float*)(ws + WS_IF) + (size_t)row * 32 + 8 * fq + 4 * n) = v;
                        }
                    }
            }
        } else {
            size_t doff; int ld, col, act;
            if (pn < 4) { doff = WS_Q; ld = 1024; col = pn * 256; act = 0; }
            else if (pn == 4) { doff = WS_K; ld = 256; col = 0; act = 0; }
            else if (pn == 5) { doff = WS_V; ld = 256; col = 0; act = 0; }
            else if (pn < 10) { doff = WS_AZ; ld = 1024; col = (pn - 6) * 256; act = 1; }
            else if (pn < 14) { doff = WS_MQ; ld = 1024; col = (pn - 10) * 256; act = 0; }
            else if (pn < 18) { doff = WS_MK; ld = 1024; col = (pn - 14) * 256; act = 0; }
            else if (pn < 22) { doff = WS_MV; ld = 1024; col = (pn - 18) * 256; act = 0; }
            else if (pn < 26) { doff = WS_MO; ld = 1024; col = (pn - 22) * 256; act = 2; }
            else if (pn < 30) { doff = WS_MZ; ld = 1024; col = (pn - 26) * 256; act = 1; }
            else { doff = WS_GT; ld = 2048; col = (pn - 30) * 256; act = 2; }
            bf16_t* dst = (bf16_t*)(ws + doff);
            col += wc * 32 + 8 * fq;
            f32x4 bv[2][2];
#pragma unroll
            for (int bj = 0; bj < 2; ++bj)
#pragma unroll
                for (int n = 0; n < 2; ++n) bv[bj][n] = *(const f32x4*)(bias + pc0 + bj * 128 + 4 * n);
#pragma unroll
            for (int ai = 0; ai < 2; ++ai)
#pragma unroll
                for (int m = 0; m < 4; ++m) {
                    bf16_t* rowp = dst + (size_t)(row0 + ai * 128 + m * 16) * ld + col;
                    const float rsc = rscv[ai][m];
#pragma unroll
                    for (int bj = 0; bj < 2; ++bj) {
                        f32x4 v[2];
#pragma unroll
                        for (int n = 0; n < 2; ++n) {
                            v[n] = acc[ai][bj][m][n] * rsc + bv[bj][n];
                            if (act != 0) {
#pragma unroll
                                for (int i = 0; i < 4; ++i) { const float s = __builtin_amdgcn_rcpf(1.f + fexp(-v[n][i])); v[n][i] = act == 1 ? v[n][i] * s : s; }
                            }
                        }
                        u32x4 w; w.x = cvt_pk_bf16(v[0][0], v[0][1]); w.y = cvt_pk_bf16(v[0][2], v[0][3]); w.z = cvt_pk_bf16(v[1][0], v[1][1]); w.w = cvt_pk_bf16(v[1][2], v[1][3]);
                        __builtin_nontemporal_store(w, (u32x4*)(rowp + bj * 128));
                    }
                }
        }
    }
};

template <int MODE> struct EpiGate {
    static constexpr bool PERM = true;
    const bf16_t* GT; bf16_t* T; bf16_t* MG;
    __device__ __forceinline__ void operator()(const f32x4 (&acc)[2][2][4][2], const pg8::Unit& u, int wr, int wc, int fr, int fq) const {
        const int row0 = u.pm * 256 + wr * 64 + fr; const int col0 = u.pn * 256 + wc * 32 + 8 * fq;
        u32x4 gc[2], tc[2];
#pragma unroll
        for (int bj = 0; bj < 2; ++bj) { gc[bj] = *(const u32x4*)(GT + (size_t)row0 * 2048 + MODE * 1024 + col0 + bj * 128); if (MODE == 1) tc[bj] = *(const u32x4*)(T + (size_t)row0 * 1024 + col0 + bj * 128); }
#pragma unroll
        for (int it = 0; it < 8; ++it) {
            const int ai = it >> 2, m = it & 3;
            const size_t row = (size_t)(row0 + ai * 128 + m * 16);
            u32x4 gn[2], tn[2];
            if (it < 7) { const size_t rown = (size_t)(row0 + ((it + 1) >> 2) * 128 + ((it + 1) & 3) * 16);
#pragma unroll
                for (int bj = 0; bj < 2; ++bj) { gn[bj] = *(const u32x4*)(GT + rown * 2048 + MODE * 1024 + col0 + bj * 128); if (MODE == 1) tn[bj] = *(const u32x4*)(T + rown * 1024 + col0 + bj * 128); } }
#pragma unroll
            for (int bj = 0; bj < 2; ++bj) {
                const int col = col0 + bj * 128;
                const u32x4 gw = gc[bj];
                float o[8];
                o[0] = acc[ai][bj][m][0][0] * bflo(gw.x); o[1] = acc[ai][bj][m][0][1] * bfhi(gw.x); o[2] = acc[ai][bj][m][0][2] * bflo(gw.y); o[3] = acc[ai][bj][m][0][3] * bfhi(gw.y);
                o[4] = acc[ai][bj][m][1][0] * bflo(gw.z); o[5] = acc[ai][bj][m][1][1] * bfhi(gw.z); o[6] = acc[ai][bj][m][1][2] * bflo(gw.w); o[7] = acc[ai][bj][m][1][3] * bfhi(gw.w);
                if (MODE == 1) {
                    const u32x4 tw = tc[bj];
                    o[0] += bflo(tw.x); o[1] += bfhi(tw.x); o[2] += bflo(tw.y); o[3] += bfhi(tw.y); o[4] += bflo(tw.z); o[5] += bfhi(tw.z); o[6] += bflo(tw.w); o[7] += bfhi(tw.w);
                }
                u32x4 w; w.x = cvt_pk_bf16(o[0], o[1]); w.y = cvt_pk_bf16(o[2], o[3]); w.z = cvt_pk_bf16(o[4], o[5]); w.w = cvt_pk_bf16(o[6], o[7]);
                *(u32x4*)((MODE == 0 ? T : MG) + row * 1024 + col) = w;
            }
            if (it < 7) {
#pragma unroll
                for (int bj = 0; bj < 2; ++bj) { gc[bj] = gn[bj]; if (MODE == 1) tc[bj] = tn[bj]; } }
            asm volatile("" ::: "memory");
        }
    }
};

struct EpiRes {
    static constexpr bool PERM = false;
    const float* xin; float* xout; bf16_t* xb; float* rsq; LAS float* xl; int wxb;
    __device__ __forceinline__ void operator()(const f32x4 (&acc)[2][2][4][2], const pg8::Unit& u, int wr, int wc, int fr, int fq) const {
        const int row0 = u.pm * 256 + wr * 64 + fr; const int col0 = u.pn * 256 + wc * 32 + 4 * fq; const int lane = fq * 16 + fr;
        f32x4 xc[2][2];
#pragma unroll
        for (int bj = 0; bj < 2; ++bj)
#pragma unroll
            for (int n = 0; n < 2; ++n) xc[bj][n] = *(const f32x4*)(xin + (size_t)row0 * 1024 + col0 + bj * 128 + n * 16);
#pragma unroll
        for (int it = 0; it < 8; ++it) {
            const int ai = it >> 2, m = it & 3;
            const int row = row0 + ai * 128 + m * 16;
            const size_t off = (size_t)row * 1024 + col0;
            f32x4 xn[2][2];
            if (it < 7) { const size_t offn = (size_t)(row0 + ((it + 1) >> 2) * 128 + ((it + 1) & 3) * 16) * 1024 + col0;
#pragma unroll
                for (int bj = 0; bj < 2; ++bj)
#pragma unroll
                    for (int n = 0; n < 2; ++n) xn[bj][n] = *(const f32x4*)(xin + offn + bj * 128 + n * 16); }
            float ss = 0.f;
#pragma unroll
            for (int bj = 0; bj < 2; ++bj)
#pragma unroll
                for (int n = 0; n < 2; ++n) { const f32x4 x = xc[bj][n] + acc[ai][bj][m][n]; *(f32x4*)(xout + off + bj * 128 + n * 16) = x;
                    if (wxb) { u32x2 w; w.x = cvt_pk_bf16(x[0], x[1]); w.y = cvt_pk_bf16(x[2], x[3]); *(u32x2*)(xb + off + bj * 128 + n * 16) = w; }
                    ss += (x[0] * x[0] + x[1] * x[1]) + (x[2] * x[2] + x[3] * x[3]); }
            ss += shfl_x(ss, lane, 16); ss += shfl_x(ss, lane, 32);
            if (fq == 0) xl[(row - u.pm * 256) * 4 + wc] = ss;
            if (it < 7) {
#pragma unroll
                for (int bj = 0; bj < 2; ++bj)
#pragma unroll
                    for (int n = 0; n < 2; ++n) xc[bj][n] = xn[bj][n]; }
            asm volatile("" ::: "memory");
        }
        __syncthreads();
        {
            const int t = wr * 256 + wc * 64 + lane;
            if (t < 256 && wxb) { const f32x4 a = *(const LAS f32x4*)(xl + t * 4); rsq[(size_t)(u.pm * 256 + t) * 4 + u.pn] = (a[0] + a[1]) + (a[2] + a[3]); }
        }
    }
};

struct Ctx {
    int S, nseq, lgn;
    const float* xin; float* xout; unsigned char* ws;
};
#define CB(c, OFF) ((bf16_t*)((c).ws + (OFF)))
#define CF(c, OFF) ((float*)((c).ws + (OFF)))

__device__ __forceinline__ void transpose_item(const float* W, int K, int Nsrc, bf16_t* WT, int kb, int n_src, int n_dst, LAS float* scr, int lane, const float* gk) {
    const int k0 = 64 * kb;
    if (n_src >= 0) {
#pragma unroll 8
        for (int i = 0; i < 32; ++i) { const int kk = 2 * i + (lane >> 5); scr[kk * 33 + (lane & 31)] = W[(size_t)(k0 + kk) * Nsrc + n_src + (lane & 31)] * (gk ? gk[k0 + kk] : 1.f); }
    } else {
#pragma unroll 8
        for (int i = 0; i < 32; ++i) { const int kk = 2 * i + (lane >> 5); scr[kk * 33 + (lane & 31)] = 0.f; }
    }
    asm volatile("s_waitcnt lgkmcnt(0)" ::: "memory");
    const int c = lane & 7;
#pragma unroll
    for (int j = 0; j < 4; ++j) { const int n = (lane >> 3) + 8 * j; const LAS float* s = scr + (8 * c) * 33 + n;
        u32x4 o; o.x = cvt_pk_bf16(s[0 * 33], s[1 * 33]); o.y = cvt_pk_bf16(s[2 * 33], s[3 * 33]); o.z = cvt_pk_bf16(s[4 * 33], s[5 * 33]); o.w = cvt_pk_bf16(s[6 * 33], s[7 * 33]);
        *(u32x4*)(WT + (size_t)(n_dst + n) * K + k0 + 8 * c) = o; }
    asm volatile("s_waitcnt lgkmcnt(0)" ::: "memory");
}
__device__ __forceinline__ int in_block_map(int pb) {
    if (pb < 240) return pb;
    if (pb < 304) return 241 + (pb - 240);
    if (pb == 304) return 240;
    return -1;
}

struct Args {
    const float* x_prompt; const float* x_sample; const float* norm_g; const float* w_in; const float* b_in; const float* q_norm_g; const float* k_norm_g;
    const float* sink; const float* conv_w; const float* m_norm_g; const float* w_att_out; const float* w_m_out; const float* w_out;
    float* out; unsigned char* ws;
};

template <class KP> __device__ __forceinline__ void prologue(KP ka, LAS unsigned char* lds) {
    const int tid = tid_opaque(), lane = tid & 63, wave = tid >> 6;
    const int gw = blockIdx.x * 8 + wave, NGW = gridDim.x * 8;
    LAS float* scr = (LAS float*)(lds + wave * 16384);
    unsigned char* ws = ka->ws;
    constexpr int IT_IN = 16 * 312, IT_SQ = 16 * 32, IT_L = IT_IN + 3 * IT_SQ;
    for (int it = gw; it < DEPTH * IT_L; it += NGW) {
        const int l = it / IT_L; int r = it % IT_L;
        if (r < IT_IN) { const int kb = r / 312, pb = r % 312; const int lb = in_block_map(pb);
            transpose_item(ka->w_in + (size_t)l * DM * IN_DIM, DM, IN_DIM, (bf16_t*)(ws + WS_WIN + l * WIN_BYTES), kb, lb < 0 ? -1 : lb * 32, pb * 32, scr, lane, ka->norm_g + l * DM); continue; }
        r -= IT_IN;
        const int which = r / IT_SQ; r %= IT_SQ; const int kb = r / 32, nb = r % 32;
        const float* W = (which == 0 ? ka->w_att_out : which == 1 ? ka->w_m_out : ka->w_out) + (size_t)l * DM * DM;
        bf16_t* WT = (bf16_t*)(ws + (which == 0 ? WS_WA : which == 1 ? WS_WM : WS_WO) + (size_t)l * DM * DM * 2);
        transpose_item(W, DM, DM, WT, kb, nb * 32, nb * 32, scr, lane, nullptr);
    }
    const int gt = blockIdx.x * 512 + tid, NT = gridDim.x * 512;
    for (int i = gt; i < DEPTH * NPHYS; i += NT) { const int l = i / NPHYS, p = i % NPHYS; const int lb = in_block_map(p >> 5);
        ((float*)(ws + WS_BIAS))[i] = lb < 0 ? 0.f : ka->b_in[(size_t)l * IN_DIM + lb * 32 + (p & 31)]; }
    for (int i = gt; i < 4096 * 8; i += NT) { const int pos = i >> 3, j = i & 7;
        const float inv = j == 0 ? 1.0f : j == 1 ? 0.1939227432012558f : j == 2 ? 0.03760603070259094f : j == 3 ? 0.007292664609849453f : j == 4 ? 0.0014142135623842478f : j == 5 ? 0.00027424818836152554f : j == 6 ? 5.318296098266728e-05f : 1.0313386155758053e-05f;
        const float ang = (float)pos * inv;
        const double rev = (double)ang * 0.15915494309189535; const double fr = rev - __builtin_rint(rev);
        const float f = (float)fr;
        ((float*)(ws + WS_ROPE))[2 * i] = __builtin_amdgcn_cosf(f); ((float*)(ws + WS_ROPE))[2 * i + 1] = __builtin_amdgcn_sinf(f); }
    if (gt < DEPTH) { float mq = 0.f, mk = 0.f; for (int i = 0; i < 64; ++i) { mq = fmaxf(mq, fabsf(ka->q_norm_g[gt * 64 + i])); mk = fmaxf(mk, fabsf(ka->k_norm_g[gt * 64 + i])); }
        ((float*)(ws + WS_MB))[gt] = 8.f * mq * mk; }
}

__device__ __forceinline__ void norm_phase(const Ctx& c) {
    const int tid = tid_opaque(); const int lane = tid & 63, wave = tid >> 6;
    const int gw = blockIdx.x * 8 + wave, NGW = gridDim.x * 8;
    for (int m = gw; m < GM; m += NGW) {
        const f32x4* xr = (const f32x4*)(c.xin + (size_t)m * DM) + lane;
        f32x4 v[4]; float s = 0.f;
#pragma unroll
        for (int j = 0; j < 4; ++j) { v[j] = xr[64 * j]; s += (v[j].x * v[j].x + v[j].y * v[j].y) + (v[j].z * v[j].z + v[j].w * v[j].w); }
#pragma unroll
        for (int o = 1; o < 64; o <<= 1) s += shfl_x(s, lane, o);
        if (lane < 4) CF(c, WS_RS)[(size_t)m * 4 + lane] = lane == 0 ? s : 0.f;
        u32x2* o8 = (u32x2*)(CB(c, WS_XN) + (size_t)m * DM) + lane;
#pragma unroll
        for (int j = 0; j < 4; ++j) { u32x2 w; w.x = cvt_pk_bf16(v[j].x, v[j].y); w.y = cvt_pk_bf16(v[j].z, v[j].w); o8[64 * j] = w; }
    }
}

constexpr int AT_KP = 144, AT_VP = 776, AT_VOFF = 384 * AT_KP;
__device__ __forceinline__ void attn_unit(LAS unsigned char* lds, int unit, const Ctx& c, const float* sink, float mb, bf16_t* dstbuf, const float* qg) {
    const int tid = tid_opaque(), lane = tid & 63, w = tid >> 6, l32 = lane & 31, hi = lane >> 5;
    const int S = c.S, nb = S >> 7;
    const int g = unit & 3, qb = (unit >> 2) & (nb - 1), seq = (unit >> 2) >> c.lgn;
    const size_t rowbase = (size_t)seq * S;
    LAS unsigned char* Ks = lds; LAS unsigned char* Vt = lds + AT_VOFF;
#pragma unroll
    for (int it = 0; it < 6; ++it) { const int idx = tid + it * 512; const int r = idx >> 3, ch = idx & 7; const int kpos = (qb - 1) * 128 + r;
        if (kpos >= 0 && kpos < S) { const u32x4 v = *(const u32x4*)(CB(c, WS_K) + (rowbase + kpos) * 256 + g * 64 + ch * 8); *(LAS u32x4*)(Ks + r * AT_KP + ch * 16) = v; } }
#pragma unroll
    for (int it = 0; it < 3; ++it) { const int idx = tid + it * 512; const int kp = idx >> 3, dg = idx & 7; const int key0 = kp * 2; const int kpos = (qb - 1) * 128 + key0;
        if (kpos >= 0 && kpos < S) {
            const u32x4 va = *(const u32x4*)(CB(c, WS_V) + (rowbase + kpos) * 256 + g * 64 + dg * 8), vb = *(const u32x4*)(CB(c, WS_V) + (rowbase + kpos + 1) * 256 + g * 64 + dg * 8);
            const unsigned aa[4] = {va.x, va.y, va.z, va.w}, bb[4] = {vb.x, vb.y, vb.z, vb.w};
#pragma unroll
            for (int i = 0; i < 8; ++i) { const unsigned lo = (i & 1) ? (aa[i >> 1] >> 16) : (aa[i >> 1] & 0xffffu); const unsigned hh = (i & 1) ? (bb[i >> 1] & 0xffff0000u) : (bb[i >> 1] << 16);
                *(LAS unsigned*)(Vt + (dg * 8 + i) * AT_VP + key0 * 2) = lo | hh; }
        } }
    __syncthreads();
    const int hq = g * 4 + (w >> 1);
    const float mb2 = mb * 1.4426950408889634f;
    const float sinkv = __builtin_amdgcn_exp2f(sink[hq] * 1.4426950408889634f - mb2);
#pragma unroll 1
    for (int half = 0; half < 2; ++half) {
        const int qt = (w & 1) * 2 + half; const int qi = qt * 32 + l32; const size_t qrow = rowbase + qb * 128 + qi;
        bf16x8 qf[4];
        {
            u32x4 qw[4]; float ss = 0.f;
#pragma unroll
            for (int s = 0; s < 4; ++s) { qw[s] = *(const u32x4*)(CB(c, WS_Q) + qrow * 1024 + hq * 64 + 16 * s + 8 * hi);
                const float a0 = bflo(qw[s].x), a1 = bfhi(qw[s].x), a2 = bflo(qw[s].y), a3 = bfhi(qw[s].y), a4 = bflo(qw[s].z), a5 = bfhi(qw[s].z), a6 = bflo(qw[s].w), a7 = bfhi(qw[s].w);
                ss += ((a0 * a0 + a1 * a1) + (a2 * a2 + a3 * a3)) + ((a4 * a4 + a5 * a5) + (a6 * a6 + a7 * a7)); }
            ss += shfl_x(ss, lane, 32);
            const float rs = __builtin_amdgcn_rsqf(ss * (1.f / 64.f) + NORM_EPS) * (0.125f * 1.4426950408889634f);
            const int pos = (qb * 128 + qi) & (S - 1);
            const float* rp = (const float*)(c.ws + WS_ROPE) + pos * 16;
#pragma unroll
            for (int s = 0; s < 4; ++s) {
                const f32x4 g0 = *(const f32x4*)(qg + 16 * s + 8 * hi), g1 = *(const f32x4*)(qg + 16 * s + 8 * hi + 4);
                float v[8] = {bflo(qw[s].x) * rs * g0[0], bfhi(qw[s].x) * rs * g0[1], bflo(qw[s].y) * rs * g0[2], bfhi(qw[s].y) * rs * g0[3],
                              bflo(qw[s].z) * rs * g1[0], bfhi(qw[s].z) * rs * g1[1], bflo(qw[s].w) * rs * g1[2], bfhi(qw[s].w) * rs * g1[3]};
                if (s == 0) {
#pragma unroll
                    for (int j = 0; j < 8; ++j) { const float cs = rp[2 * j], sn = rp[2 * j + 1]; const float pr = shfl_x(v[j], lane, 32);
                        v[j] = hi == 0 ? v[j] * cs - pr * sn : v[j] * cs + pr * sn; }
                }
                u32x4 o; o.x = cvt_pk_bf16(v[0], v[1]); o.y = cvt_pk_bf16(v[2], v[3]); o.z = cvt_pk_bf16(v[4], v[5]); o.w = cvt_pk_bf16(v[6], v[7]);
                qf[s] = __builtin_bit_cast(bf16x8, o);
            }
        }
        f32x16 o0, o1;
#pragma unroll
        for (int r = 0; r < 16; ++r) { o0[r] = 0.f; o1[r] = 0.f; }
        float rsum = 0.f;
        const int bt_lo = qb > 0 ? qt : 4, bt_hi = qb < nb - 1 ? 8 + qt : 7;
        f32x16 pc;
#pragma unroll
        for (int r = 0; r < 16; ++r) pc[r] = -mb2;
#pragma unroll
        for (int s = 0; s < 4; ++s) { const bf16x8 ka = *(const LAS bf16x8*)(Ks + (bt_lo * 32 + l32) * AT_KP + (16 * s + 8 * hi) * 2); pc = MFMA32(ka, qf[s], pc); }
#pragma unroll 1
        for (int bt = bt_lo; bt <= bt_hi; ++bt) {
            const int kj0 = bt * 32;
            const int bn = bt < bt_hi ? bt + 1 : bt;
            f32x16 pn;
#pragma unroll
            for (int r = 0; r < 16; ++r) pn[r] = -mb2;
#pragma unroll
            for (int s = 0; s < 4; ++s) { const bf16x8 ka = *(const LAS bf16x8*)(Ks + (bn * 32 + l32) * AT_KP + (16 * s + 8 * hi) * 2); pn = MFMA32(ka, qf[s], pn); }
            f32x16 p = pc;
            if (bt == qt || bt == 8 + qt) {
#pragma unroll
                for (int r = 0; r < 16; ++r) { const int jr = crow(r, hi);
                    const bool valid = bt < 4 ? (jr >= l32) : (jr <= l32);
                    const float e = valid ? __builtin_amdgcn_exp2f(p[r]) : 0.f; p[r] = e; rsum += e; }
            } else {
#pragma unroll
                for (int r = 0; r < 16; ++r) { const float e = __builtin_amdgcn_exp2f(p[r]); p[r] = e; rsum += e; }
            }
#pragma unroll
            for (int s2 = 0; s2 < 2; ++s2) {
                u32x4 bw; bw.x = cvt_pk_bf16(p[8 * s2 + 0], p[8 * s2 + 1]); bw.y = cvt_pk_bf16(p[8 * s2 + 2], p[8 * s2 + 3]); bw.z = cvt_pk_bf16(p[8 * s2 + 4], p[8 * s2 + 5]); bw.w = cvt_pk_bf16(p[8 * s2 + 6], p[8 * s2 + 7]);
                const bf16x8 b2 = __builtin_bit_cast(bf16x8, bw);
                { const LAS unsigned char* vp = Vt + (l32) * AT_VP + (kj0 + 16 * s2 + 4 * hi) * 2; const u32x2 lo = *(const LAS u32x2*)vp, h2 = *(const LAS u32x2*)(vp + 16);
                  u32x4 aw; aw.x = lo.x; aw.y = lo.y; aw.z = h2.x; aw.w = h2.y; o0 = MFMA32(__builtin_bit_cast(bf16x8, aw), b2, o0); }
                { const LAS unsigned char* vp = Vt + (32 + l32) * AT_VP + (kj0 + 16 * s2 + 4 * hi) * 2; const u32x2 lo = *(const LAS u32x2*)vp, h2 = *(const LAS u32x2*)(vp + 16);
                  u32x4 aw; aw.x = lo.x; aw.y = lo.y; aw.z = h2.x; aw.w = h2.y; o1 = MFMA32(__builtin_bit_cast(bf16x8, aw), b2, o1); }
            }
            pc = pn;
        }
        rsum += shfl_x(rsum, lane, 32);
        const float inv = __builtin_amdgcn_rcpf(rsum + sinkv);
#pragma unroll
        for (int dt = 0; dt < 2; ++dt)
#pragma unroll
            for (int rg = 0; rg < 4; ++rg) {
                const int dim = dt * 32 + 8 * rg + 4 * hi; const size_t off = qrow * 1024 + hq * 64 + dim;
                const u32x2 zw = *(const u32x2*)(CB(c, WS_AZ) + off);
                const float v0 = (dt ? o1[4 * rg + 0] : o0[4 * rg + 0]) * inv * bflo(zw.x), v1 = (dt ? o1[4 * rg + 1] : o0[4 * rg + 1]) * inv * bfhi(zw.x);
                const float v2 = (dt ? o1[4 * rg + 2] : o0[4 * rg + 2]) * inv * bflo(zw.y), v3 = (dt ? o1[4 * rg + 3] : o0[4 * rg + 3]) * inv * bfhi(zw.y);
                u32x2 ow; ow.x = cvt_pk_bf16(v0, v1); ow.y = cvt_pk_bf16(v2, v3);
                *(u32x2*)(dstbuf + off) = ow;
            }
    }
    __syncthreads();
}


__device__ __forceinline__ void knorm_rows(const Ctx& c, const float* kg) {
    const int tid = tid_opaque(); const int lane = tid & 63, wave = tid >> 6;
    const int gw = blockIdx.x * 8 + wave, NGW = gridDim.x * 8;
    const int d0 = (lane & 3) * 16;
    const float* rope = (const float*)(c.ws + WS_ROPE);
#pragma unroll 2
    for (int m4 = gw; m4 < GM / 4; m4 += NGW) {
        const int m = m4 * 4 + (lane >> 4);
        const int pos = m & (c.S - 1);
        bf16_t* p = CB(c, WS_K) + (size_t)m * 256 + (lane & 15) * 16;
        const float* g = kg + d0;
        const u32x4 w0 = *(const u32x4*)p, w1 = *(const u32x4*)(p + 8);
        const unsigned ww[8] = {w0.x, w0.y, w0.z, w0.w, w1.x, w1.y, w1.z, w1.w};
        float v[16]; float ss = 0.f;
#pragma unroll
        for (int i = 0; i < 16; ++i) { v[i] = (i & 1) ? bfhi(ww[i >> 1]) : bflo(ww[i >> 1]); ss += v[i] * v[i]; }
        ss += shfl_x(ss, lane, 1); ss += shfl_x(ss, lane, 2);
        const float rs = __builtin_amdgcn_rsqf(ss * (1.f / 64.f) + NORM_EPS);
#pragma unroll
        for (int i = 0; i < 16; ++i) v[i] = v[i] * rs * g[i];
        if ((lane & 3) == 0) {
#pragma unroll
            for (int j = 0; j < 8; ++j) { const float cs = rope[pos * 16 + 2 * j], sn = rope[pos * 16 + 2 * j + 1]; const float x1 = v[j], x2 = v[j + 8]; v[j] = x1 * cs - x2 * sn; v[j + 8] = x2 * cs + x1 * sn; }
        }
        u32x4 o0, o1; o0.x = cvt_pk_bf16(v[0], v[1]); o0.y = cvt_pk_bf16(v[2], v[3]); o0.z = cvt_pk_bf16(v[4], v[5]); o0.w = cvt_pk_bf16(v[6], v[7]);
        o1.x = cvt_pk_bf16(v[8], v[9]); o1.y = cvt_pk_bf16(v[10], v[11]); o1.z = cvt_pk_bf16(v[12], v[13]); o1.w = cvt_pk_bf16(v[14], v[15]);
        *(u32x4*)p = o0; *(u32x4*)(p + 8) = o1;
    }
}

constexpr int PR_P = 260;
__device__ __forceinline__ void prep_unit(LAS unsigned char* lds, int unit, const Ctx& c, const float* cw) {
    const int tid = tid_opaque();
    const int S = c.S, nc = S >> 7;
    const int ch = unit & (nc - 1), h = (unit >> c.lgn) & 7, seq = unit >> (c.lgn + 3);
    const size_t rowbase = (size_t)seq * S; const int t0 = ch * 128;
    LAS unsigned char* Tk = lds; LAS unsigned char* Tv = lds + 128 * PR_P;
    const size_t hb = (size_t)(seq * 8 + h) * S * 128;
#pragma unroll 2
    for (int it = 0; it < 4; ++it) {
        const int idx = tid + it * 512; const int l = idx >> 4, dg = idx & 15; const int t = t0 + l; const int col = h * 128 + dg * 8;
#pragma unroll
        for (int qk = 0; qk < 2; ++qk) {
            const bf16_t* src = qk ? CB(c, WS_MK) : CB(c, WS_MQ);
            const u32x4 z = {0u, 0u, 0u, 0u};
            const u32x4 xm = t > 0 ? *(const u32x4*)(src + (rowbase + t - 1) * 1024 + col) : z;
            const u32x4 x0 = *(const u32x4*)(src + (rowbase + t) * 1024 + col);
            const u32x4 xp = t < S - 1 ? *(const u32x4*)(src + (rowbase + t + 1) * 1024 + col) : z;
            const float* w0 = cw + qk * 1024 + col; const float* w1 = w0 + 2048; const float* w2 = w1 + 2048;
            const unsigned am[4] = {xm.x, xm.y, xm.z, xm.w}, a0[4] = {x0.x, x0.y, x0.z, x0.w}, ap[4] = {xp.x, xp.y, xp.z, xp.w};
            float y[8];
#pragma unroll
            for (int i = 0; i < 8; ++i) {
                const float vm = (i & 1) ? bfhi(am[i >> 1]) : bflo(am[i >> 1]), v0 = (i & 1) ? bfhi(a0[i >> 1]) : bflo(a0[i >> 1]), vp = (i & 1) ? bfhi(ap[i >> 1]) : bflo(ap[i >> 1]);
                float s = vm * w0[i] + v0 * w1[i] + vp * w2[i];
                s = s * __builtin_amdgcn_rcpf(1.f + fexp(-s));
                y[i] = qk ? s * KSCALE : s;
            }
            u32x4 o; o.x = cvt_pk_bf16(y[0], y[1]); o.y = cvt_pk_bf16(y[2], y[3]); o.z = cvt_pk_bf16(y[4], y[5]); o.w = cvt_pk_bf16(y[6], y[7]);
            *(u32x4*)((qk ? CB(c, WS_KC) : CB(c, WS_QC)) + hb + (size_t)(t >> 5) * 4096 + dg * 256 + (t & 31) * 8) = o;
            if (qk) { LAS unsigned* tp = (LAS unsigned*)(Tk + l * PR_P + dg * 16); tp[0] = o.x; tp[1] = o.y; tp[2] = o.z; tp[3] = o.w; }
        }
        { const u32x4 v = *(const u32x4*)(CB(c, WS_MV) + (rowbase + t) * 1024 + col); LAS unsigned* tp = (LAS unsigned*)(Tv + l * PR_P + dg * 16); tp[0] = v.x; tp[1] = v.y; tp[2] = v.z; tp[3] = v.w; }
    }
    __syncthreads();
#pragma unroll 2
    for (int it = 0; it < 4; ++it) {
        const int idx = tid + it * 512; const int d = idx & 127, lg = idx >> 7;
#pragma unroll
        for (int kv = 0; kv < 2; ++kv) {
            const LAS unsigned char* T = kv ? Tv : Tk;
            unsigned short e[8];
#pragma unroll
            for (int i = 0; i < 8; ++i) e[i] = *(const LAS unsigned short*)(T + (lg * 8 + i) * PR_P + d * 2);
            u32x4 o; o.x = e[0] | ((unsigned)e[1] << 16); o.y = e[2] | ((unsigned)e[3] << 16); o.z = e[4] | ((unsigned)e[5] << 16); o.w = e[6] | ((unsigned)e[7] << 16);
            *(u32x4*)((kv ? CB(c, WS_VT) : CB(c, WS_KT)) + hb + (size_t)ch * 16384 + (d >> 5) * 4096 + lg * 256 + (d & 31) * 8) = o;
        }
    }
    __syncthreads();
}

__device__ __forceinline__ void scan_job(int job, const Ctx& c) {
    const int lane = tid_opaque() & 63;
    const int S = c.S, nc = S >> 7;
    const int ch = job & (nc - 1), dir = (job >> c.lgn) & 1, h = (job >> (c.lgn + 1)) & 7, seq = job >> (c.lgn + 4);
    const size_t rowbase = (size_t)seq * S; const int t0 = ch * 128;
    const int p0 = dir ? 127 - 2 * lane : 2 * lane, p1 = dir ? 126 - 2 * lane : 2 * lane + 1;
    const float* r0 = CF(c, WS_IF) + (rowbase + t0 + p0) * 32 + dir * 16 + h; const float* r1 = CF(c, WS_IF) + (rowbase + t0 + p1) * 32 + dir * 16 + h;
    const float li0 = r0[0], lf0 = r0[8], li1 = r1[0], lf1 = r1[8];
    float s = lf0 + lf1;
#pragma unroll
    for (int o = 1; o < 64; o <<= 1) { const float y = shfl_u(s, lane, o); if (lane >= o) s += y; }
    const float b1 = s, b0 = s - lf1;
    const float a0 = li0 - b0, a1 = li1 - b1;
    float mx = fmaxf(a0, a1);
#pragma unroll
    for (int o = 1; o < 64; o <<= 1) { const float y = shfl_u(mx, lane, o); if (lane >= o) mx = fmaxf(mx, y); }
    float ex = shfl_u(mx, lane, 1); if (lane == 0) ex = -3.0e38f;
    const float cm0 = fmaxf(ex, a0), cm1 = mx;
    const size_t sb = (size_t)((seq * 8 + h) * 2 + dir) * S + t0;
    const float cmL = __int_as_float(__builtin_amdgcn_ds_bpermute(63 << 2, __float_as_int(cm1)));
    bf16_t* ea = CB(c, WS_EA);
    ea[sb + p0] = (bf16_t)(cvt_pk_bf16(fexp(a0 - cmL), 0.f) & 0xffffu); ea[sb + p1] = (bf16_t)(cvt_pk_bf16(fexp(a1 - cmL), 0.f) & 0xffffu);
    CF(c, WS_SA)[sb + p0] = a0 * 1.4426950408889634f; CF(c, WS_SA)[sb + p1] = a1 * 1.4426950408889634f;     CF(c, WS_SCM)[sb + p0] = cm0; CF(c, WS_SCM)[sb + p1] = cm1; CF(c, WS_SB)[sb + p0] = b0; CF(c, WS_SB)[sb + p1] = b1;
}

__device__ __forceinline__ void st_stage(LAS unsigned char* buf, const bf16_t* KTc, const bf16_t* VTc, int w, int lane) {
#pragma unroll
    for (int p = 0; p < 6; ++p) {
        const int piece = w * 6 + p;
        const char* src = piece < 32 ? (const char*)KTc + piece * 1024 : (const char*)VTc + (piece - 32) * 1024;
        __builtin_amdgcn_global_load_lds((const unsigned*)(src + lane * 16), (LAS unsigned*)(buf + piece * 1024), 16, 0, 0);
    }
}
__device__ __forceinline__ void mlstm_state_unit(LAS unsigned char* lds, int unit, const Ctx& c) {
    const int tid = tid_opaque(), lane = tid & 63, w = __builtin_amdgcn_readfirstlane(tid >> 6), l32 = lane & 31, hi = lane >> 5;
    const int S = c.S, nc = S >> 7;
    const int es = unit & 1, dir = (unit >> 1) & 1, h = (unit >> 2) & 7, seq = unit >> 5;
    const size_t hb = (size_t)(seq * 8 + h) * S * 128;
    const int chain = (seq * 8 + h) * 2 + dir;
    const size_t sbase = (size_t)chain * S;
    const int et = w >> 2, dt = w & 3;
    const bf16_t* KTg = CB(c, WS_KT) + hb; const bf16_t* VTg = CB(c, WS_VT) + hb + es * 8192;
    const bf16_t* EAl = CB(c, WS_EA) + sbase;
    const float* scm = CF(c, WS_SCM) + sbase; const float* sbv = CF(c, WS_SB) + sbase;
    bf16_t* CPl = CB(c, WS_CP) + (size_t)chain * nc * 16384 + (es * 2 + et) * 4096 + dt * 1024 + l32 * 8 + 4 * hi;
    bf16_t* NPl = CB(c, WS_NP) + (size_t)chain * nc * 128 + dt * 32 + 4 * hi;
    float* MPl = CF(c, WS_MP) + (size_t)chain * nc;
    const int plast = dir ? 0 : 127;
    const int kofs = dt * 8192 + hi * 512 + l32 * 16, vofs = 32768 + et * 8192 + hi * 512 + l32 * 16;
    f32x16 Cacc, nacc;
#pragma unroll
    for (int r = 0; r < 16; ++r) { Cacc[r] = 0.f; nacc[r] = 0.f; }
    float m_prev = -1e30f;
    u32x4 ea[8]; float cmLn, bLn;
    { const int ch0 = dir ? nc - 1 : 0;
      st_stage(lds, KTg + (size_t)ch0 * 16384, VTg + (size_t)ch0 * 16384, w, lane);
#pragma unroll
      for (int s = 0; s < 8; ++s) ea[s] = *(const u32x4*)(EAl + ch0 * 128 + 16 * s + 8 * hi);
      cmLn = scm[ch0 * 128 + plast]; bLn = sbv[ch0 * 128 + plast]; }
#pragma unroll 1
    for (int step = 0; step < nc; ++step) {
        const int ch = dir ? nc - 1 - step : step;
        const int sn = step + 1 < nc ? step + 1 : step; const int chn = dir ? nc - 1 - sn : sn;
        asm volatile("s_waitcnt vmcnt(0)" ::: "memory"); __syncthreads();
        const LAS unsigned char* buf = lds + (step & 1) * 49152;
        if (step + 1 < nc) st_stage(lds + ((step + 1) & 1) * 49152, KTg + (size_t)chn * 16384, VTg + (size_t)chn * 16384, w, lane);
        const bf16_t* EAn = EAl + chn * 128 + 8 * hi;
#pragma unroll
        for (int rg = 0; rg < 4; ++rg) { u32x2 o; o.x = cvt_pk_bf16(Cacc[4 * rg + 0], Cacc[4 * rg + 1]); o.y = cvt_pk_bf16(Cacc[4 * rg + 2], Cacc[4 * rg + 3]); *(u32x2*)(CPl + (size_t)ch * 16384 + 256 * rg) = o; }
        if (es == 0 && et == 0 && l32 == 0) {
#pragma unroll
            for (int rg = 0; rg < 4; ++rg) { u32x2 o; o.x = cvt_pk_bf16(nacc[4 * rg + 0], nacc[4 * rg + 1]); o.y = cvt_pk_bf16(nacc[4 * rg + 2], nacc[4 * rg + 3]); *(u32x2*)(NPl + (size_t)ch * 128 + 8 * rg) = o; }
            if (dt == 0 && hi == 0) MPl[ch] = m_prev;
        }
        const float cmL = cmLn, bL = bLn;
        cmLn = scm[chn * 128 + plast]; bLn = sbv[chn * 128 + plast];
        const float M_last = fmaxf(m_prev, cmL);
        const float w_c = fexp(m_prev - M_last), w_d = fexp(cmL - M_last);
        f32x16 dC, dn;
#pragma unroll
        for (int r = 0; r < 16; ++r) { dC[r] = 0.f; dn[r] = 0.f; }
#pragma unroll
        for (int s = 0; s < 8; ++s) {
            const bf16x8 kt = *(const LAS bf16x8*)(buf + kofs + s * 1024);
            const u32x4 vw = *(const LAS u32x4*)(buf + vofs + s * 1024), ew = ea[s];
            u32x4 bw; bw.x = cvt_pk_bf16(bflo(vw.x) * bflo(ew.x), bfhi(vw.x) * bfhi(ew.x)); bw.y = cvt_pk_bf16(bflo(vw.y) * bflo(ew.y), bfhi(vw.y) * bfhi(ew.y));
            bw.z = cvt_pk_bf16(bflo(vw.z) * bflo(ew.z), bfhi(vw.z) * bfhi(ew.z)); bw.w = cvt_pk_bf16(bflo(vw.w) * bflo(ew.w), bfhi(vw.w) * bfhi(ew.w));
            dC = MFMA32(kt, __builtin_bit_cast(bf16x8, bw), dC);
            if (et == 0) dn = MFMA32(kt, __builtin_bit_cast(bf16x8, ew), dn);
            ea[s] = *(const u32x4*)(EAn + 16 * s);
        }
#pragma unroll
        for (int r = 0; r < 16; ++r) { Cacc[r] = w_c * Cacc[r] + w_d * dC[r]; nacc[r] = w_c * nacc[r] + w_d * dn[r]; }
        m_prev = bL + M_last;
    }
    asm volatile("s_waitcnt vmcnt(0)" ::: "memory"); __syncthreads();
}

__device__ __forceinline__ void out_stage(LAS unsigned char* buf, int unit, const Ctx& c, int w, int lane) {
    const int S = c.S, nc = S >> 7;
    const int ch = unit & (nc - 1), h = (unit >> c.lgn) & 7, seq = unit >> (c.lgn + 3);
    const size_t hb = (size_t)(seq * 8 + h) * S * 128 + (size_t)ch * 16384;
    const char* q = (const char*)(CB(c, WS_QC) + hb); const char* k = (const char*)(CB(c, WS_KC) + hb);
#pragma unroll
    for (int p = 0; p < 4; ++p) {
        const int piece = w * 4 + p;
        __builtin_amdgcn_global_load_lds((const unsigned*)(q + piece * 1024 + lane * 16), (LAS unsigned*)(buf + piece * 1024), 16, 0, 0);
        __builtin_amdgcn_global_load_lds((const unsigned*)(k + piece * 1024 + lane * 16), (LAS unsigned*)(buf + 32768 + piece * 1024), 16, 0, 0);
    }
}
__device__ __forceinline__ void mlstm_out_unit(const LAS unsigned char* buf, LAS float* xch, int unit, const Ctx& c, const float* mg) {
    const int tid = tid_opaque(), lane = tid & 63, w = __builtin_amdgcn_readfirstlane(tid >> 6), l32 = lane & 31, hi = lane >> 5;
    const int S = c.S, nc = S >> 7;
    const int ch = unit & (nc - 1), h = (unit >> c.lgn) & 7, seq = unit >> (c.lgn + 3);
    const size_t hb = (size_t)(seq * 8 + h) * S * 128;
    const int t0 = ch * 128;
    const int it = w & 3, ep = w >> 2;
    const int i = it * 32 + l32;
    const LAS unsigned char* Ql = buf + hi * 512 + l32 * 16; const LAS unsigned char* Kl = buf + 32768 + hi * 512 + l32 * 16;
    const bf16_t* VTl = CB(c, WS_VT) + hb + (size_t)ch * 16384 + (2 * ep) * 4096;
    const unsigned vlo = (unsigned)(l32 * 8 + 4 * hi), clo = (unsigned)(hi * 256 + l32 * 8), nlo = (unsigned)(8 * hi), alo = (unsigned)(4 * hi);
    bf16x8 qf[8];
#pragma unroll
    for (int s = 0; s < 8; ++s) qf[s] = *(const LAS bf16x8*)(Ql + it * 8192 + s * 1024);
    float hsum[2][16];
#pragma unroll
    for (int r = 0; r < 16; ++r) { hsum[0][r] = 0.f; hsum[1][r] = 0.f; }
#pragma unroll 1
    for (int dir = 0; dir < 2; ++dir) {
        const int chain = (seq * 8 + h) * 2 + dir;
        const size_t sbase = (size_t)chain * S + t0;
        const bf16_t* CPl = CB(c, WS_CP) + ((size_t)chain * nc + ch) * 16384 + (2 * ep) * 4096;
        const bf16_t* NPl = CB(c, WS_NP) + ((size_t)chain * nc + ch) * 128;
        const float* sa = CF(c, WS_SA) + sbase;
        const int jlo = dir ? it : 0, jhi = dir ? 3 : it;
        const float m_prev = CF(c, WS_MP)[(size_t)chain * nc + ch];
        const float cm_i = (CF(c, WS_SCM) + sbase)[(unsigned)i], b_i = (CF(c, WS_SB) + sbase)[(unsigned)i];
        const float M_i = fmaxf(m_prev, cm_i); const float w_i = fexp(m_prev - M_i); const float M_i2 = M_i * 1.4426950408889634f;
        f32x16 ainta, aintb, aqn, anuma, anumb;
#pragma unroll
        for (int r = 0; r < 16; ++r) { ainta[r] = 0.f; aintb[r] = 0.f; aqn[r] = 0.f; anuma[r] = 0.f; anumb[r] = 0.f; }
        float rsum = 0.f;
        f32x16 pc;
#pragma unroll
        for (int r = 0; r < 16; ++r) pc[r] = 0.f;
#pragma unroll
        for (int s = 0; s < 8; ++s) { const bf16x8 kf = *(const LAS bf16x8*)(Kl + jlo * 8192 + s * 1024); pc = MFMA32(kf, qf[s], pc); }
#pragma unroll 1
        for (int jt = jlo; jt <= jhi; ++jt) {
            u32x2 vlc[2][2], vhc[2][2]; f32x4 avc[4];
#pragma unroll
            for (int e2 = 0; e2 < 2; ++e2)
#pragma unroll
                for (int s2 = 0; s2 < 2; ++s2) { const unsigned vo = vlo + (unsigned)(e2 * 4096 + (4 * jt + 2 * s2) * 256); vlc[e2][s2] = *(const u32x2*)(VTl + vo); vhc[e2][s2] = *(const u32x2*)(VTl + (vo + 256u)); }
#pragma unroll
            for (int rg = 0; rg < 4; ++rg) avc[rg] = *(const f32x4*)(sa + (alo + (unsigned)(jt * 32 + 8 * rg)));
            const int jn = jt < jhi ? jt + 1 : jt;
            f32x16 pn;
#pragma unroll
            for (int r = 0; r < 16; ++r) pn[r] = 0.f;
#pragma unroll
            for (int s = 0; s < 8; ++s) { const bf16x8 kf = *(const LAS bf16x8*)(Kl + jn * 8192 + s * 1024); pn = MFMA32(kf, qf[s], pn); }
            f32x16 p = pc;
            if (jt == it) {
#pragma unroll
                for (int r = 0; r < 16; ++r) { const int jr = crow(r, hi);
                    const bool valid = dir ? (jr >= l32) : (jr <= l32);
                    const float dg = valid ? __builtin_amdgcn_exp2f(avc[r >> 2][r & 3] - M_i2) : 0.f; p[r] *= dg; rsum += p[r]; }
            } else {
#pragma unroll
                for (int r = 0; r < 16; ++r) { p[r] *= __builtin_amdgcn_exp2f(avc[r >> 2][r & 3] - M_i2); rsum += p[r]; }
            }
#pragma unroll
            for (int s2 = 0; s2 < 2; ++s2) {
                u32x4 bw; bw.x = cvt_pk_bf16(p[8 * s2 + 0], p[8 * s2 + 1]); bw.y = cvt_pk_bf16(p[8 * s2 + 2], p[8 * s2 + 3]); bw.z = cvt_pk_bf16(p[8 * s2 + 4], p[8 * s2 + 5]); bw.w = cvt_pk_bf16(p[8 * s2 + 6], p[8 * s2 + 7]);
                u32x4 aw; aw.x = vlc[0][s2].x; aw.y = vlc[0][s2].y; aw.z = vhc[0][s2].x; aw.w = vhc[0][s2].y;
                anuma = MFMA32(__builtin_bit_cast(bf16x8, aw), __builtin_bit_cast(bf16x8, bw), anuma);
                u32x4 cw; cw.x = vlc[1][s2].x; cw.y = vlc[1][s2].y; cw.z = vhc[1][s2].x; cw.w = vhc[1][s2].y;
                anumb = MFMA32(__builtin_bit_cast(bf16x8, cw), __builtin_bit_cast(bf16x8, bw), anumb);
            }
            pc = pn;
        }
        {
            bf16x8 cfa[8], nf[8];
#pragma unroll
            for (int s = 0; s < 8; ++s) { cfa[s] = *(const bf16x8*)(CPl + (clo + 512u * s)); nf[s] = *(const bf16x8*)(NPl + (nlo + 16u * s)); }
#pragma unroll
        for (int s = 0; s < 8; ++s) { ainta = MFMA32(cfa[s], qf[s], ainta); aqn = MFMA32(nf[s], qf[s], aqn); }
        }
        asm volatile("" ::: "memory");
        {
            bf16x8 cfb[8];
#pragma unroll
            for (int s = 0; s < 8; ++s) cfb[s] = *(const bf16x8*)(CPl + (clo + 4096u + 512u * s));
#pragma unroll
            for (int s = 0; s < 8; ++s) aintb = MFMA32(cfb[s], qf[s], aintb);
        }
        asm volatile("" ::: "memory");
        const float qn = aqn[0];
        rsum += shfl_x(rsum, lane, 32);
        const float den = w_i * qn + rsum;
        const float dd = fmaxf(fabsf(den), fexp(-(b_i + M_i)));
        const float inv = __builtin_amdgcn_rcpf(dd);
#pragma unroll
        for (int r = 0; r < 16; ++r) { hsum[0][r] += (w_i * ainta[r] + anuma[r]) * inv; hsum[1][r] += (w_i * aintb[r] + anumb[r]) * inv; }
    }
    int h2 = h; asm volatile("" : "+s"(h2));
    const size_t ob = ((size_t)seq * S + t0) * 1024 + h2 * 128 + (2 * ep) * 32; const unsigned oo = (unsigned)(i * 1024 + 4 * hi);
    bf16_t* MOb = CB(c, WS_MO) + ob; bf16_t* MZb = CB(c, WS_MZ) + ob; const float* mgb = mg + h2 * 128 + (2 * ep) * 32;
    u32x2 ow[2][4], zw[2][4];
#pragma unroll
    for (int e2 = 0; e2 < 2; ++e2)
#pragma unroll
        for (int rg = 0; rg < 4; ++rg) { ow[e2][rg] = *(const u32x2*)(MOb + (oo + (unsigned)(e2 * 32 + 8 * rg))); zw[e2][rg] = *(const u32x2*)(MZb + (oo + (unsigned)(e2 * 32 + 8 * rg))); }
    float ss = 0.f;
#pragma unroll
    for (int e2 = 0; e2 < 2; ++e2)
#pragma unroll
        for (int rg = 0; rg < 4; ++rg) { hsum[e2][4 * rg + 0] *= bflo(ow[e2][rg].x); hsum[e2][4 * rg + 1] *= bfhi(ow[e2][rg].x); hsum[e2][4 * rg + 2] *= bflo(ow[e2][rg].y); hsum[e2][4 * rg + 3] *= bfhi(ow[e2][rg].y);
            ss += (hsum[e2][4 * rg + 0] * hsum[e2][4 * rg + 0] + hsum[e2][4 * rg + 1] * hsum[e2][4 * rg + 1]) + (hsum[e2][4 * rg + 2] * hsum[e2][4 * rg + 2] + hsum[e2][4 * rg + 3] * hsum[e2][4 * rg + 3]); }
    ss += shfl_x(ss, lane, 32);
    if (hi == 0) xch[(it * 2 + ep) * 32 + l32] = ss;
    __syncthreads();
    const float tot = xch[(it * 2) * 32 + l32] + xch[(it * 2 + 1) * 32 + l32];
    const float rs = __builtin_amdgcn_rsqf(tot * (1.f / 128.f) + NORM_EPS);
#pragma unroll
    for (int e2 = 0; e2 < 2; ++e2)
#pragma unroll
        for (int rg = 0; rg < 4; ++rg) { const f32x4 gv = *(const f32x4*)(mgb + (alo + (unsigned)(e2 * 32 + 8 * rg)));
            u32x2 o; o.x = cvt_pk_bf16(hsum[e2][4 * rg + 0] * rs * gv[0] * bflo(zw[e2][rg].x), hsum[e2][4 * rg + 1] * rs * gv[1] * bfhi(zw[e2][rg].x));
            o.y = cvt_pk_bf16(hsum[e2][4 * rg + 2] * rs * gv[2] * bflo(zw[e2][rg].y), hsum[e2][4 * rg + 3] * rs * gv[3] * bfhi(zw[e2][rg].y));
            *(u32x2*)(MZb + (oo + (unsigned)(e2 * 32 + 8 * rg))) = o; }
}

__device__ __forceinline__ void post_phase(const Ctx& c, const float* mg) {
    const int tid = tid_opaque(); const int lane = tid & 63, wave = tid >> 6;
    const int gw = blockIdx.x * 8 + wave, NGW = gridDim.x * 8;
    f32x4 gv[4];
#pragma unroll
    for (int j = 0; j < 4; ++j) gv[j] = *(const f32x4*)(mg + lane * 16 + 4 * j);
    for (int m = gw; m < GM; m += NGW) {
        const size_t off = (size_t)m * 1024 + lane * 16;
        const u32x4 ow0 = *(const u32x4*)(CB(c, WS_MO) + off), ow1 = *(const u32x4*)(CB(c, WS_MO) + off + 8);
        const u32x4 zw0 = *(const u32x4*)(CB(c, WS_MZ) + off), zw1 = *(const u32x4*)(CB(c, WS_MZ) + off + 8);
        const unsigned ow[8] = {ow0.x, ow0.y, ow0.z, ow0.w, ow1.x, ow1.y, ow1.z, ow1.w}, zw[8] = {zw0.x, zw0.y, zw0.z, zw0.w, zw1.x, zw1.y, zw1.z, zw1.w};
        float v[16]; float ss = 0.f;
        const u32x4 fa0 = *(const u32x4*)(CB(c, WS_HF) + off), fa1 = *(const u32x4*)(CB(c, WS_HF) + off + 8);
        const unsigned fa[8] = {fa0.x, fa0.y, fa0.z, fa0.w, fa1.x, fa1.y, fa1.z, fa1.w};
#pragma unroll
        for (int e = 0; e < 16; ++e) { const float og = (e & 1) ? bfhi(ow[e >> 1]) : bflo(ow[e >> 1]); const float hs = (e & 1) ? bfhi(fa[e >> 1]) : bflo(fa[e >> 1]); v[e] = og * hs; ss += v[e] * v[e]; }
        ss += shfl_x(ss, lane, 1); ss += shfl_x(ss, lane, 2); ss += shfl_x(ss, lane, 4);
        const float rs = __builtin_amdgcn_rsqf(ss * (1.f / 128.f) + NORM_EPS);
        unsigned o[8];
#pragma unroll
        for (int e = 0; e < 16; e += 2) { const float y0 = v[e] * rs * gv[e >> 2][e & 3] * bflo(zw[e >> 1]), y1 = v[e + 1] * rs * gv[e >> 2][(e + 1) & 3] * bfhi(zw[e >> 1]); o[e >> 1] = cvt_pk_bf16(y0, y1); }
        u32x4 s0, s1; s0.x = o[0]; s0.y = o[1]; s0.z = o[2]; s0.w = o[3]; s1.x = o[4]; s1.y = o[5]; s1.z = o[6]; s1.w = o[7];
        *(u32x4*)(CB(c, WS_MZ) + off) = s0; *(u32x4*)(CB(c, WS_MZ) + off + 8) = s1;
    }
}


typedef const Args __attribute__((address_space(4)))* KArgsP;
__device__ __forceinline__ KArgsP kargs() { unsigned long long p = (unsigned long long)__builtin_amdgcn_kernarg_segment_ptr(); asm volatile("" : "+s"(p)); return (KArgsP)p; }
#define XB_TMO      128
#define XB_XCNT(j)  (256  + 64 * (j))
#define XB_XSUB(j)  (1280 + 64 * (j))
#define XB_XGEN(j)  (2304 + 64 * (j))
#define XB_TOP      3328
#define XB_TOPGEN   3392
#define XCD_BAR_WORDS 3456
#define XB_SPIN_CAP (1u << 20)
__device__ __forceinline__ unsigned xb_ld(unsigned* p)              { return __hip_atomic_load(p, __ATOMIC_RELAXED, __HIP_MEMORY_SCOPE_AGENT); }
__device__ __forceinline__ unsigned xb_add(unsigned* p, unsigned v) { return __hip_atomic_fetch_add(p, v, __ATOMIC_RELAXED, __HIP_MEMORY_SCOPE_AGENT); }
__device__ __forceinline__ unsigned xb_xcc_id() { return (unsigned)__builtin_amdgcn_s_getreg((3 << 11) | 20) & 0xFu; }
#define XB_SPIN(cond, bar) do { unsigned _sp = 0; while (cond) { __builtin_amdgcn_s_sleep(1); \
    if ((++_sp & 255u) == 0u) { if (xb_ld(&(bar)[XB_TMO])) break; if (_sp > XB_SPIN_CAP) { atomicAdd(&(bar)[XB_TMO], 1u); break; } } } } while (0)
struct XcdBarrier { unsigned* bar; unsigned x; volatile LAS unsigned* st; };
__device__ __forceinline__ XcdBarrier xcd_barrier_post(unsigned* bar, volatile LAS unsigned* st) {
    XcdBarrier b; b.bar = bar; b.x = xb_xcc_id(); b.st = st;
    if (threadIdx.x == 0) (void)xb_add(&bar[XB_XCNT(b.x)], 1u);
    return b;
}
__device__ __forceinline__ void xcd_barrier_complete(unsigned* bar, unsigned x, unsigned& nloc, unsigned& nx) {
    const unsigned G = gridDim.x * gridDim.y * gridDim.z;
    unsigned sum, cnt, mine, sp = 0u;
    for (;;) {
        sum = 0u; cnt = 0u; mine = 0u;
#pragma unroll
        for (unsigned j = 0; j < 16; ++j) { const unsigned c = xb_ld(&bar[XB_XCNT(j)]); sum += c; cnt += (c > 0u) ? 1u : 0u; mine = (j == x) ? c : mine; }
        if (sum == G) break;
        __builtin_amdgcn_s_sleep(1);
        if ((++sp & 255u) == 0u) { if (xb_ld(&bar[XB_TMO])) break; if (sp > XB_SPIN_CAP) { atomicAdd(&bar[XB_TMO], 1u); break; } }
    }
    nloc = mine > 0u ? mine : 1u; nx = cnt > 0u ? cnt : 1u;
}
__device__ __forceinline__ void xcd_barrier(LAS unsigned char* lds) {
    XcdBarrier b; b.bar = (unsigned*)(kargs()->ws + WS_BAR); b.x = xb_xcc_id(); b.st = (volatile LAS unsigned*)(lds + 131072 + 256);
    asm volatile("s_waitcnt vmcnt(0)" ::: "memory");
    __syncthreads();
    if (tid_opaque() == 0) {
        unsigned* bar = b.bar;
        __builtin_amdgcn_s_waitcnt(0);
        unsigned nloc = b.st[0], nx = b.st[1];
        if (nloc == 0u) { xcd_barrier_complete(bar, b.x, nloc, nx); b.st[0] = nloc; b.st[1] = nx; }
        const unsigned old = xb_add(&bar[XB_XSUB(b.x)], 1u);
        const unsigned gen = old / nloc;
        if (old + 1u == (gen + 1u) * nloc) {
            __builtin_amdgcn_fence(__ATOMIC_RELEASE, "agent");
            asm volatile("s_waitcnt vmcnt(0)" ::: "memory");
            const unsigned og = xb_add(&bar[XB_TOP], 1u);
            const unsigned tg = og / nx;
            if (og + 1u == (tg + 1u) * nx) xb_add(&bar[XB_TOPGEN], 1u);
            else XB_SPIN(xb_ld(&bar[XB_TOPGEN]) == tg, bar);
            __builtin_amdgcn_fence(__ATOMIC_ACQUIRE, "agent");
            xb_add(&bar[XB_XGEN(b.x)], 1u);
            asm volatile("s_waitcnt vmcnt(0)" ::: "memory");
        } else {
            XB_SPIN(xb_ld(&bar[XB_XGEN(b.x)]) == gen, bar);
            __builtin_amdgcn_fence(__ATOMIC_ACQUIRE, "agent");
            asm volatile("s_waitcnt vmcnt(0)" ::: "memory");
        }
    }
    __syncthreads();
}

__device__ __forceinline__ Ctx make_ctx(int gi, int l) {
    KArgsP ka = kargs();
    Ctx c; c.S = gi == 0 ? 4096 : 2048; c.nseq = gi == 0 ? 4 : 8; c.lgn = gi == 0 ? 5 : 4; c.ws = ka->ws;
    float* outg = ka->out + (size_t)(unsigned)gi * (size_t)(GM * DM);
    const float* x0 = gi == 0 ? ka->x_prompt : (gi == 1 ? ka->x_sample : ka->x_sample + (size_t)GM * DM);
    c.xout = outg; c.xin = l == 0 ? x0 : outg;
    return c;
}

__global__ void __launch_bounds__(512, 2) fwd_megakernel(Args a_unused) {
    extern __shared__ __attribute__((aligned(16))) unsigned char lds_raw[];
    LAS unsigned char* lds = (LAS unsigned char*)lds_raw;
    cg::grid_group grid = cg::this_grid();

    prologue(kargs(), lds);
    {
        unsigned* bw = (unsigned*)(kargs()->ws + WS_BAR);
        if (blockIdx.x == 0) for (int i = threadIdx.x; i < XCD_BAR_WORDS; i += 512) bw[i] = 0u;
        if (threadIdx.x < 2) ((volatile LAS unsigned*)(lds + 131072 + 256))[threadIdx.x] = 0u;
    }
    grid.sync();
    (void)xcd_barrier_post((unsigned*)(kargs()->ws + WS_BAR), (volatile LAS unsigned*)(lds + 131072 + 256));

#pragma unroll 1
#ifdef TEST_NOLOOP
    for (int gi = 0; gi < 1; ++gi) {
#else
    for (int gi = 0; gi < 3; ++gi) {
#endif
#pragma unroll 1
#ifdef TEST_NOLOOP
        for (int l = 0; l < 1; ++l) {
#else
        for (int l = 0; l < DEPTH; ++l) {
#endif
            if (l == 0 && gi == 0) { const Ctx c = make_ctx(gi, l); norm_phase(c); xcd_barrier(lds); }
            {
                const Ctx c = make_ctx(gi, l); KArgsP ka = kargs(); unsigned char* ws = c.ws;
                pg8::Gemm g{CB(c, WS_XN), (const bf16_t*)(ws + WS_WIN + l * WIN_BYTES), GM, NPHYS, DM}; pg8::StaticOrder So; So.init(GM, NPHYS, gridDim.x, blockIdx.x);
                EpiProj E{ws, (const float*)(ws + WS_BIAS) + l * NPHYS};
#ifndef NO_P2
                pg8::gemm_phase<EpiProj, pg8::StaticOrder, true, false>(lds, g, So, E);
#endif
            }
            xcd_barrier(lds);
            {
                const Ctx c = make_ctx(gi, l); KArgsP ka = kargs();
                const int G = gridDim.x, bid = blockIdx.x, wave = tid_opaque() >> 6;
                knorm_rows(c, ka->k_norm_g + l * 64);
#ifndef NO_P3B
                for (int u = bid; u < 1024; u += G) prep_unit(lds, u, c, ka->conv_w + (size_t)l * 3 * 2048);
#endif
                for (int j = bid * 8 + wave; j < 2048; j += G * 8) scan_job(j, c);
            }
            xcd_barrier(lds);
            {
                const Ctx c = make_ctx(gi, l); KArgsP ka = kargs();
                const int nu = c.nseq * 32;
                const float mb = ((const float*)(c.ws + WS_MB))[l];
#ifndef NO_P3A
                if (nu == 128 && gridDim.x == 256) {
                    const int b = blockIdx.x;
                    if (b < 128) attn_unit(lds, b, c, ka->sink + l * 16, mb, CB(c, WS_Q), ka->q_norm_g + l * 64);
                    else for (int k = 0; k < 3; ++k) attn_unit(lds, 128 + (b - 128) * 3 + k, c, ka->sink + l * 16, mb, CB(c, WS_Q), ka->q_norm_g + l * 64);
                } else {
                    for (int u = blockIdx.x; u < 512; u += gridDim.x) attn_unit(lds, u, c, ka->sink + l * 16, mb, CB(c, WS_Q), ka->q_norm_g + l * 64);
                }
#endif
#ifndef NO_P4
                for (int u = blockIdx.x; u < nu; u += gridDim.x) mlstm_state_unit(lds, u, c);
#endif
            }
            xcd_barrier(lds);
            {
                const Ctx c = make_ctx(gi, l);
#ifndef NO_P4
                const int tid = tid_opaque(), w = tid >> 6, lane = tid & 63;
                const float* mgp = kargs()->m_norm_g + l * DM;
                int u = blockIdx.x, k = 0;
                if (u < 1024) out_stage(lds, u, c, w, lane);
                for (; u < 1024; u += gridDim.x, ++k) {
                    asm volatile("s_waitcnt vmcnt(0)" ::: "memory"); __syncthreads();
                    const int un = u + gridDim.x;
                    if (un < 1024) out_stage(lds + ((k + 1) & 1) * 65536, un, c, w, lane);
                    mlstm_out_unit(lds + (k & 1) * 65536, (LAS float*)(lds + 131072 + 1024), u, c, mgp);
                }
                asm volatile("s_waitcnt vmcnt(0)" ::: "memory"); __syncthreads();
#endif
            }
            xcd_barrier(lds);
            {
                const Ctx c = make_ctx(gi, l); unsigned char* ws = c.ws;
                pg8::StaticOrder So; So.init(GM, DM, gridDim.x, blockIdx.x);
                { pg8::Gemm g{CB(c, WS_Q), (const bf16_t*)(ws + WS_WA + (size_t)l * DM * DM * 2), GM, DM, DM}; EpiGate<0> E{CB(c, WS_GT), CB(c, WS_T), CB(c, WS_MG)};
#ifndef NO_P6
                  pg8::gemm_phase<EpiGate<0>, pg8::StaticOrder, true, true>(lds, g, So, E);
#endif
                }
            }
            {
                const Ctx c = make_ctx(gi, l); unsigned char* ws = c.ws;
                pg8::StaticOrder So; So.init(GM, DM, gridDim.x, blockIdx.x);
                { pg8::Gemm g{CB(c, WS_MZ), (const bf16_t*)(ws + WS_WM + (size_t)l * DM * DM * 2), GM, DM, DM}; EpiGate<1> E{CB(c, WS_GT), CB(c, WS_T), CB(c, WS_MG)};
#ifndef NO_P6
                  pg8::gemm_phase<EpiGate<1>, pg8::StaticOrder, true, true>(lds, g, So, E);
#endif
                }
            }
            xcd_barrier(lds);
            {
                const Ctx c = make_ctx(gi, l); unsigned char* ws = c.ws;
                pg8::StaticOrder So; So.init(GM, DM, gridDim.x, blockIdx.x);
                pg8::Gemm g{CB(c, WS_MG), (const bf16_t*)(ws + WS_WO + (size_t)l * DM * DM * 2), GM, DM, DM}; EpiRes E{c.xin, c.xout, CB(c, WS_XN), CF(c, WS_RS), (LAS float*)(lds + 131072 + 4096), l < DEPTH - 1 ? 1 : 0};
#ifndef NO_P7
                pg8::gemm_phase<EpiRes, pg8::StaticOrder, true, true>(lds, g, So, E);
#endif
            }
            if (l == DEPTH - 1 && gi < 2) { const Ctx cn = make_ctx(gi + 1, 0); norm_phase(cn); }
            xcd_barrier(lds);
        }
    }
}

extern "C" void kernel_launch(void* const* d_in, const int* in_sizes, int n_in, void* d_out, int out_size, void* d_ws, size_t ws_size, hipStream_t stream) {
    static int grid = 0;
    if (grid == 0) {
        if (n_in != 13 || ws_size < WS_END) { fprintf(stderr, "kernel_launch: need 13 inputs and >= %zu bytes of workspace (got %d, %zu)\n", (size_t)WS_END, n_in, ws_size); grid = -1; return; }
        int dev = 0, cus = 0, per_cu = 0;
        hipGetDevice(&dev);
        hipDeviceGetAttribute(&cus, hipDeviceAttributeMultiprocessorCount, dev);
        if (hipFuncSetAttribute((const void*)fwd_megakernel, hipFuncAttributeMaxDynamicSharedMemorySize, LDS_BYTES) != hipSuccess) { fprintf(stderr, "kernel_launch: hipFuncSetAttribute failed\n"); grid = -1; return; }
        if (hipOccupancyMaxActiveBlocksPerMultiprocessor(&per_cu, (const void*)fwd_megakernel, 512, LDS_BYTES) != hipSuccess || per_cu < 1) { fprintf(stderr, "kernel_launch: occupancy query failed (%d)\n", per_cu); per_cu = 1; }
        (void)hipGetLastError();
        grid = cus;
    }
    if (grid < 0) return;
    Args a{};
    a.x_prompt = (const float*)d_in[0]; a.x_sample = (const float*)d_in[1]; a.norm_g = (const float*)d_in[2]; a.w_in = (const float*)d_in[3]; a.b_in = (const float*)d_in[4];
    a.q_norm_g = (const float*)d_in[5]; a.k_norm_g = (const float*)d_in[6]; a.sink = (const float*)d_in[7]; a.conv_w = (const float*)d_in[8]; a.m_norm_g = (const float*)d_in[9];
    a.w_att_out = (const float*)d_in[10]; a.w_m_out = (const float*)d_in[11]; a.w_out = (const float*)d_in[12];
    a.out = (float*)d_out; a.ws = (unsigned char*)d_ws;
    void* args[] = {&a};
    hipError_t e = hipLaunchCooperativeKernel((const void*)fwd_megakernel, dim3(grid), dim3(512), args, LDS_BYTES, stream);
    if (e != hipSuccess) fprintf(stderr, "kernel_launch: cooperative launch failed: %s (grid %d)\n", hipGetErrorString(e), grid);
}
```

```cpp
#include <hip/hip_runtime.h>
#include <hip/hip_cooperative_groups.h>
#include <cstdio>
#include <cstdint>
namespace cg = cooperative_groups;

#define LAS __attribute__((address_space(3)))
typedef unsigned short bf16_t;
typedef short bf16x8 __attribute__((ext_vector_type(8)));
typedef float f32x4 __attribute__((ext_vector_type(4)));
typedef float f32x16 __attribute__((ext_vector_type(16)));
typedef unsigned u32x4 __attribute__((ext_vector_type(4)));
typedef unsigned u32x2 __attribute__((ext_vector_type(2)));

constexpr int DM = 1024, DEPTH = 4, IN_DIM = 9760, NPHYS = 9984, NTILE_IN = 39;
constexpr int GM = 16384;
constexpr float NORM_EPS = 1e-6f;
constexpr float KSCALE = 0.08838834764831845f;

constexpr size_t MiB = 1u << 20;
constexpr size_t WS_MB = 0, WS_BAR = 512 * 1024;
constexpr size_t WS_ROPE = 1 * MiB;
constexpr size_t WS_BIAS = 2 * MiB;
constexpr size_t WS_WIN = 3 * MiB;
constexpr size_t WIN_BYTES = (size_t)NPHYS * DM * 2;
constexpr size_t WS_WA = 81 * MiB, WS_WM = 89 * MiB, WS_WO = 97 * MiB;
constexpr size_t WS_AZ = 105 * MiB;
constexpr size_t WS_Q = 137 * MiB, WS_K = 169 * MiB, WS_V = 177 * MiB;
constexpr size_t WS_MQ = 185 * MiB, WS_MK = 217 * MiB, WS_MV = 249 * MiB, WS_XN = 281 * MiB;
constexpr size_t WS_MO = 313 * MiB, WS_MZ = 345 * MiB, WS_GT = 377 * MiB, WS_IF = 441 * MiB;
constexpr size_t WS_QC = 443 * MiB, WS_KC = 475 * MiB, WS_KT = 507 * MiB, WS_VT = 539 * MiB;
constexpr size_t WS_SA = 571 * MiB, WS_SCM = 572 * MiB, WS_SB = 573 * MiB;
constexpr size_t WS_EA = 574 * MiB, WS_NP = 575 * MiB, WS_MP = 575 * MiB + 768 * 1024, WS_RS = 576 * MiB, WS_END = 577 * MiB;
constexpr size_t WS_HF = WS_MQ, WS_HB = WS_MK;
constexpr size_t WS_CP = WS_MV;
constexpr size_t WS_T = WS_QC, WS_MG = WS_KC;

constexpr int LDS_BYTES = 147456;

typedef __bf16 bf16v2_t __attribute__((ext_vector_type(2)));
typedef float f32v2_t __attribute__((ext_vector_type(2)));
__device__ __forceinline__ unsigned cvt_pk_bf16(float lo, float hi) { const f32v2_t v = {lo, hi}; return __builtin_bit_cast(unsigned, __builtin_convertvector(v, bf16v2_t)); }
__device__ __forceinline__ float bflo(unsigned w) { return __uint_as_float(w << 16); }
__device__ __forceinline__ float bfhi(unsigned w) { return __uint_as_float(w & 0xffff0000u); }
__device__ __forceinline__ float fexp(float x) { return __builtin_amdgcn_exp2f(x * 1.4426950408889634f); }
__device__ __forceinline__ int crow(int r, int hi) { return (r & 3) + 8 * (r >> 2) + 4 * hi; }
__device__ __forceinline__ int tid_opaque() { int t = threadIdx.x; asm volatile("" : "+v"(t)); return t; }
__device__ __forceinline__ float shfl_x(float v, int lane, int m) { return __int_as_float(__builtin_amdgcn_ds_bpermute((lane ^ m) << 2, __float_as_int(v))); }
__device__ __forceinline__ float shfl_u(float v, int lane, int o) { int src = lane - o; src = src < 0 ? lane : src; return __int_as_float(__builtin_amdgcn_ds_bpermute(src << 2, __float_as_int(v))); }
#define MFMA32(a, b, c) __builtin_amdgcn_mfma_f32_32x32x16_bf16((a), (b), (c), 0, 0, 0)

namespace pg8 {
constexpr int BM = 256, BK = 64, HALF = 128, HTB = HALF * BK * 2, STAGE_BYTES = 8 * HTB, NXCD = 8, WGM = 8;
__host__ __device__ __forceinline__ int lds_byte(int r, int c) { const int st = (r >> 4) * 2 + (c >> 5), rr = r & 15, cc = c & 31, ob = rr * 64 + cc * 2; return st * 1024 + (ob ^ (((ob >> 9) & 1) << 5)); }
__host__ __device__ __forceinline__ void stage_rc(int b, int& R, int& C) { const int st = b / 1024, sb = b % 1024, swz = sb ^ (((sb >> 9) & 1) << 5); R = (st >> 1) * 16 + swz / 64; C = (st & 1) * 32 + (swz % 64) / 2; }
__host__ __device__ __forceinline__ int perm32(int rho) { const int n = rho >> 4, i = rho & 15; return 8 * (i >> 2) + 4 * n + (i & 3); }

struct Unit { int pm, pn; };
struct Gemm { const bf16_t* A; const bf16_t* Bt; int M, N, K; };

struct StaticOrder {
    int nM, nN, nwg, G, c;
    __host__ __device__ void init(int M, int N, int G_, int c_) { nM = M / BM; nN = N / BM; nwg = nM * nN; G = G_; c = c_; }
    __host__ __device__ bool next(int i, Unit& u) const {
        const long L = (long)i * G + c; if (L >= nwg) return false;
        int wgid = (int)L; { const int q = nwg / NXCD, r = nwg % NXCD, xcd = wgid % NXCD, off = wgid / NXCD; wgid = (xcd < r ? xcd * (q + 1) : r * (q + 1) + (xcd - r) * q) + off; }
        const int nig = WGM * nN, gid = wgid / nig, fm = gid * WGM, gsz = (nM - fm) < WGM ? (nM - fm) : WGM;
        u.pm = fm + ((wgid % nig) % gsz); u.pn = (wgid % nig) / gsz; return true;
    }
    __device__ __forceinline__ void a_ready(const Unit&) const {}
    __device__ __forceinline__ void done(const Unit&) const {}
};

template <class Epi, class Sched, bool ALIGN_EPI = false, bool SP2 = false>
__device__ __forceinline__ void gemm_phase(LAS unsigned char* lds, const Gemm g, const Sched& S, const Epi& E) {
    const int tid = tid_opaque(), wid = __builtin_amdgcn_readfirstlane(tid >> 6), lane = tid & 63, wr = wid >> 2, wc = wid & 3, fr = lane & 15, fq = lane >> 4;
    const int K = g.K, nt = K / BK;
    unsigned voffA[2], voffB[2];
#pragma unroll
    for (int i = 0; i < 2; ++i) { int R, C; stage_rc(tid * 16 + i * 8192, R, C); const int Rb = Epi::PERM ? ((R & ~31) + perm32(R & 31)) : R;
        voffA[i] = (unsigned)(R * K + C) * 2u; voffB[i] = (unsigned)(Rb * K + C) * 2u; }
    const size_t kstep = (size_t)(BK * 2);
    const size_t hstep = (size_t)HALF * K * 2;
    const size_t tstep = 2 * hstep;
    const unsigned ldsw = (unsigned)wid * 1024u;
    const int aoff = lds_byte(wr * 64 + fr, fq * 8), boff = lds_byte(wc * 32 + fr, fq * 8);
#define PG8_SA(b, h) (((b) * 2 + (h)) * HTB)
#define PG8_SB(b, h) ((4 + (b) * 2 + (h)) * HTB)
#define PG8_STAGE(bufoff, gbase, voff) do { _Pragma("unroll") for (int _i = 0; _i < 2; ++_i) \
        __builtin_amdgcn_global_load_lds((const unsigned*)((const char*)(gbase) + (voff)[_i]), (LAS unsigned*)(lds + (bufoff) + ldsw + _i * 8192), 16, 0, 0); } while (0)
#define PG8_LDA(dst, b, h) do { _Pragma("unroll") for (int m = 0; m < 4; ++m) _Pragma("unroll") for (int k = 0; k < 2; ++k) dst[m][k] = *(const LAS bf16x8*)(lds + PG8_SA(b, h) + aoff + m * 2048 + k * 1024); } while (0)
#define PG8_LDB(dst, b, h) do { _Pragma("unroll") for (int n = 0; n < 2; ++n) _Pragma("unroll") for (int k = 0; k < 2; ++k) dst[n][k] = *(const LAS bf16x8*)(lds + PG8_SB(b, h) + boff + n * 2048 + k * 1024); } while (0)
#define PG8_MMA(ai, bj, At, Bt) do { __builtin_amdgcn_s_setprio(1); _Pragma("unroll") for (int m = 0; m < 4; ++m) _Pragma("unroll") for (int n = 0; n < 2; ++n) _Pragma("unroll") for (int k = 0; k < 2; ++k) \
        acc[ai][bj][m][n] = __builtin_amdgcn_mfma_f32_16x16x32_bf16(Bt[n][k], At[m][k], acc[ai][bj][m][n], 0, 0, 0); __builtin_amdgcn_s_setprio(0); } while (0)
#define PG8_WAIT_V(n) asm volatile("s_waitcnt vmcnt(" #n ")" ::: "memory")
#define PG8_WAIT_L(n) asm volatile("s_waitcnt lgkmcnt(" #n ")" ::: "memory")
#define PG8_BAR __builtin_amdgcn_s_barrier()
#define PG8_SCHED __builtin_amdgcn_sched_barrier(0)
    Unit cur, nxt; int ui = 0;
    if (!S.next(0, cur)) return;
    f32x4 acc[2][2][4][2];
#pragma unroll
    for (int a = 0; a < 2; ++a)
#pragma unroll
        for (int b = 0; b < 2; ++b)
#pragma unroll
            for (int m = 0; m < 4; ++m)
#pragma unroll
                for (int n = 0; n < 2; ++n) acc[a][b][m][n] = (f32x4){0.f, 0.f, 0.f, 0.f};
    bf16x8 At[4][2], B0[2][2], B1[2][2];
    const char* cA = (const char*)g.A + (size_t)cur.pm * tstep; const char* cB = (const char*)g.Bt + (size_t)cur.pn * tstep;
    S.a_ready(cur);
    if constexpr (SP2) {
        PG8_STAGE(PG8_SB(0, 0), cB, voffB); PG8_STAGE(PG8_SB(0, 1), cB + hstep, voffB); PG8_STAGE(PG8_SA(0, 0), cA, voffA); PG8_STAGE(PG8_SA(0, 1), cA + hstep, voffA);
        if (wr == 1) PG8_BAR;
        PG8_WAIT_V(2); PG8_BAR;
        PG8_STAGE(PG8_SB(1, 0), cB + kstep, voffB); PG8_STAGE(PG8_SA(1, 0), cA + kstep, voffA); PG8_STAGE(PG8_SB(1, 1), cB + hstep + kstep, voffB);
        PG8_WAIT_V(6); PG8_BAR;
    } else {
        PG8_STAGE(PG8_SB(0, 0), cB, voffB); PG8_STAGE(PG8_SA(0, 0), cA, voffA); PG8_STAGE(PG8_SB(0, 1), cB + hstep, voffB); PG8_STAGE(PG8_SA(0, 1), cA + hstep, voffA);
        if (wr == 1) PG8_BAR;
        PG8_WAIT_V(4); PG8_BAR;
        PG8_STAGE(PG8_SB(1, 0), cB + kstep, voffB); PG8_STAGE(PG8_SA(1, 0), cA + kstep, voffA); PG8_STAGE(PG8_SB(1, 1), cB + hstep + kstep, voffB);
        PG8_WAIT_V(6); PG8_BAR;
    }
    for (;;) {
        const bool has_next = S.next(ui + 1, nxt);
        const char* nA = has_next ? (const char*)g.A + (size_t)nxt.pm * tstep : cA; const char* nB = has_next ? (const char*)g.Bt + (size_t)nxt.pn * tstep : cB;
        for (int t = 0; t < nt; t += 2) {
            const bool last = (t == nt - 2);
            const char* a1 = cA + (size_t)(t + 1) * kstep;
            const char* a2 = last ? nA : cA + (size_t)(t + 2) * kstep; const char* b2 = last ? nB : cB + (size_t)(t + 2) * kstep;
            const char* a3 = a2 + kstep; const char* b3 = b2 + kstep;
            if (last && has_next) S.a_ready(nxt);
            if constexpr (SP2) {
            PG8_LDB(B0, 0, 0); PG8_LDB(B1, 0, 1); PG8_SCHED; PG8_LDA(At, 0, 0); PG8_STAGE(PG8_SA(1, 1), a1 + hstep, voffA);
            PG8_WAIT_V(8); PG8_WAIT_L(0); PG8_BAR; PG8_MMA(0, 0, At, B0); PG8_MMA(0, 1, At, B1); PG8_BAR; PG8_SCHED;
            PG8_LDA(At, 0, 1); PG8_STAGE(PG8_SB(0, 0), b2, voffB); PG8_STAGE(PG8_SB(0, 1), b2 + hstep, voffB); PG8_STAGE(PG8_SA(0, 0), a2, voffA);
            PG8_WAIT_V(8); PG8_WAIT_L(0); PG8_BAR; PG8_MMA(1, 0, At, B0); PG8_MMA(1, 1, At, B1); PG8_BAR; PG8_SCHED;
            PG8_LDB(B0, 1, 0); PG8_LDB(B1, 1, 1); PG8_SCHED; PG8_LDA(At, 1, 0); PG8_STAGE(PG8_SA(0, 1), a2 + hstep, voffA);
            PG8_WAIT_V(8); PG8_WAIT_L(0); PG8_BAR; PG8_MMA(0, 0, At, B0); PG8_MMA(0, 1, At, B1); PG8_BAR; PG8_SCHED;
            PG8_LDA(At, 1, 1); PG8_STAGE(PG8_SB(1, 0), b3, voffB); PG8_STAGE(PG8_SB(1, 1), b3 + hstep, voffB); PG8_STAGE(PG8_SA(1, 0), a3, voffA);
            PG8_WAIT_V(8); PG8_WAIT_L(0); PG8_BAR; PG8_MMA(1, 0, At, B0); PG8_MMA(1, 1, At, B1); PG8_BAR; PG8_SCHED;
            } else {
            PG8_LDB(B0, 0, 0); PG8_SCHED; PG8_LDA(At, 0, 0); PG8_STAGE(PG8_SA(1, 1), a1 + hstep, voffA);
            PG8_WAIT_L(8); PG8_BAR; PG8_WAIT_L(0); PG8_MMA(0, 0, At, B0); PG8_BAR; PG8_SCHED;
            PG8_LDB(B1, 0, 1); PG8_STAGE(PG8_SB(0, 0), b2, voffB);
            PG8_BAR; PG8_WAIT_L(0); PG8_MMA(0, 1, At, B1); PG8_BAR;
            PG8_LDA(At, 0, 1); PG8_STAGE(PG8_SA(0, 0), a2, voffA);
            PG8_BAR; PG8_WAIT_L(0); PG8_MMA(1, 0, At, B0); PG8_BAR; PG8_SCHED;
            PG8_STAGE(PG8_SB(0, 1), b2 + hstep, voffB);
            PG8_WAIT_V(6); PG8_BAR; PG8_MMA(1, 1, At, B1); PG8_BAR;
            PG8_LDB(B0, 1, 0); PG8_SCHED; PG8_LDA(At, 1, 0); PG8_STAGE(PG8_SA(0, 1), a2 + hstep, voffA);
            PG8_WAIT_L(8); PG8_BAR; PG8_WAIT_L(0); PG8_MMA(0, 0, At, B0); PG8_BAR; PG8_SCHED;
            PG8_LDB(B1, 1, 1); PG8_STAGE(PG8_SB(1, 0), b3, voffB);
            PG8_BAR; PG8_WAIT_L(0); PG8_MMA(0, 1, At, B1); PG8_BAR;
            PG8_LDA(At, 1, 1); PG8_STAGE(PG8_SA(1, 0), a3, voffA);
            PG8_BAR; PG8_WAIT_L(0); PG8_MMA(1, 0, At, B0); PG8_BAR; PG8_SCHED;
            PG8_STAGE(PG8_SB(1, 1), b3 + hstep, voffB);
            PG8_WAIT_V(6); PG8_BAR; PG8_MMA(1, 1, At, B1); PG8_BAR;
            }
        }
        if constexpr (ALIGN_EPI) { if (wr == 0) PG8_BAR; }
        E(acc, cur, wr, wc, fr, fq); S.done(cur);
        if (!has_next) break;
#pragma unroll
        for (int a = 0; a < 2; ++a)
#pragma unroll
            for (int b = 0; b < 2; ++b)
#pragma unroll
                for (int m = 0; m < 4; ++m)
#pragma unroll
                    for (int n = 0; n < 2; ++n) acc[a][b][m][n] = (f32x4){0.f, 0.f, 0.f, 0.f};
        cur = nxt; cA = nA; cB = nB; ++ui;
        if constexpr (ALIGN_EPI) { if (wr == 1) PG8_BAR; }
    }
    PG8_WAIT_V(0);
    if constexpr (!ALIGN_EPI) { if (wr == 0) PG8_BAR; }
    PG8_BAR;
#undef PG8_SA
#undef PG8_SB
#undef PG8_STAGE
#undef PG8_LDA
#undef PG8_LDB
#undef PG8_MMA
#undef PG8_WAIT_V
#undef PG8_WAIT_L
#undef PG8_BAR
#undef PG8_SCHED
}
}

__device__ __forceinline__ float row_rscale(const float* rs, int row) {
    const f32x4 a = *(const f32x4*)(rs + (size_t)row * 4);
    return __builtin_amdgcn_rsqf(((a[0] + a[1]) + (a[2] + a[3])) * (1.f / DM) + NORM_EPS);
}

struct EpiProj {
    static constexpr bool PERM = true;
    unsigned char* ws; const float* bias;
    __device__ __forceinline__ void operator()(const f32x4 (&acc)[2][2][4][2], const pg8::Unit& u, int wr, int wc, int fr, int fq) const {
        const int pn = u.pn;
        const int row0 = u.pm * 256 + wr * 64 + fr;
        const int pc0 = pn * 256 + wc * 32 + 8 * fq;
        float rscv[2][4];
#pragma unroll
        for (int ai = 0; ai < 2; ++ai)
#pragma unroll
            for (int m = 0; m < 4; ++m) rscv[ai][m] = row_rscale((const float*)(ws + WS_RS), row0 + ai * 128 + m * 16);
        if (false) {
        } else if (pn == 38) {
            if (wc == 0) {
                f32x4 bv[2];
#pragma unroll
                for (int n = 0; n < 2; ++n) bv[n] = *(const f32x4*)(bias + pc0 + 4 * n);
#pragma unroll
                for (int ai = 0; ai < 2; ++ai)
#pragma unroll
                    for (int m = 0; m < 4; ++m) {
                        const int row = row0 + ai * 128 + m * 16;
                        const float rsc = rscv[ai][m];
#pragma unroll
                        for (int n = 0; n < 2; ++n) {
                            f32x4 v = acc[ai][0][m][n] * rsc + bv[n];
                            if (fq & 1) {
#pragma unroll
                                for (int i = 0; i < 4; ++i) { const float ex = fexp(-fabsf(v[i])); const float l1 = ex < 0.01f ? ex * (1.f - ex * (0.5f - ex * 0.33333333f)) : __logf(1.f + ex); v[i] = fminf(v[i], 0.f) - l1; }
                            }
                            *(f32x4*)((float*)(ws + WS_IF) + (size_t)row * 32 + 8 * fq + 4 * n) = v;
                        }
                    }
            }
        } else {
            size_t doff; int ld, col, act;
            if (pn < 4) { doff = WS_Q; ld = 1024; col = pn * 256; act = 0; }
            else if (pn == 4) { doff = WS_K; ld = 256; col = 0; act = 0; }
            else if (pn == 5) { doff = WS_V; ld = 256; col = 0; act = 0; }
            else if (pn < 10) { doff = WS_AZ; ld = 1024; col = (pn - 6) * 256; act = 1; }
            else if (pn < 14) { doff = WS_MQ; ld = 1024; col = (pn - 10) * 256; act = 0; }
            else if (pn < 18) { doff = WS_MK; ld = 1024; col = (pn - 14) * 256; act = 0; }
            else if (pn < 22) { doff = WS_MV; ld = 1024; col = (pn - 18) * 256; act = 0; }
            else if (pn < 26) { doff = WS_MO; ld = 1024; col = (pn - 22) * 256; act = 2; }
            else if (pn < 30) { doff = WS_MZ; ld = 1024; col = (pn - 26) * 256; act = 1; }
            else { doff = WS_GT; ld = 2048; col = (pn - 30) * 256; act = 2; }
            bf16_t* dst = (bf16_t*)(ws + doff);
            col += wc * 32 + 8 * fq;
            f32x4 bv[2][2];
#pragma unroll
            for (int bj = 0; bj < 2; ++bj)
#pragma unroll
                for (int n = 0; n < 2; ++n) bv[bj][n] = *(const f32x4*)(bias + pc0 + bj * 128 + 4 * n);
#pragma unroll
            for (int ai = 0; ai < 2; ++ai)
#pragma unroll
                for (int m = 0; m < 4; ++m) {
                    bf16_t* rowp = dst + (size_t)(row0 + ai * 128 + m * 16) * ld + col;
                    const float rsc = rscv[ai][m];
#pragma unroll
                    for (int bj = 0; bj < 2; ++bj) {
                        f32x4 v[2];
#pragma unroll
                        for (int n = 0; n < 2; ++n) {
                            v[n] = acc[ai][bj][m][n] * rsc + bv[bj][n];
                            if (act != 0) {
#pragma unroll
                                for (int i = 0; i < 4; ++i) { const float s = __builtin_amdgcn_rcpf(1.f + fexp(-v[n][i])); v[n][i] = act == 1 ? v[n][i] * s : s; }
                            }
                        }
                        u32x4 w; w.x = cvt_pk_bf16(v[0][0], v[0][1]); w.y = cvt_pk_bf16(v[0][2], v[0][3]); w.z = cvt_pk_bf16(v[1][0], v[1][1]); w.w = cvt_pk_bf16(v[1][2], v[1][3]);
                        __builtin_nontemporal_store(w, (u32x4*)(rowp + bj * 128));
                    }
                }
        }
    }
};

template <int MODE> struct EpiGate {
    static constexpr bool PERM = true;
    const bf16_t* GT; bf16_t* T; bf16_t* MG;
    __device__ __forceinline__ void operator()(const f32x4 (&acc)[2][2][4][2], const pg8::Unit& u, int wr, int wc, int fr, int fq) const {
        const int row0 = u.pm * 256 + wr * 64 + fr; const int col0 = u.pn * 256 + wc * 32 + 8 * fq;
        u32x4 gc[2], tc[2];
#pragma unroll
        for (int bj = 0; bj < 2; ++bj) { gc[bj] = *(const u32x4*)(GT + (size_t)row0 * 2048 + MODE * 1024 + col0 + bj * 128); if (MODE == 1) tc[bj] = *(const u32x4*)(T + (size_t)row0 * 1024 + col0 + bj * 128); }
#pragma unroll
        for (int it = 0; it < 8; ++it) {
            const int ai = it >> 2, m = it & 3;
            const size_t row = (size_t)(row0 + ai * 128 + m * 16);
            u32x4 gn[2], tn[2];
            if (it < 7) { const size_t rown = (size_t)(row0 + ((it + 1) >> 2) * 128 + ((it + 1) & 3) * 16);
#pragma unroll
                for (int bj = 0; bj < 2; ++bj) { gn[bj] = *(const u32x4*)(GT + rown * 2048 + MODE * 1024 + col0 + bj * 128); if (MODE == 1) tn[bj] = *(const u32x4*)(T + rown * 1024 + col0 + bj * 128); } }
#pragma unroll
            for (int bj = 0; bj < 2; ++bj) {
                const int col = col0 + bj * 128;
                const u32x4 gw = gc[bj];
                float o[8];
                o[0] = acc[ai][bj][m][0][0] * bflo(gw.x); o[1] = acc[ai][bj][m][0][1] * bfhi(gw.x); o[2] = acc[ai][bj][m][0][2] * bflo(gw.y); o[3] = acc[ai][bj][m][0][3] * bfhi(gw.y);
                o[4] = acc[ai][bj][m][1][0] * bflo(gw.z); o[5] = acc[ai][bj][m][1][1] * bfhi(gw.z); o[6] = acc[ai][bj][m][1][2] * bflo(gw.w); o[7] = acc[ai][bj][m][1][3] * bfhi(gw.w);
                if (MODE == 1) {
                    const u32x4 tw = tc[bj];
                    o[0] += bflo(tw.x); o[1] += bfhi(tw.x); o[2] += bflo(tw.y); o[3] += bfhi(tw.y); o[4] += bflo(tw.z); o[5] += bfhi(tw.z); o[6] += bflo(tw.w); o[7] += bfhi(tw.w);
                }
                u32x4 w; w.x = cvt_pk_bf16(o[0], o[1]); w.y = cvt_pk_bf16(o[2], o[3]); w.z = cvt_pk_bf16(o[4], o[5]); w.w = cvt_pk_bf16(o[6], o[7]);
                *(u32x4*)((MODE == 0 ? T : MG) + row * 1024 + col) = w;
            }
            if (it < 7) {
#pragma unroll
                for (int bj = 0; bj < 2; ++bj) { gc[bj] = gn[bj]; if (MODE == 1) tc[bj] = tn[bj]; } }
            asm volatile("" ::: "memory");
        }
    }
};

struct EpiRes {
    static constexpr bool PERM = false;
    const float* xin; float* xout; bf16_t* xb; float* rsq; LAS float* xl; int wxb;
    __device__ __forceinline__ void operator()(const f32x4 (&acc)[2][2][4][2], const pg8::Unit& u, int wr, int wc, int fr, int fq) const {
        const int row0 = u.pm * 256 + wr * 64 + fr; const int col0 = u.pn * 256 + wc * 32 + 4 * fq; const int lane = fq * 16 + fr;
        f32x4 xc[2][2];
#pragma unroll
        for (int bj = 0; bj < 2; ++bj)
#pragma unroll
            for (int n = 0; n < 2; ++n) xc[bj][n] = *(const f32x4*)(xin + (size_t)row0 * 1024 + col0 + bj * 128 + n * 16);
#pragma unroll
        for (int it = 0; it < 8; ++it) {
            const int ai = it >> 2, m = it & 3;
            const int row = row0 + ai * 128 + m * 16;
            const size_t off = (size_t)row * 1024 + col0;
            f32x4 xn[2][2];
            if (it < 7) { const size_t offn = (size_t)(row0 + ((it + 1) >> 2) * 128 + ((it + 1) & 3) * 16) * 1024 + col0;
#pragma unroll
                for (int bj = 0; bj < 2; ++bj)
#pragma unroll
                    for (int n = 0; n < 2; ++n) xn[bj][n] = *(const f32x4*)(xin + offn + bj * 128 + n * 16); }
            float ss = 0.f;
#pragma unroll
            for (int bj = 0; bj < 2; ++bj)
#pragma unroll
                for (int n = 0; n < 2; ++n) { const f32x4 x = xc[bj][n] + acc[ai][bj][m][n]; *(f32x4*)(xout + off + bj * 128 + n * 16) = x;
                    if (wxb) { u32x2 w; w.x = cvt_pk_bf16(x[0], x[1]); w.y = cvt_pk_bf16(x[2], x[3]); *(u32x2*)(xb + off + bj * 128 + n * 16) = w; }
                    ss += (x[0] * x[0] + x[1] * x[1]) + (x[2] * x[2] + x[3] * x[3]); }
            ss += shfl_x(ss, lane, 16); ss += shfl_x(ss, lane, 32);
            if (fq == 0) xl[(row - u.pm * 256) * 4 + wc] = ss;
            if (it < 7) {
#pragma unroll
                for (int bj = 0; bj < 2; ++bj)
#pragma unroll
                    for (int n = 0; n < 2; ++n) xc[bj][n] = xn[bj][n]; }
            asm volatile("" ::: "memory");
        }
        __syncthreads();
        {
            const int t = wr * 256 + wc * 64 + lane;
            if (t < 256 && wxb) { const f32x4 a = *(const LAS f32x4*)(xl + t * 4); rsq[(size_t)(u.pm * 256 + t) * 4 + u.pn] = (a[0] + a[1]) + (a[2] + a[3]); }
        }
    }
};

struct Ctx {
    int S, nseq, lgn;
    const float* xin; float* xout; unsigned char* ws;
};
#define CB(c, OFF) ((bf16_t*)((c).ws + (OFF)))
#define CF(c, OFF) ((float*)((c).ws + (OFF)))

__device__ __forceinline__ void transpose_item(const float* W, int K, int Nsrc, bf16_t* WT, int kb, int n_src, int n_dst, LAS float* scr, int lane, const float* gk) {
    const int k0 = 64 * kb;
    if (n_src >= 0) {
#pragma unroll 8
        for (int i = 0; i < 32; ++i) { const int kk = 2 * i + (lane >> 5); scr[kk * 33 + (lane & 31)] = W[(size_t)(k0 + kk) * Nsrc + n_src + (lane & 31)] * (gk ? gk[k0 + kk] : 1.f); }
    } else {
#pragma unroll 8
        for (int i = 0; i < 32; ++i) { const int kk = 2 * i + (lane >> 5); scr[kk * 33 + (lane & 31)] = 0.f; }
    }
    asm volatile("s_waitcnt lgkmcnt(0)" ::: "memory");
    const int c = lane & 7;
#pragma unroll
    for (int j = 0; j < 4; ++j) { const int n = (lane >> 3) + 8 * j; const LAS float* s = scr + (8 * c) * 33 + n;
        u32x4 o; o.x = cvt_pk_bf16(s[0 * 33], s[1 * 33]); o.y = cvt_pk_bf16(s[2 * 33], s[3 * 33]); o.z = cvt_pk_bf16(s[4 * 33], s[5 * 33]); o.w = cvt_pk_bf16(s[6 * 33], s[7 * 33]);
        *(u32x4*)(WT + (size_t)(n_dst + n) * K + k0 + 8 * c) = o; }
    asm volatile("s_waitcnt lgkmcnt(0)" ::: "memory");
}
__device__ __forceinline__ int in_block_map(int pb) {
    if (pb < 240) return pb;
    if (pb < 304) return 241 + (pb - 240);
    if (pb == 304) return 240;
    return -1;
}

struct Args {
    const float* x_prompt; const float* x_sample; const float* norm_g; const float* w_in; const float* b_in; const float* q_norm_g; const float* k_norm_g;
    const float* sink; const float* conv_w; const float* m_norm_g; const float* w_att_out; const float* w_m_out; const float* w_out;
    float* out; unsigned char* ws;
};

template <class KP> __device__ __forceinline__ void prologue(KP ka, LAS unsigned char* lds) {
    const int tid = tid_opaque(), lane = tid & 63, wave = tid >> 6;
    const int gw = blockIdx.x * 8 + wave, NGW = gridDim.x * 8;
    LAS float* scr = (LAS float*)(lds + wave * 16384);
    unsigned char* ws = ka->ws;
    constexpr int IT_IN = 16 * 312, IT_SQ = 16 * 32, IT_L = IT_IN + 3 * IT_SQ;
    for (int it = gw; it < DEPTH * IT_L; it += NGW) {
        const int l = it / IT_L; int r = it % IT_L;
        if (r < IT_IN) { const int kb = r / 312, pb = r % 312; const int lb = in_block_map(pb);
            transpose_item(ka->w_in + (size_t)l * DM * IN_DIM, DM, IN_DIM, (bf16_t*)(ws + WS_WIN + l * WIN_BYTES), kb, lb < 0 ? -1 : lb * 32, pb * 32, scr, lane, ka->norm_g + l * DM); continue; }
        r -= IT_IN;
        const int which = r / IT_SQ; r %= IT_SQ; const int kb = r / 32, nb = r % 32;
        const float* W = (which == 0 ? ka->w_att_out : which == 1 ? ka->w_m_out : ka->w_out) + (size_t)l * DM * DM;
        bf16_t* WT = (bf16_t*)(ws + (which == 0 ? WS_WA : which == 1 ? WS_WM : WS_WO) + (size_t)l * DM * DM * 2);
        transpose_item(W, DM, DM, WT, kb, nb * 32, nb * 32, scr, lane, nullptr);
    }
    const int gt = blockIdx.x * 512 + tid, NT = gridDim.x * 512;
    for (int i = gt; i < DEPTH * NPHYS; i += NT) { const int l = i / NPHYS, p = i % NPHYS; const int lb = in_block_map(p >> 5);
        ((float*)(ws + WS_BIAS))[i] = lb < 0 ? 0.f : ka->b_in[(size_t)l * IN_DIM + lb * 32 + (p & 31)]; }
    for (int i = gt; i < 4096 * 8; i += NT) { const int pos = i >> 3, j = i & 7;
        const float inv = j == 0 ? 1.0f : j == 1 ? 0.1939227432012558f : j == 2 ? 0.03760603070259094f : j == 3 ? 0.007292664609849453f : j == 4 ? 0.0014142135623842478f : j == 5 ? 0.00027424818836152554f : j == 6 ? 5.318296098266728e-05f : 1.0313386155758053e-05f;
        const float ang = (float)pos * inv;
        const double rev = (double)ang * 0.15915494309189535; const double fr = rev - __builtin_rint(rev);
        const float f = (float)fr;
        ((float*)(ws + WS_ROPE))[2 * i] = __builtin_amdgcn_cosf(f); ((float*)(ws + WS_ROPE))[2 * i + 1] = __builtin_amdgcn_sinf(f); }
    if (gt < DEPTH) { float mq = 0.f, mk = 0.f; for (int i = 0; i < 64; ++i) { mq = fmaxf(mq, fabsf(ka->q_norm_g[gt * 64 + i])); mk = fmaxf(mk, fabsf(ka->k_norm_g[gt * 64 + i])); }
        ((float*)(ws + WS_MB))[gt] = 8.f * mq * mk; }
}

__device__ __forceinline__ void norm_phase(const Ctx& c) {
    const int tid = tid_opaque(); const int lane = tid & 63, wave = tid >> 6;
    const int gw = blockIdx.x * 8 + wave, NGW = gridDim.x * 8;
    for (int m = gw; m < GM; m += NGW) {
        const f32x4* xr = (const f32x4*)(c.xin + (size_t)m * DM) + lane;
        f32x4 v[4]; float s = 0.f;
#pragma unroll
        for (int j = 0; j < 4; ++j) { v[j] = xr[64 * j]; s += (v[j].x * v[j].x + v[j].y * v[j].y) + (v[j].z * v[j].z + v[j].w * v[j].w); }
#pragma unroll
        for (int o = 1; o < 64; o <<= 1) s += shfl_x(s, lane, o);
        if (lane < 4) CF(c, WS_RS)[(size_t)m * 4 + lane] = lane == 0 ? s : 0.f;
        u32x2* o8 = (u32x2*)(CB(c, WS_XN) + (size_t)m * DM) + lane;
#pragma unroll
        for (int j = 0; j < 4; ++j) { u32x2 w; w.x = cvt_pk_bf16(v[j].x, v[j].y); w.y = cvt_pk_bf16(v[j].z, v[j].w); o8[64 * j] = w; }
    }
}

constexpr int AT_KP = 144, AT_VP = 776, AT_VOFF = 384 * AT_KP;
__device__ __forceinline__ void attn_unit(LAS unsigned char* lds, int unit, const Ctx& c, const float* sink, float mb, bf16_t* dstbuf, const float* qg) {
    const int tid = tid_opaque(), lane = tid & 63, w = tid >> 6, l32 = lane & 31, hi = lane >> 5;
    const int S = c.S, nb = S >> 7;
    const int g = unit & 3, qb = (unit >> 2) & (nb - 1), seq = (unit >> 2) >> c.lgn;
    const size_t rowbase = (size_t)seq * S;
    LAS unsigned char* Ks = lds; LAS unsigned char* Vt = lds + AT_VOFF;
    const int hq = g * 4 + (w >> 1);
    u32x4 qwp[2][4]; f32x4 rpp[2][4]; u32x2 zwp[2][8];
#pragma unroll
    for (int hf = 0; hf < 2; ++hf) {
        const int qi_ = ((w & 1) * 2 + hf) * 32 + l32; const size_t qrow_ = rowbase + qb * 128 + qi_;
#pragma unroll
        for (int s = 0; s < 4; ++s) { qwp[hf][s] = *(const u32x4*)(CB(c, WS_Q) + qrow_ * 1024 + hq * 64 + 16 * s + 8 * hi); rpp[hf][s] = *(const f32x4*)((const float*)(c.ws + WS_ROPE) + (qb * 128 + qi_) * 16 + 4 * s); }
#pragma unroll
        for (int k8 = 0; k8 < 8; ++k8) zwp[hf][k8] = *(const u32x2*)(CB(c, WS_AZ) + qrow_ * 1024 + hq * 64 + (k8 >> 2) * 32 + 8 * (k8 & 3) + 4 * hi);
    }
#pragma unroll
    for (int it = 0; it < 6; ++it) { const int idx = tid + it * 512; const int r = idx >> 3, ch = idx & 7; const int kpos = (qb - 1) * 128 + r;
        if (kpos >= 0 && kpos < S) { const u32x4 v = *(const u32x4*)(CB(c, WS_K) + (rowbase + kpos) * 256 + g * 64 + ch * 8); *(LAS u32x4*)(Ks + r * AT_KP + ch * 16) = v; } }
#pragma unroll
    for (int it = 0; it < 3; ++it) { const int idx = tid + it * 512; const int kp = idx >> 3, dg = idx & 7; const int key0 = kp * 2; const int kpos = (qb - 1) * 128 + key0;
        if (kpos >= 0 && kpos < S) {
            const u32x4 va = *(const u32x4*)(CB(c, WS_V) + (rowbase + kpos) * 256 + g * 64 + dg * 8), vb = *(const u32x4*)(CB(c, WS_V) + (rowbase + kpos + 1) * 256 + g * 64 + dg * 8);
            const unsigned aa[4] = {va.x, va.y, va.z, va.w}, bb[4] = {vb.x, vb.y, vb.z, vb.w};
#pragma unroll
            for (int i = 0; i < 8; ++i) { const unsigned lo = (i & 1) ? (aa[i >> 1] >> 16) : (aa[i >> 1] & 0xffffu); const unsigned hh = (i & 1) ? (bb[i >> 1] & 0xffff0000u) : (bb[i >> 1] << 16);
                *(LAS unsigned*)(Vt + (dg * 8 + i) * AT_VP + key0 * 2) = lo | hh; }
        } }
    __syncthreads();
    const float mb2 = mb * 1.4426950408889634f;
    const float sinkv = __builtin_amdgcn_exp2f(sink[hq] * 1.4426950408889634f - mb2);
#pragma unroll 1
    for (int half = 0; half < 2; ++half) {
        const int qt = (w & 1) * 2 + half; const int qi = qt * 32 + l32; const size_t qrow = rowbase + qb * 128 + qi;
        bf16x8 qf[4];
        {
            u32x4 qw[4]; float ss = 0.f;
#pragma unroll
            for (int s = 0; s < 4; ++s) { qw[s] = half ? qwp[1][s] : qwp[0][s];
                const float a0 = bflo(qw[s].x), a1 = bfhi(qw[s].x), a2 = bflo(qw[s].y), a3 = bfhi(qw[s].y), a4 = bflo(qw[s].z), a5 = bfhi(qw[s].z), a6 = bflo(qw[s].w), a7 = bfhi(qw[s].w);
                ss += ((a0 * a0 + a1 * a1) + (a2 * a2 + a3 * a3)) + ((a4 * a4 + a5 * a5) + (a6 * a6 + a7 * a7)); }
            ss += shfl_x(ss, lane, 32);
            const float rs = __builtin_amdgcn_rsqf(ss * (1.f / 64.f) + NORM_EPS) * (0.125f * 1.4426950408889634f);
            float rp[16];
#pragma unroll
            for (int s = 0; s < 4; ++s) { const f32x4 t4 = half ? rpp[1][s] : rpp[0][s]; rp[4 * s] = t4[0]; rp[4 * s + 1] = t4[1]; rp[4 * s + 2] = t4[2]; rp[4 * s + 3] = t4[3]; }
#pragma unroll
            for (int s = 0; s < 4; ++s) {
                const f32x4 g0 = *(const f32x4*)(qg + 16 * s + 8 * hi), g1 = *(const f32x4*)(qg + 16 * s + 8 * hi + 4);
                float v[8] = {bflo(qw[s].x) * rs * g0[0], bfhi(qw[s].x) * rs * g0[1], bflo(qw[s].y) * rs * g0[2], bfhi(qw[s].y) * rs * g0[3],
                              bflo(qw[s].z) * rs * g1[0], bfhi(qw[s].z) * rs * g1[1], bflo(qw[s].w) * rs * g1[2], bfhi(qw[s].w) * rs * g1[3]};
                if (s == 0) {
#pragma unroll
                    for (int j = 0; j < 8; ++j) { const float cs = rp[2 * j], sn = rp[2 * j + 1]; const float pr = shfl_x(v[j], lane, 32);
                        v[j] = hi == 0 ? v[j] * cs - pr * sn : v[j] * cs + pr * sn; }
                }
                u32x4 o; o.x = cvt_pk_bf16(v[0], v[1]); o.y = cvt_pk_bf16(v[2], v[3]); o.z = cvt_pk_bf16(v[4], v[5]); o.w = cvt_pk_bf16(v[6], v[7]);
                qf[s] = __builtin_bit_cast(bf16x8, o);
            }
        }
        f32x16 o0, o1;
#pragma unroll
        for (int r = 0; r < 16; ++r) { o0[r] = 0.f; o1[r] = 0.f; }
        float rsum = 0.f;
        const int bt_lo = qb > 0 ? qt : 4, bt_hi = qb < nb - 1 ? 8 + qt : 7;
        f32x16 pc;
#pragma unroll
        for (int r = 0; r < 16; ++r) pc[r] = -mb2;
#pragma unroll
        for (int s = 0; s < 4; ++s) { const bf16x8 ka = *(const LAS bf16x8*)(Ks + (bt_lo * 32 + l32) * AT_KP + (16 * s + 8 * hi) * 2); pc = MFMA32(ka, qf[s], pc); }
#pragma unroll 1
        for (int bt = bt_lo; bt <= bt_hi; ++bt) {
            const int kj0 = bt * 32;
            const int bn = bt < bt_hi ? bt + 1 : bt;
            f32x16 pn;
#pragma unroll
            for (int r = 0; r < 16; ++r) pn[r] = -mb2;
#pragma unroll
            for (int s = 0; s < 4; ++s) { const bf16x8 ka = *(const LAS bf16x8*)(Ks + (bn * 32 + l32) * AT_KP + (16 * s + 8 * hi) * 2); pn = MFMA32(ka, qf[s], pn); }
            f32x16 p = pc;
            if (bt == qt || bt == 8 + qt) {
#pragma unroll
                for (int r = 0; r < 16; ++r) { const int jr = crow(r, hi);
                    const bool valid = bt < 4 ? (jr >= l32) : (jr <= l32);
                    const float e = valid ? __builtin_amdgcn_exp2f(p[r]) : 0.f; p[r] = e; rsum += e; }
            } else {
#pragma unroll
                for (int r = 0; r < 16; ++r) { const float e = __builtin_amdgcn_exp2f(p[r]); p[r] = e; rsum += e; }
            }
#pragma unroll
            for (int s2 = 0; s2 < 2; ++s2) {
                u32x4 bw; bw.x = cvt_pk_bf16(p[8 * s2 + 0], p[8 * s2 + 1]); bw.y = cvt_pk_bf16(p[8 * s2 + 2], p[8 * s2 + 3]); bw.z = cvt_pk_bf16(p[8 * s2 + 4], p[8 * s2 + 5]); bw.w = cvt_pk_bf16(p[8 * s2 + 6], p[8 * s2 + 7]);
                const bf16x8 b2 = __builtin_bit_cast(bf16x8, bw);
                { const LAS unsigned char* vp = Vt + (l32) * AT_VP + (kj0 + 16 * s2 + 4 * hi) * 2; const u32x2 lo = *(const LAS u32x2*)vp, h2 = *(const LAS u32x2*)(vp + 16);
                  u32x4 aw; aw.x = lo.x; aw.y = lo.y; aw.z = h2.x; aw.w = h2.y; o0 = MFMA32(__builtin_bit_cast(bf16x8, aw), b2, o0); }
                { const LAS unsigned char* vp = Vt + (32 + l32) * AT_VP + (kj0 + 16 * s2 + 4 * hi) * 2; const u32x2 lo = *(const LAS u32x2*)vp, h2 = *(const LAS u32x2*)(vp + 16);
                  u32x4 aw; aw.x = lo.x; aw.y = lo.y; aw.z = h2.x; aw.w = h2.y; o1 = MFMA32(__builtin_bit_cast(bf16x8, aw), b2, o1); }
            }
            pc = pn;
        }
        rsum += shfl_x(rsum, lane, 32);
        const float inv = __builtin_amdgcn_rcpf(rsum + sinkv);
#pragma unroll
        for (int dt = 0; dt < 2; ++dt)
#pragma unroll
            for (int rg = 0; rg < 4; ++rg) {
                const int dim = dt * 32 + 8 * rg + 4 * hi; const size_t off = qrow * 1024 + hq * 64 + dim;
                const u32x2 zw = half ? zwp[1][dt * 4 + rg] : zwp[0][dt * 4 + rg];
                const float v0 = (dt ? o1[4 * rg + 0] : o0[4 * rg + 0]) * inv * bflo(zw.x), v1 = (dt ? o1[4 * rg + 1] : o0[4 * rg + 1]) * inv * bfhi(zw.x);
                const float v2 = (dt ? o1[4 * rg + 2] : o0[4 * rg + 2]) * inv * bflo(zw.y), v3 = (dt ? o1[4 * rg + 3] : o0[4 * rg + 3]) * inv * bfhi(zw.y);
                u32x2 ow; ow.x = cvt_pk_bf16(v0, v1); ow.y = cvt_pk_bf16(v2, v3);
                *(u32x2*)(dstbuf + off) = ow;
            }
    }
    __syncthreads();
}


__device__ __forceinline__ void knorm_rows(const Ctx& c, const float* kg) {
    const int tid = tid_opaque(); const int lane = tid & 63, wave = tid >> 6;
    const int gw = blockIdx.x * 8 + wave, NGW = gridDim.x * 8;
    const int d0 = (lane & 3) * 16;
    const float* rope = (const float*)(c.ws + WS_ROPE);
#pragma unroll 2
    for (int m4 = gw; m4 < GM / 4; m4 += NGW) {
        const int m = m4 * 4 + (lane >> 4);
        const int pos = m & (c.S - 1);
        bf16_t* p = CB(c, WS_K) + (size_t)m * 256 + (lane & 15) * 16;
        const float* g = kg + d0;
        const u32x4 w0 = *(const u32x4*)p, w1 = *(const u32x4*)(p + 8);
        const unsigned ww[8] = {w0.x, w0.y, w0.z, w0.w, w1.x, w1.y, w1.z, w1.w};
        float v[16]; float ss = 0.f;
#pragma unroll
        for (int i = 0; i < 16; ++i) { v[i] = (i & 1) ? bfhi(ww[i >> 1]) : bflo(ww[i >> 1]); ss += v[i] * v[i]; }
        ss += shfl_x(ss, lane, 1); ss += shfl_x(ss, lane, 2);
        const float rs = __builtin_amdgcn_rsqf(ss * (1.f / 64.f) + NORM_EPS);
#pragma unroll
        for (int i = 0; i < 16; ++i) v[i] = v[i] * rs * g[i];
        if ((lane & 3) == 0) {
#pragma unroll
            for (int j = 0; j < 8; ++j) { const float cs = rope[pos * 16 + 2 * j], sn = rope[pos * 16 + 2 * j + 1]; const float x1 = v[j], x2 = v[j + 8]; v[j] = x1 * cs - x2 * sn; v[j + 8] = x2 * cs + x1 * sn; }
        }
        u32x4 o0, o1; o0.x = cvt_pk_bf16(v[0], v[1]); o0.y = cvt_pk_bf16(v[2], v[3]); o0.z = cvt_pk_bf16(v[4], v[5]); o0.w = cvt_pk_bf16(v[6], v[7]);
        o1.x = cvt_pk_bf16(v[8], v[9]); o1.y = cvt_pk_bf16(v[10], v[11]); o1.z = cvt_pk_bf16(v[12], v[13]); o1.w = cvt_pk_bf16(v[14], v[15]);
        *(u32x4*)p = o0; *(u32x4*)(p + 8) = o1;
    }
}

constexpr int PR_P = 260;
__device__ __forceinline__ void prep_unit(LAS unsigned char* lds, int unit, const Ctx& c, const float* cw) {
    const int tid = tid_opaque();
    const int S = c.S, nc = S >> 7;
    const int ch = unit & (nc - 1), h = (unit >> c.lgn) & 7, seq = unit >> (c.lgn + 3);
    const size_t rowbase = (size_t)seq * S; const int t0 = ch * 128;
    LAS unsigned char* Tk = lds; LAS unsigned char* Tv = lds + 128 * PR_P;
    const size_t hb = (size_t)(seq * 8 + h) * S * 128;
#pragma unroll 2
    for (int it = 0; it < 4; ++it) {
        const int idx = tid + it * 512; const int l = idx >> 4, dg = idx & 15; const int t = t0 + l; const int col = h * 128 + dg * 8;
#pragma unroll
        for (int qk = 0; qk < 2; ++qk) {
            const bf16_t* src = qk ? CB(c, WS_MK) : CB(c, WS_MQ);
            const u32x4 z = {0u, 0u, 0u, 0u};
            const u32x4 xm = t > 0 ? *(const u32x4*)(src + (rowbase + t - 1) * 1024 + col) : z;
            const u32x4 x0 = *(const u32x4*)(src + (rowbase + t) * 1024 + col);
            const u32x4 xp = t < S - 1 ? *(const u32x4*)(src + (rowbase + t + 1) * 1024 + col) : z;
            const float* w0 = cw + qk * 1024 + col; const float* w1 = w0 + 2048; const float* w2 = w1 + 2048;
            const unsigned am[4] = {xm.x, xm.y, xm.z, xm.w}, a0[4] = {x0.x, x0.y, x0.z, x0.w}, ap[4] = {xp.x, xp.y, xp.z, xp.w};
            float y[8];
#pragma unroll
            for (int i = 0; i < 8; ++i) {
                const float vm = (i & 1) ? bfhi(am[i >> 1]) : bflo(am[i >> 1]), v0 = (i & 1) ? bfhi(a0[i >> 1]) : bflo(a0[i >> 1]), vp = (i & 1) ? bfhi(ap[i >> 1]) : bflo(ap[i >> 1]);
                float s = vm * w0[i] + v0 * w1[i] + vp * w2[i];
                s = s * __builtin_amdgcn_rcpf(1.f + fexp(-s));
                y[i] = qk ? s * KSCALE : s;
            }
            u32x4 o; o.x = cvt_pk_bf16(y[0], y[1]); o.y = cvt_pk_bf16(y[2], y[3]); o.z = cvt_pk_bf16(y[4], y[5]); o.w = cvt_pk_bf16(y[6], y[7]);
            *(u32x4*)((qk ? CB(c, WS_KC) : CB(c, WS_QC)) + hb + (size_t)(t >> 5) * 4096 + dg * 256 + (t & 31) * 8) = o;
            if (qk) { LAS unsigned* tp = (LAS unsigned*)(Tk + l * PR_P + dg * 16); tp[0] = o.x; tp[1] = o.y; tp[2] = o.z; tp[3] = o.w; }
        }
        { const u32x4 v = *(const u32x4*)(CB(c, WS_MV) + (rowbase + t) * 1024 + col); LAS unsigned* tp = (LAS unsigned*)(Tv + l * PR_P + dg * 16); tp[0] = v.x; tp[1] = v.y; tp[2] = v.z; tp[3] = v.w; }
    }
    __syncthreads();
#pragma unroll 2
    for (int it = 0; it < 4; ++it) {
        const int idx = tid + it * 512; const int d = idx & 127, lg = idx >> 7;
#pragma unroll
        for (int kv = 0; kv < 2; ++kv) {
            const LAS unsigned char* T = kv ? Tv : Tk;
            unsigned short e[8];
#pragma unroll
            for (int i = 0; i < 8; ++i) e[i] = *(const LAS unsigned short*)(T + (lg * 8 + i) * PR_P + d * 2);
            u32x4 o; o.x = e[0] | ((unsigned)e[1] << 16); o.y = e[2] | ((unsigned)e[3] << 16); o.z = e[4] | ((unsigned)e[5] << 16); o.w = e[6] | ((unsigned)e[7] << 16);
            *(u32x4*)((kv ? CB(c, WS_VT) : CB(c, WS_KT)) + hb + (size_t)ch * 16384 + (d >> 5) * 4096 + lg * 256 + (d & 31) * 8) = o;
        }
    }
    __syncthreads();
}

__device__ __forceinline__ void scan_job(int job, const Ctx& c) {
    const int lane = tid_opaque() & 63;
    const int S = c.S, nc = S >> 7;
    const int ch = job & (nc - 1), dir = (job >> c.lgn) & 1, h = (job >> (c.lgn + 1)) & 7, seq = job >> (c.lgn + 4);
    const size_t rowbase = (size_t)seq * S; const int t0 = ch * 128;
    const int p0 = dir ? 127 - 2 * lane : 2 * lane, p1 = dir ? 126 - 2 * lane : 2 * lane + 1;
    const float* r0 = CF(c, WS_IF) + (rowbase + t0 + p0) * 32 + dir * 16 + h; const float* r1 = CF(c, WS_IF) + (rowbase + t0 + p1) * 32 + dir * 16 + h;
    const float li0 = r0[0], lf0 = r0[8], li1 = r1[0], lf1 = r1[8];
    float s = lf0 + lf1;
#pragma unroll
    for (int o = 1; o < 64; o <<= 1) { const float y = shfl_u(s, lane, o); if (lane >= o) s += y; }
    const float b1 = s, b0 = s - lf1;
    const float a0 = li0 - b0, a1 = li1 - b1;
    float mx = fmaxf(a0, a1);
#pragma unroll
    for (int o = 1; o < 64; o <<= 1) { const float y = shfl_u(mx, lane, o); if (lane >= o) mx = fmaxf(mx, y); }
    float ex = shfl_u(mx, lane, 1); if (lane == 0) ex = -3.0e38f;
    const float cm0 = fmaxf(ex, a0), cm1 = mx;
    const size_t sb = (size_t)((seq * 8 + h) * 2 + dir) * S + t0;
    const float cmL = __int_as_float(__builtin_amdgcn_ds_bpermute(63 << 2, __float_as_int(cm1)));
    bf16_t* ea = CB(c, WS_EA);
    ea[sb + p0] = (bf16_t)(cvt_pk_bf16(fexp(a0 - cmL), 0.f) & 0xffffu); ea[sb + p1] = (bf16_t)(cvt_pk_bf16(fexp(a1 - cmL), 0.f) & 0xffffu);
    CF(c, WS_SA)[sb + p0] = a0 * 1.4426950408889634f; CF(c, WS_SA)[sb + p1] = a1 * 1.4426950408889634f;     CF(c, WS_SCM)[sb + p0] = cm0; CF(c, WS_SCM)[sb + p1] = cm1; CF(c, WS_SB)[sb + p0] = b0; CF(c, WS_SB)[sb + p1] = b1;
}

__device__ __forceinline__ void st_stage(LAS unsigned char* buf, const bf16_t* KTc, const bf16_t* VTc, int w, int lane) {
#pragma unroll
    for (int p = 0; p < 6; ++p) {
        const int piece = w * 6 + p;
        const char* src = piece < 32 ? (const char*)KTc + piece * 1024 : (const char*)VTc + (piece - 32) * 1024;
        __builtin_amdgcn_global_load_lds((const unsigned*)(src + lane * 16), (LAS unsigned*)(buf + piece * 1024), 16, 0, 0);
    }
}
__device__ __forceinline__ void mlstm_state_unit(LAS unsigned char* lds, int unit, const Ctx& c) {
    const int tid = tid_opaque(), lane = tid & 63, w = __builtin_amdgcn_readfirstlane(tid >> 6), l32 = lane & 31, hi = lane >> 5;
    const int S = c.S, nc = S >> 7;
    const int es = unit & 1, dir = (unit >> 1) & 1, h = (unit >> 2) & 7, seq = unit >> 5;
    const size_t hb = (size_t)(seq * 8 + h) * S * 128;
    const int chain = (seq * 8 + h) * 2 + dir;
    const size_t sbase = (size_t)chain * S;
    const int et = w >> 2, dt = w & 3;
    const bf16_t* KTg = CB(c, WS_KT) + hb; const bf16_t* VTg = CB(c, WS_VT) + hb + es * 8192;
    const bf16_t* EAl = CB(c, WS_EA) + sbase;
    const float* scm = CF(c, WS_SCM) + sbase; const float* sbv = CF(c, WS_SB) + sbase;
    bf16_t* CPl = CB(c, WS_CP) + (size_t)chain * nc * 16384 + (es * 2 + et) * 4096 + dt * 1024 + l32 * 8 + 4 * hi;
    bf16_t* NPl = CB(c, WS_NP) + (size_t)chain * nc * 128 + dt * 32 + 4 * hi;
    float* MPl = CF(c, WS_MP) + (size_t)chain * nc;
    const int plast = dir ? 0 : 127;
    const int kofs = dt * 8192 + hi * 512 + l32 * 16, vofs = 32768 + et * 8192 + hi * 512 + l32 * 16;
    f32x16 Cacc, nacc;
#pragma unroll
    for (int r = 0; r < 16; ++r) { Cacc[r] = 0.f; nacc[r] = 0.f; }
    float m_prev = -1e30f;
    u32x4 ea[8]; float cmLn, bLn;
    { const int ch0 = dir ? nc - 1 : 0;
      st_stage(lds, KTg + (size_t)ch0 * 16384, VTg + (size_t)ch0 * 16384, w, lane);
#pragma unroll
      for (int s = 0; s < 8; ++s) ea[s] = *(const u32x4*)(EAl + ch0 * 128 + 16 * s + 8 * hi);
      cmLn = scm[ch0 * 128 + plast]; bLn = sbv[ch0 * 128 + plast]; }
#pragma unroll 1
    for (int step = 0; step < nc; ++step) {
        const int ch = dir ? nc - 1 - step : step;
        const int sn = step + 1 < nc ? step + 1 : step; const int chn = dir ? nc - 1 - sn : sn;
        asm volatile("s_waitcnt vmcnt(0)" ::: "memory"); __syncthreads();
        const LAS unsigned char* buf = lds + (step & 1) * 49152;
        if (step + 1 < nc) st_stage(lds + ((step + 1) & 1) * 49152, KTg + (size_t)chn * 16384, VTg + (size_t)chn * 16384, w, lane);
        const bf16_t* EAn = EAl + chn * 128 + 8 * hi;
#pragma unroll
        for (int rg = 0; rg < 4; ++rg) { u32x2 o; o.x = cvt_pk_bf16(Cacc[4 * rg + 0], Cacc[4 * rg + 1]); o.y = cvt_pk_bf16(Cacc[4 * rg + 2], Cacc[4 * rg + 3]); *(u32x2*)(CPl + (size_t)ch * 16384 + 256 * rg) = o; }
        if (es == 0 && et == 0 && l32 == 0) {
#pragma unroll
            for (int rg = 0; rg < 4; ++rg) { u32x2 o; o.x = cvt_pk_bf16(nacc[4 * rg + 0], nacc[4 * rg + 1]); o.y = cvt_pk_bf16(nacc[4 * rg + 2], nacc[4 * rg + 3]); *(u32x2*)(NPl + (size_t)ch * 128 + 8 * rg) = o; }
            if (dt == 0 && hi == 0) MPl[ch] = m_prev;
        }
        const float cmL = cmLn, bL = bLn;
        cmLn = scm[chn * 128 + plast]; bLn = sbv[chn * 128 + plast];
        const float M_last = fmaxf(m_prev, cmL);
        const float w_c = fexp(m_prev - M_last), w_d = fexp(cmL - M_last);
        f32x16 dC, dn;
#pragma unroll
        for (int r = 0; r < 16; ++r) { dC[r] = 0.f; dn[r] = 0.f; }
#pragma unroll
        for (int s = 0; s < 8; ++s) {
            const bf16x8 kt = *(const LAS bf16x8*)(buf + kofs + s * 1024);
            const u32x4 vw = *(const LAS u32x4*)(buf + vofs + s * 1024), ew = ea[s];
            u32x4 bw; bw.x = cvt_pk_bf16(bflo(vw.x) * bflo(ew.x), bfhi(vw.x) * bfhi(ew.x)); bw.y = cvt_pk_bf16(bflo(vw.y) * bflo(ew.y), bfhi(vw.y) * bfhi(ew.y));
            bw.z = cvt_pk_bf16(bflo(vw.z) * bflo(ew.z), bfhi(vw.z) * bfhi(ew.z)); bw.w = cvt_pk_bf16(bflo(vw.w) * bflo(ew.w), bfhi(vw.w) * bfhi(ew.w));
            dC = MFMA32(kt, __builtin_bit_cast(bf16x8, bw), dC);
            if (et == 0) dn = MFMA32(kt, __builtin_bit_cast(bf16x8, ew), dn);
            ea[s] = *(const u32x4*)(EAn + 16 * s);
        }
#pragma unroll
        for (int r = 0; r < 16; ++r) { Cacc[r] = w_c * Cacc[r] + w_d * dC[r]; nacc[r] = w_c * nacc[r] + w_d * dn[r]; }
        m_prev = bL + M_last;
    }
    asm volatile("s_waitcnt vmcnt(0)" ::: "memory"); __syncthreads();
}

__device__ __forceinline__ void out_stage(LAS unsigned char* buf, int unit, const Ctx& c, int w, int lane) {
    const int S = c.S, nc = S >> 7;
    const int ch = unit & (nc - 1), h = (unit >> c.lgn) & 7, seq = unit >> (c.lgn + 3);
    const size_t hb = (size_t)(seq * 8 + h) * S * 128 + (size_t)ch * 16384;
    const char* q = (const char*)(CB(c, WS_QC) + hb); const char* k = (const char*)(CB(c, WS_KC) + hb);
#pragma unroll
    for (int p = 0; p < 4; ++p) {
        const int piece = w * 4 + p;
        __builtin_amdgcn_global_load_lds((const unsigned*)(q + piece * 1024 + lane * 16), (LAS unsigned*)(buf + piece * 1024), 16, 0, 0);
        __builtin_amdgcn_global_load_lds((const unsigned*)(k + piece * 1024 + lane * 16), (LAS unsigned*)(buf + 32768 + piece * 1024), 16, 0, 0);
    }
}
__device__ __forceinline__ void mlstm_out_unit(const LAS unsigned char* buf, LAS float* xch, int unit, const Ctx& c, const float* mg) {
    const int tid = tid_opaque(), lane = tid & 63, w = __builtin_amdgcn_readfirstlane(tid >> 6), l32 = lane & 31, hi = lane >> 5;
    const int S = c.S, nc = S >> 7;
    const int ch = unit & (nc - 1), h = (unit >> c.lgn) & 7, seq = unit >> (c.lgn + 3);
    const size_t hb = (size_t)(seq * 8 + h) * S * 128;
    const int t0 = ch * 128;
    const int it = w & 3, ep = w >> 2;
    const int i = it * 32 + l32;
    const LAS unsigned char* Ql = buf + hi * 512 + l32 * 16; const LAS unsigned char* Kl = buf + 32768 + hi * 512 + l32 * 16;
    const bf16_t* VTl = CB(c, WS_VT) + hb + (size_t)ch * 16384 + (2 * ep) * 4096;
    const unsigned vlo = (unsigned)(l32 * 8 + 4 * hi), clo = (unsigned)(hi * 256 + l32 * 8), nlo = (unsigned)(8 * hi), alo = (unsigned)(4 * hi);
    bf16x8 qf[8];
#pragma unroll
    for (int s = 0; s < 8; ++s) qf[s] = *(const LAS bf16x8*)(Ql + it * 8192 + s * 1024);
    float hsum[2][16];
#pragma unroll
    for (int r = 0; r < 16; ++r) { hsum[0][r] = 0.f; hsum[1][r] = 0.f; }
#pragma unroll 1
    for (int dir = 0; dir < 2; ++dir) {
        const int chain = (seq * 8 + h) * 2 + dir;
        const size_t sbase = (size_t)chain * S + t0;
        const bf16_t* CPl = CB(c, WS_CP) + ((size_t)chain * nc + ch) * 16384 + (2 * ep) * 4096;
        const bf16_t* NPl = CB(c, WS_NP) + ((size_t)chain * nc + ch) * 128;
        const float* sa = CF(c, WS_SA) + sbase;
        const int jlo = dir ? it : 0, jhi = dir ? 3 : it;
        const float m_prev = CF(c, WS_MP)[(size_t)chain * nc + ch];
        const float cm_i = (CF(c, WS_SCM) + sbase)[(unsigned)i], b_i = (CF(c, WS_SB) + sbase)[(unsigned)i];
        const float M_i = fmaxf(m_prev, cm_i); const float w_i = fexp(m_prev - M_i); const float M_i2 = M_i * 1.4426950408889634f;
        f32x16 ainta, aintb, aqn, anuma, anumb;
#pragma unroll
        for (int r = 0; r < 16; ++r) { ainta[r] = 0.f; aintb[r] = 0.f; aqn[r] = 0.f; anuma[r] = 0.f; anumb[r] = 0.f; }
        float rsum = 0.f;
        f32x16 pc;
#pragma unroll
        for (int r = 0; r < 16; ++r) pc[r] = 0.f;
#pragma unroll
        for (int s = 0; s < 8; ++s) { const bf16x8 kf = *(const LAS bf16x8*)(Kl + jlo * 8192 + s * 1024); pc = MFMA32(kf, qf[s], pc); }
#pragma unroll 1
        for (int jt = jlo; jt <= jhi; ++jt) {
            u32x2 vlc[2][2], vhc[2][2]; f32x4 avc[4];
#pragma unroll
            for (int e2 = 0; e2 < 2; ++e2)
#pragma unroll
                for (int s2 = 0; s2 < 2; ++s2) { const unsigned vo = vlo + (unsigned)(e2 * 4096 + (4 * jt + 2 * s2) * 256); vlc[e2][s2] = *(const u32x2*)(VTl + vo); vhc[e2][s2] = *(const u32x2*)(VTl + (vo + 256u)); }
#pragma unroll
            for (int rg = 0; rg < 4; ++rg) avc[rg] = *(const f32x4*)(sa + (alo + (unsigned)(jt * 32 + 8 * rg)));
            const int jn = jt < jhi ? jt + 1 : jt;
            f32x16 pn;
#pragma unroll
            for (int r = 0; r < 16; ++r) pn[r] = 0.f;
#pragma unroll
            for (int s = 0; s < 8; ++s) { const bf16x8 kf = *(const LAS bf16x8*)(Kl + jn * 8192 + s * 1024); pn = MFMA32(kf, qf[s], pn); }
            f32x16 p = pc;
            if (jt == it) {
#pragma unroll
                for (int r = 0; r < 16; ++r) { const int jr = crow(r, hi);
                    const bool valid = dir ? (jr >= l32) : (jr <= l32);
                    const float dg = valid ? __builtin_amdgcn_exp2f(avc[r >> 2][r & 3] - M_i2) : 0.f; p[r] *= dg; rsum += p[r]; }
            } else {
#pragma unroll
                for (int r = 0; r < 16; ++r) { p[r] *= __builtin_amdgcn_exp2f(avc[r >> 2][r & 3] - M_i2); rsum += p[r]; }
            }
#pragma unroll
            for (int s2 = 0; s2 < 2; ++s2) {
                u32x4 bw; bw.x = cvt_pk_bf16(p[8 * s2 + 0], p[8 * s2 + 1]); bw.y = cvt_pk_bf16(p[8 * s2 + 2], p[8 * s2 + 3]); bw.z = cvt_pk_bf16(p[8 * s2 + 4], p[8 * s2 + 5]); bw.w = cvt_pk_bf16(p[8 * s2 + 6], p[8 * s2 + 7]);
                u32x4 aw; aw.x = vlc[0][s2].x; aw.y = vlc[0][s2].y; aw.z = vhc[0][s2].x; aw.w = vhc[0][s2].y;
                anuma = MFMA32(__builtin_bit_cast(bf16x8, aw), __builtin_bit_cast(bf16x8, bw), anuma);
                u32x4 cw; cw.x = vlc[1][s2].x; cw.y = vlc[1][s2].y; cw.z = vhc[1][s2].x; cw.w = vhc[1][s2].y;
                anumb = MFMA32(__builtin_bit_cast(bf16x8, cw), __builtin_bit_cast(bf16x8, bw), anumb);
            }
            pc = pn;
        }
        {
            bf16x8 cfa[8], nf[8];
#pragma unroll
            for (int s = 0; s < 8; ++s) { cfa[s] = *(const bf16x8*)(CPl + (clo + 512u * s)); nf[s] = *(const bf16x8*)(NPl + (nlo + 16u * s)); }
#pragma unroll
        for (int s = 0; s < 8; ++s) { ainta = MFMA32(cfa[s], qf[s], ainta); aqn = MFMA32(nf[s], qf[s], aqn); }
        }
        asm volatile("" ::: "memory");
        {
            bf16x8 cfb[8];
#pragma unroll
            for (int s = 0; s < 8; ++s) cfb[s] = *(const bf16x8*)(CPl + (clo + 4096u + 512u * s));
#pragma unroll
            for (int s = 0; s < 8; ++s) aintb = MFMA32(cfb[s], qf[s], aintb);
        }
        asm volatile("" ::: "memory");
        const float qn = aqn[0];
        rsum += shfl_x(rsum, lane, 32);
        const float den = w_i * qn + rsum;
        const float dd = fmaxf(fabsf(den), fexp(-(b_i + M_i)));
        const float inv = __builtin_amdgcn_rcpf(dd);
#pragma unroll
        for (int r = 0; r < 16; ++r) { hsum[0][r] += (w_i * ainta[r] + anuma[r]) * inv; hsum[1][r] += (w_i * aintb[r] + anumb[r]) * inv; }
    }
    int h2 = h; asm volatile("" : "+s"(h2));
    const size_t ob = ((size_t)seq * S + t0) * 1024 + h2 * 128 + (2 * ep) * 32; const unsigned oo = (unsigned)(i * 1024 + 4 * hi);
    bf16_t* MOb = CB(c, WS_MO) + ob; bf16_t* MZb = CB(c, WS_MZ) + ob; const float* mgb = mg + h2 * 128 + (2 * ep) * 32;
    u32x2 ow[2][4], zw[2][4];
#pragma unroll
    for (int e2 = 0; e2 < 2; ++e2)
#pragma unroll
        for (int rg = 0; rg < 4; ++rg) { ow[e2][rg] = *(const u32x2*)(MOb + (oo + (unsigned)(e2 * 32 + 8 * rg))); zw[e2][rg] = *(const u32x2*)(MZb + (oo + (unsigned)(e2 * 32 + 8 * rg))); }
    float ss = 0.f;
#pragma unroll
    for (int e2 = 0; e2 < 2; ++e2)
#pragma unroll
        for (int rg = 0; rg < 4; ++rg) { hsum[e2][4 * rg + 0] *= bflo(ow[e2][rg].x); hsum[e2][4 * rg + 1] *= bfhi(ow[e2][rg].x); hsum[e2][4 * rg + 2] *= bflo(ow[e2][rg].y); hsum[e2][4 * rg + 3] *= bfhi(ow[e2][rg].y);
            ss += (hsum[e2][4 * rg + 0] * hsum[e2][4 * rg + 0] + hsum[e2][4 * rg + 1] * hsum[e2][4 * rg + 1]) + (hsum[e2][4 * rg + 2] * hsum[e2][4 * rg + 2] + hsum[e2][4 * rg + 3] * hsum[e2][4 * rg + 3]); }
    ss += shfl_x(ss, lane, 32);
    if (hi == 0) xch[(it * 2 + ep) * 32 + l32] = ss;
    __syncthreads();
    const float tot = xch[(it * 2) * 32 + l32] + xch[(it * 2 + 1) * 32 + l32];
    const float rs = __builtin_amdgcn_rsqf(tot * (1.f / 128.f) + NORM_EPS);
#pragma unroll
    for (int e2 = 0; e2 < 2; ++e2)
#pragma unroll
        for (int rg = 0; rg < 4; ++rg) { const f32x4 gv = *(const f32x4*)(mgb + (alo + (unsigned)(e2 * 32 + 8 * rg)));
            u32x2 o; o.x = cvt_pk_bf16(hsum[e2][4 * rg + 0] * rs * gv[0] * bflo(zw[e2][rg].x), hsum[e2][4 * rg + 1] * rs * gv[1] * bfhi(zw[e2][rg].x));
            o.y = cvt_pk_bf16(hsum[e2][4 * rg + 2] * rs * gv[2] * bflo(zw[e2][rg].y), hsum[e2][4 * rg + 3] * rs * gv[3] * bfhi(zw[e2][rg].y));
            *(u32x2*)(MZb + (oo + (unsigned)(e2 * 32 + 8 * rg))) = o; }
}

__device__ __forceinline__ void post_phase(const Ctx& c, const float* mg) {
    const int tid = tid_opaque(); const int lane = tid & 63, wave = tid >> 6;
    const int gw = blockIdx.x * 8 + wave, NGW = gridDim.x * 8;
    f32x4 gv[4];
#pragma unroll
    for (int j = 0; j < 4; ++j) gv[j] = *(const f32x4*)(mg + lane * 16 + 4 * j);
    for (int m = gw; m < GM; m += NGW) {
        const size_t off = (size_t)m * 1024 + lane * 16;
        const u32x4 ow0 = *(const u32x4*)(CB(c, WS_MO) + off), ow1 = *(const u32x4*)(CB(c, WS_MO) + off + 8);
        const u32x4 zw0 = *(const u32x4*)(CB(c, WS_MZ) + off), zw1 = *(const u32x4*)(CB(c, WS_MZ) + off + 8);
        const unsigned ow[8] = {ow0.x, ow0.y, ow0.z, ow0.w, ow1.x, ow1.y, ow1.z, ow1.w}, zw[8] = {zw0.x, zw0.y, zw0.z, zw0.w, zw1.x, zw1.y, zw1.z, zw1.w};
        float v[16]; float ss = 0.f;
        const u32x4 fa0 = *(const u32x4*)(CB(c, WS_HF) + off), fa1 = *(const u32x4*)(CB(c, WS_HF) + off + 8);
        const unsigned fa[8] = {fa0.x, fa0.y, fa0.z, fa0.w, fa1.x, fa1.y, fa1.z, fa1.w};
#pragma unroll
        for (int e = 0; e < 16; ++e) { const float og = (e & 1) ? bfhi(ow[e >> 1]) : bflo(ow[e >> 1]); const float hs = (e & 1) ? bfhi(fa[e >> 1]) : bflo(fa[e >> 1]); v[e] = og * hs; ss += v[e] * v[e]; }
        ss += shfl_x(ss, lane, 1); ss += shfl_x(ss, lane, 2); ss += shfl_x(ss, lane, 4);
        const float rs = __builtin_amdgcn_rsqf(ss * (1.f / 128.f) + NORM_EPS);
        unsigned o[8];
#pragma unroll
        for (int e = 0; e < 16; e += 2) { const float y0 = v[e] * rs * gv[e >> 2][e & 3] * bflo(zw[e >> 1]), y1 = v[e + 1] * rs * gv[e >> 2][(e + 1) & 3] * bfhi(zw[e >> 1]); o[e >> 1] = cvt_pk_bf16(y0, y1); }
        u32x4 s0, s1; s0.x = o[0]; s0.y = o[1]; s0.z = o[2]; s0.w = o[3]; s1.x = o[4]; s1.y = o[5]; s1.z = o[6]; s1.w = o[7];
        *(u32x4*)(CB(c, WS_MZ) + off) = s0; *(u32x4*)(CB(c, WS_MZ) + off + 8) = s1;
    }
}


typedef const Args __attribute__((address_space(4)))* KArgsP;
__device__ __forceinline__ KArgsP kargs() { unsigned long long p = (unsigned long long)__builtin_amdgcn_kernarg_segment_ptr(); asm volatile("" : "+s"(p)); return (KArgsP)p; }
#define XB_TMO      128
#define XB_XCNT(j)  (256  + 64 * (j))
#define XB_XSUB(j)  (1280 + 64 * (j))
#define XB_XGEN(j)  (2304 + 64 * (j))
#define XB_TOP      3328
#define XB_TOPGEN   3392
#define XCD_BAR_WORDS 3456
#define XB_SPIN_CAP (1u << 20)
__device__ __forceinline__ unsigned xb_ld(unsigned* p)              { return __hip_atomic_load(p, __ATOMIC_RELAXED, __HIP_MEMORY_SCOPE_AGENT); }
__device__ __forceinline__ unsigned xb_add(unsigned* p, unsigned v) { return __hip_atomic_fetch_add(p, v, __ATOMIC_RELAXED, __HIP_MEMORY_SCOPE_AGENT); }
__device__ __forceinline__ unsigned xb_xcc_id() { return (unsigned)__builtin_amdgcn_s_getreg((3 << 11) | 20) & 0xFu; }
#define XB_SPIN(cond, bar) do { unsigned _sp = 0; while (cond) { __builtin_amdgcn_s_sleep(1); \
    if ((++_sp & 255u) == 0u) { if (xb_ld(&(bar)[XB_TMO])) break; if (_sp > XB_SPIN_CAP) { atomicAdd(&(bar)[XB_TMO], 1u); break; } } } } while (0)
struct XcdBarrier { unsigned* bar; unsigned x; volatile LAS unsigned* st; };
__device__ __forceinline__ XcdBarrier xcd_barrier_post(unsigned* bar, volatile LAS unsigned* st) {
    XcdBarrier b; b.bar = bar; b.x = xb_xcc_id(); b.st = st;
    if (threadIdx.x == 0) (void)xb_add(&bar[XB_XCNT(b.x)], 1u);
    return b;
}
__device__ __forceinline__ void xcd_barrier_complete(unsigned* bar, unsigned x, unsigned& nloc, unsigned& nx) {
    const unsigned G = gridDim.x * gridDim.y * gridDim.z;
    unsigned sum, cnt, mine, sp = 0u;
    for (;;) {
        sum = 0u; cnt = 0u; mine = 0u;
#pragma unroll
        for (unsigned j = 0; j < 16; ++j) { const unsigned c = xb_ld(&bar[XB_XCNT(j)]); sum += c; cnt += (c > 0u) ? 1u : 0u; mine = (j == x) ? c : mine; }
        if (sum == G) break;
        __builtin_amdgcn_s_sleep(1);
        if ((++sp & 255u) == 0u) { if (xb_ld(&bar[XB_TMO])) break; if (sp > XB_SPIN_CAP) { atomicAdd(&bar[XB_TMO], 1u); break; } }
    }
    nloc = mine > 0u ? mine : 1u; nx = cnt > 0u ? cnt : 1u;
}
__device__ __forceinline__ void xcd_barrier(LAS unsigned char* lds) {
    XcdBarrier b; b.bar = (unsigned*)(kargs()->ws + WS_BAR); b.x = xb_xcc_id(); b.st = (volatile LAS unsigned*)(lds + 131072 + 256);
    asm volatile("s_waitcnt vmcnt(0)" ::: "memory");
    __syncthreads();
    if (tid_opaque() == 0) {
        unsigned* bar = b.bar;
        __builtin_amdgcn_s_waitcnt(0);
        unsigned nloc = b.st[0], nx = b.st[1];
        if (nloc == 0u) { xcd_barrier_complete(bar, b.x, nloc, nx); b.st[0] = nloc; b.st[1] = nx; }
        const unsigned old = xb_add(&bar[XB_XSUB(b.x)], 1u);
        const unsigned gen = old / nloc;
        if (old + 1u == (gen + 1u) * nloc) {
            __builtin_amdgcn_fence(__ATOMIC_RELEASE, "agent");
            asm volatile("s_waitcnt vmcnt(0)" ::: "memory");
            const unsigned og = xb_add(&bar[XB_TOP], 1u);
            const unsigned tg = og / nx;
            if (og + 1u == (tg + 1u) * nx) xb_add(&bar[XB_TOPGEN], 1u);
            else XB_SPIN(xb_ld(&bar[XB_TOPGEN]) == tg, bar);
            __builtin_amdgcn_fence(__ATOMIC_ACQUIRE, "agent");
            xb_add(&bar[XB_XGEN(b.x)], 1u);
            asm volatile("s_waitcnt vmcnt(0)" ::: "memory");
        } else {
            XB_SPIN(xb_ld(&bar[XB_XGEN(b.x)]) == gen, bar);
            __builtin_amdgcn_fence(__ATOMIC_ACQUIRE, "agent");
            asm volatile("s_waitcnt vmcnt(0)" ::: "memory");
        }
    }
    __syncthreads();
}

__device__ __forceinline__ Ctx make_ctx(int gi, int l) {
    KArgsP ka = kargs();
    Ctx c; c.S = gi == 0 ? 4096 : 2048; c.nseq = gi == 0 ? 4 : 8; c.lgn = gi == 0 ? 5 : 4; c.ws = ka->ws;
    float* outg = ka->out + (size_t)(unsigned)gi * (size_t)(GM * DM);
    const float* x0 = gi == 0 ? ka->x_prompt : (gi == 1 ? ka->x_sample : ka->x_sample + (size_t)GM * DM);
    c.xout = outg; c.xin = l == 0 ? x0 : outg;
    return c;
}

__global__ void __launch_bounds__(512, 2) fwd_megakernel(Args a_unused) {
    extern __shared__ __attribute__((aligned(16))) unsigned char lds_raw[];
    LAS unsigned char* lds = (LAS unsigned char*)lds_raw;
    cg::grid_group grid = cg::this_grid();

    prologue(kargs(), lds);
    {
        unsigned* bw = (unsigned*)(kargs()->ws + WS_BAR);
        if (blockIdx.x == 0) for (int i = threadIdx.x; i < XCD_BAR_WORDS; i += 512) bw[i] = 0u;
        if (threadIdx.x < 2) ((volatile LAS unsigned*)(lds + 131072 + 256))[threadIdx.x] = 0u;
    }
    grid.sync();
    (void)xcd_barrier_post((unsigned*)(kargs()->ws + WS_BAR), (volatile LAS unsigned*)(lds + 131072 + 256));

#pragma unroll 1
#ifdef TEST_NOLOOP
    for (int gi = 0; gi < 1; ++gi) {
#else
    for (int gi = 0; gi < 3; ++gi) {
#endif
#pragma unroll 1
#ifdef TEST_NOLOOP
        for (int l = 0; l < 1; ++l) {
#else
        for (int l = 0; l < DEPTH; ++l) {
#endif
            if (l == 0 && gi == 0) { const Ctx c = make_ctx(gi, l); norm_phase(c); xcd_barrier(lds); }
            {
                const Ctx c = make_ctx(gi, l); KArgsP ka = kargs(); unsigned char* ws = c.ws;
                pg8::Gemm g{CB(c, WS_XN), (const bf16_t*)(ws + WS_WIN + l * WIN_BYTES), GM, NPHYS, DM}; pg8::StaticOrder So; So.init(GM, NPHYS, gridDim.x, blockIdx.x);
                EpiProj E{ws, (const float*)(ws + WS_BIAS) + l * NPHYS};
#ifndef NO_P2
                pg8::gemm_phase<EpiProj, pg8::StaticOrder, true, true>(lds, g, So, E);
#endif
            }
            xcd_barrier(lds);
            {
                const Ctx c = make_ctx(gi, l); KArgsP ka = kargs();
                const int G = gridDim.x, bid = blockIdx.x, wave = tid_opaque() >> 6;
                knorm_rows(c, ka->k_norm_g + l * 64);
#ifndef NO_P3B
                for (int u = bid; u < 1024; u += G) prep_unit(lds, u, c, ka->conv_w + (size_t)l * 3 * 2048);
#endif
                for (int j = bid * 8 + wave; j < 2048; j += G * 8) scan_job(j, c);
            }
            xcd_barrier(lds);
            {
                const Ctx c = make_ctx(gi, l); KArgsP ka = kargs();
                const int nu = c.nseq * 32;
                const float mb = ((const float*)(c.ws + WS_MB))[l];
#ifndef NO_P3A
                if (nu == 128 && gridDim.x == 256) {
                    const int b = blockIdx.x;
                    if (b < 128) attn_unit(lds, b, c, ka->sink + l * 16, mb, CB(c, WS_Q), ka->q_norm_g + l * 64);
                    else for (int k = 0; k < 3; ++k) attn_unit(lds, 128 + (b - 128) * 3 + k, c, ka->sink + l * 16, mb, CB(c, WS_Q), ka->q_norm_g + l * 64);
                } else {
                    for (int u = blockIdx.x; u < 512; u += gridDim.x) attn_unit(lds, u, c, ka->sink + l * 16, mb, CB(c, WS_Q), ka->q_norm_g + l * 64);
                }
#endif
#ifndef NO_P4
                for (int u = blockIdx.x; u < nu; u += gridDim.x) mlstm_state_unit(lds, u, c);
#endif
            }
            xcd_barrier(lds);
            {
                const Ctx c = make_ctx(gi, l);
#ifndef NO_P4
                const int tid = tid_opaque(), w = tid >> 6, lane = tid & 63;
                const float* mgp = kargs()->m_norm_g + l * DM;
                int u = blockIdx.x, k = 0;
                if (u < 1024) out_stage(lds, u, c, w, lane);
                for (; u < 1024; u += gridDim.x, ++k) {
                    asm volatile("s_waitcnt vmcnt(0)" ::: "memory"); __syncthreads();
                    const int un = u + gridDim.x;
                    if (un < 1024) out_stage(lds + ((k + 1) & 1) * 65536, un, c, w, lane);
                    mlstm_out_unit(lds + (k & 1) * 65536, (LAS float*)(lds + 131072 + 1024), u, c, mgp);
                }
                asm volatile("s_waitcnt vmcnt(0)" ::: "memory"); __syncthreads();
#endif
            }
            xcd_barrier(lds);
            {
                const Ctx c = make_ctx(gi, l); unsigned char* ws = c.ws;
                pg8::StaticOrder So; So.init(GM, DM, gridDim.x, blockIdx.x);
                { pg8::Gemm g{CB(c, WS_Q), (const bf16_t*)(ws + WS_WA + (size_t)l * DM * DM * 2), GM, DM, DM}; EpiGate<0> E{CB(c, WS_GT), CB(c, WS_T), CB(c, WS_MG)};
#ifndef NO_P6
                  pg8::gemm_phase<EpiGate<0>, pg8::StaticOrder, true, true>(lds, g, So, E);
#endif
                }
            }
            {
                const Ctx c = make_ctx(gi, l); unsigned char* ws = c.ws;
                pg8::StaticOrder So; So.init(GM, DM, gridDim.x, blockIdx.x);
                { pg8::Gemm g{CB(c, WS_MZ), (const bf16_t*)(ws + WS_WM + (size_t)l * DM * DM * 2), GM, DM, DM}; EpiGate<1> E{CB(c, WS_GT), CB(c, WS_T), CB(c, WS_MG)};
#ifndef NO_P6
                  pg8::gemm_phase<EpiGate<1>, pg8::StaticOrder, true, true>(lds, g, So, E);
#endif
                }
            }
            xcd_barrier(lds);
            {
                const Ctx c = make_ctx(gi, l); unsigned char* ws = c.ws;
                pg8::StaticOrder So; So.init(GM, DM, gridDim.x, blockIdx.x);
                pg8::Gemm g{CB(c, WS_MG), (const bf16_t*)(ws + WS_WO + (size_t)l * DM * DM * 2), GM, DM, DM}; EpiRes E{c.xin, c.xout, CB(c, WS_XN), CF(c, WS_RS), (LAS float*)(lds + 131072 + 4096), l < DEPTH - 1 ? 1 : 0};
#ifndef NO_P7
                pg8::gemm_phase<EpiRes, pg8::StaticOrder, true, true>(lds, g, So, E);
#endif
            }
            if (l == DEPTH - 1 && gi < 2) { const Ctx cn = make_ctx(gi + 1, 0); norm_phase(cn); }
            xcd_barrier(lds);
        }
    }
}

extern "C" void kernel_launch(void* const* d_in, const int* in_sizes, int n_in, void* d_out, int out_size, void* d_ws, size_t ws_size, hipStream_t stream) {
    static int grid = 0;
    if (grid == 0) {
        if (n_in != 13 || ws_size < WS_END) { fprintf(stderr, "kernel_launch: need 13 inputs and >= %zu bytes of workspace (got %d, %zu)\n", (size_t)WS_END, n_in, ws_size); grid = -1; return; }
        int dev = 0, cus = 0, per_cu = 0;
        hipGetDevice(&dev);
        hipDeviceGetAttribute(&cus, hipDeviceAttributeMultiprocessorCount, dev);
        if (hipFuncSetAttribute((const void*)fwd_megakernel, hipFuncAttributeMaxDynamicSharedMemorySize, LDS_BYTES) != hipSuccess) { fprintf(stderr, "kernel_launch: hipFuncSetAttribute failed\n"); grid = -1; return; }
        if (hipOccupancyMaxActiveBlocksPerMultiprocessor(&per_cu, (const void*)fwd_megakernel, 512, LDS_BYTES) != hipSuccess || per_cu < 1) { fprintf(stderr, "kernel_launch: occupancy query failed (%d)\n", per_cu); per_cu = 1; }
        (void)hipGetLastError();
        grid = cus;
    }
    if (grid < 0) return;
    Args a{};
    a.x_prompt = (const float*)d_in[0]; a.x_sample = (const float*)d_in[1]; a.norm_g = (const float*)d_in[2]; a.w_in = (const float*)d_in[3]; a.b_in = (const float*)d_in[4];
    a.q_norm_g = (const float*)d_in[5]; a.k_norm_g = (const float*)d_in[6]; a.sink = (const float*)d_in[7]; a.conv_w = (const float*)d_in[8]; a.m_norm_g = (const float*)d_in[9];
    a.w_att_out = (const float*)d_in[10]; a.w_m_out = (const float*)d_in[11]; a.w_out = (const float*)d_in[12];
    a.out = (float*)d_out; a.ws = (unsigned char*)d_ws;
    void* args[] = {&a};
    hipError_t e = hipLaunchCooperativeKernel((const void*)fwd_megakernel, dim3(grid), dim3(512), args, LDS_BYTES, stream);
    if (e != hipSuccess) fprintf(stderr, "kernel_launch: cooperative launch failed: %s (grid %d)\n", hipGetErrorString(e), grid);
}
```

```cpp
#include <hip/hip_runtime.h>
#include <hip/hip_cooperative_groups.h>
#include <cstdio>
#include <cstdint>
namespace cg = cooperative_groups;

#define LAS __attribute__((address_space(3)))
typedef unsigned short bf16_t;
typedef short bf16x8 __attribute__((ext_vector_type(8)));
typedef float f32x4 __attribute__((ext_vector_type(4)));
typedef float f32x16 __attribute__((ext_vector_type(16)));
typedef unsigned u32x4 __attribute__((ext_vector_type(4)));
typedef unsigned u32x2 __attribute__((ext_vector_type(2)));

constexpr int DM = 1024, DEPTH = 4, IN_DIM = 9760, NPHYS = 9984, NTILE_IN = 39;
constexpr int GM = 16384;
constexpr float NORM_EPS = 1e-6f;
constexpr float KSCALE = 0.08838834764831845f;

constexpr size_t MiB = 1u << 20;
constexpr size_t WS_MB = 0, WS_BAR = 512 * 1024;
constexpr size_t WS_ROPE = 1 * MiB;
constexpr size_t WS_BIAS = 2 * MiB;
constexpr size_t WS_WIN = 3 * MiB;
constexpr size_t WIN_BYTES = (size_t)NPHYS * DM * 2;
constexpr size_t WS_WA = 81 * MiB, WS_WM = 89 * MiB, WS_WO = 97 * MiB;
constexpr size_t WS_AZ = 105 * MiB;
constexpr size_t WS_Q = 137 * MiB, WS_K = 169 * MiB, WS_V = 177 * MiB;
constexpr size_t WS_MQ = 185 * MiB, WS_MK = 217 * MiB, WS_MV = 249 * MiB, WS_XN = 281 * MiB;
constexpr size_t WS_MO = 313 * MiB, WS_MZ = 345 * MiB, WS_GT = 377 * MiB, WS_IF = 441 * MiB;
constexpr size_t WS_QC = 443 * MiB, WS_KC = 475 * MiB, WS_KT = 507 * MiB, WS_VT = 539 * MiB;
constexpr size_t WS_SA = 571 * MiB, WS_SCM = 572 * MiB, WS_SB = 573 * MiB;
constexpr size_t WS_EA = 574 * MiB, WS_NP = 575 * MiB, WS_MP = 575 * MiB + 768 * 1024, WS_RS = 576 * MiB, WS_END = 577 * MiB;
constexpr size_t WS_HF = WS_MQ, WS_HB = WS_MK;
constexpr size_t WS_CP = WS_MV;
constexpr size_t WS_T = WS_QC, WS_MG = WS_KC;

constexpr int LDS_BYTES = 147456;

typedef __bf16 bf16v2_t __attribute__((ext_vector_type(2)));
typedef float f32v2_t __attribute__((ext_vector_type(2)));
__device__ __forceinline__ unsigned cvt_pk_bf16(float lo, float hi) { const f32v2_t v = {lo, hi}; return __builtin_bit_cast(unsigned, __builtin_convertvector(v, bf16v2_t)); }
__device__ __forceinline__ float bflo(unsigned w) { return __uint_as_float(w << 16); }
__device__ __forceinline__ float bfhi(unsigned w) { return __uint_as_float(w & 0xffff0000u); }
__device__ __forceinline__ float fexp(float x) { return __builtin_amdgcn_exp2f(x * 1.4426950408889634f); }
__device__ __forceinline__ int crow(int r, int hi) { return (r & 3) + 8 * (r >> 2) + 4 * hi; }
__device__ __forceinline__ int tid_opaque() { int t = threadIdx.x; asm volatile("" : "+v"(t)); return t; }
__device__ __forceinline__ float shfl_x(float v, int lane, int m) { return __int_as_float(__builtin_amdgcn_ds_bpermute((lane ^ m) << 2, __float_as_int(v))); }
__device__ __forceinline__ float shfl_u(float v, int lane, int o) { int src = lane - o; src = src < 0 ? lane : src; return __int_as_float(__builtin_amdgcn_ds_bpermute(src << 2, __float_as_int(v))); }
#define MFMA32(a, b, c) __builtin_amdgcn_mfma_f32_32x32x16_bf16((a), (b), (c), 0, 0, 0)

namespace pg8 {
constexpr int BM = 256, BK = 64, HALF = 128, HTB = HALF * BK * 2, STAGE_BYTES = 8 * HTB, NXCD = 8, WGM = 8;
__host__ __device__ __forceinline__ int lds_byte(int r, int c) { const int st = (r >> 4) * 2 + (c >> 5), rr = r & 15, cc = c & 31, ob = rr * 64 + cc * 2; return st * 1024 + (ob ^ (((ob >> 9) & 1) << 5)); }
__host__ __device__ __forceinline__ void stage_rc(int b, int& R, int& C) { const int st = b / 1024, sb = b % 1024, swz = sb ^ (((sb >> 9) & 1) << 5); R = (st >> 1) * 16 + swz / 64; C = (st & 1) * 32 + (swz % 64) / 2; }
__host__ __device__ __forceinline__ int perm32(int rho) { const int n = rho >> 4, i = rho & 15; return 8 * (i >> 2) + 4 * n + (i & 3); }

struct Unit { int pm, pn; };
struct Gemm { const bf16_t* A; const bf16_t* Bt; int M, N, K; };

struct StaticOrder {
    int nM, nN, nwg, G, c;
    __host__ __device__ void init(int M, int N, int G_, int c_) { nM = M / BM; nN = N / BM; nwg = nM * nN; G = G_; c = c_; }
    __host__ __device__ bool next(int i, Unit& u) const {
        const long L = (long)i * G + c; if (L >= nwg) return false;
        int wgid = (int)L; { const int q = nwg / NXCD, r = nwg % NXCD, xcd = wgid % NXCD, off = wgid / NXCD; wgid = (xcd < r ? xcd * (q + 1) : r * (q + 1) + (xcd - r) * q) + off; }
        const int nig = WGM * nN, gid = wgid / nig, fm = gid * WGM, gsz = (nM - fm) < WGM ? (nM - fm) : WGM;
        u.pm = fm + ((wgid % nig) % gsz); u.pn = (wgid % nig) / gsz; return true;
    }
    __device__ __forceinline__ void a_ready(const Unit&) const {}
    __device__ __forceinline__ void done(const Unit&) const {}
};

template <class Epi, class Sched, bool ALIGN_EPI = false, bool SP2 = false>
__device__ __forceinline__ void gemm_phase(LAS unsigned char* lds, const Gemm g, const Sched& S, const Epi& E) {
    const int tid = tid_opaque(), wid = __builtin_amdgcn_readfirstlane(tid >> 6), lane = tid & 63, wr = wid >> 2, wc = wid & 3, fr = lane & 15, fq = lane >> 4;
    const int K = g.K, nt = K / BK;
    unsigned voffA[2], voffB[2];
#pragma unroll
    for (int i = 0; i < 2; ++i) { int R, C; stage_rc(tid * 16 + i * 8192, R, C); const int Rb = Epi::PERM ? ((R & ~31) + perm32(R & 31)) : R;
        voffA[i] = (unsigned)(R * K + C) * 2u; voffB[i] = (unsigned)(Rb * K + C) * 2u; }
    const size_t kstep = (size_t)(BK * 2);
    const size_t hstep = (size_t)HALF * K * 2;
    const size_t tstep = 2 * hstep;
    const unsigned ldsw = (unsigned)wid * 1024u;
    const int aoff = lds_byte(wr * 64 + fr, fq * 8), boff = lds_byte(wc * 32 + fr, fq * 8);
#define PG8_SA(b, h) (((b) * 2 + (h)) * HTB)
#define PG8_SB(b, h) ((4 + (b) * 2 + (h)) * HTB)
#define PG8_STAGE(bufoff, gbase, voff) do { _Pragma("unroll") for (int _i = 0; _i < 2; ++_i) \
        __builtin_amdgcn_global_load_lds((const unsigned*)((const char*)(gbase) + (voff)[_i]), (LAS unsigned*)(lds + (bufoff) + ldsw + _i * 8192), 16, 0, 0); } while (0)
#define PG8_LDA(dst, b, h) do { _Pragma("unroll") for (int m = 0; m < 4; ++m) _Pragma("unroll") for (int k = 0; k < 2; ++k) dst[m][k] = *(const LAS bf16x8*)(lds + PG8_SA(b, h) + aoff + m * 2048 + k * 1024); } while (0)
#define PG8_LDB(dst, b, h) do { _Pragma("unroll") for (int n = 0; n < 2; ++n) _Pragma("unroll") for (int k = 0; k < 2; ++k) dst[n][k] = *(const LAS bf16x8*)(lds + PG8_SB(b, h) + boff + n * 2048 + k * 1024); } while (0)
#define PG8_MMA(ai, bj, At, Bt) do { __builtin_amdgcn_s_setprio(1); _Pragma("unroll") for (int m = 0; m < 4; ++m) _Pragma("unroll") for (int n = 0; n < 2; ++n) _Pragma("unroll") for (int k = 0; k < 2; ++k) \
        acc[ai][bj][m][n] = __builtin_amdgcn_mfma_f32_16x16x32_bf16(Bt[n][k], At[m][k], acc[ai][bj][m][n], 0, 0, 0); __builtin_amdgcn_s_setprio(0); } while (0)
#define PG8_WAIT_V(n) asm volatile("s_waitcnt vmcnt(" #n ")" ::: "memory")
#define PG8_WAIT_L(n) asm volatile("s_waitcnt lgkmcnt(" #n ")" ::: "memory")
#define PG8_BAR __builtin_amdgcn_s_barrier()
#define PG8_SCHED __builtin_amdgcn_sched_barrier(0)
    Unit cur, nxt; int ui = 0;
    if (!S.next(0, cur)) return;
    f32x4 acc[2][2][4][2];
#pragma unroll
    for (int a = 0; a < 2; ++a)
#pragma unroll
        for (int b = 0; b < 2; ++b)
#pragma unroll
            for (int m = 0; m < 4; ++m)
#pragma unroll
                for (int n = 0; n < 2; ++n) acc[a][b][m][n] = (f32x4){0.f, 0.f, 0.f, 0.f};
    bf16x8 At[4][2], B0[2][2], B1[2][2];
    const char* cA = (const char*)g.A + (size_t)cur.pm * tstep; const char* cB = (const char*)g.Bt + (size_t)cur.pn * tstep;
    S.a_ready(cur);
    if constexpr (SP2) {
        PG8_STAGE(PG8_SB(0, 0), cB, voffB); PG8_STAGE(PG8_SB(0, 1), cB + hstep, voffB); PG8_STAGE(PG8_SA(0, 0), cA, voffA); PG8_STAGE(PG8_SA(0, 1), cA + hstep, voffA);
        if (wr == 1) PG8_BAR;
        PG8_WAIT_V(2); PG8_BAR;
        PG8_STAGE(PG8_SB(1, 0), cB + kstep, voffB); PG8_STAGE(PG8_SA(1, 0), cA + kstep, voffA); PG8_STAGE(PG8_SB(1, 1), cB + hstep + kstep, voffB);
        PG8_WAIT_V(6); PG8_BAR;
    } else {
        PG8_STAGE(PG8_SB(0, 0), cB, voffB); PG8_STAGE(PG8_SA(0, 0), cA, voffA); PG8_STAGE(PG8_SB(0, 1), cB + hstep, voffB); PG8_STAGE(PG8_SA(0, 1), cA + hstep, voffA);
        if (wr == 1) PG8_BAR;
        PG8_WAIT_V(4); PG8_BAR;
        PG8_STAGE(PG8_SB(1, 0), cB + kstep, voffB); PG8_STAGE(PG8_SA(1, 0), cA + kstep, voffA); PG8_STAGE(PG8_SB(1, 1), cB + hstep + kstep, voffB);
        PG8_WAIT_V(6); PG8_BAR;
    }
    for (;;) {
        const bool has_next = S.next(ui + 1, nxt);
        const char* nA = has_next ? (const char*)g.A + (size_t)nxt.pm * tstep : cA; const char* nB = has_next ? (const char*)g.Bt + (size_t)nxt.pn * tstep : cB;
        for (int t = 0; t < nt; t += 2) {
            const bool last = (t == nt - 2);
            const char* a1 = cA + (size_t)(t + 1) * kstep;
            const char* a2 = last ? nA : cA + (size_t)(t + 2) * kstep; const char* b2 = last ? nB : cB + (size_t)(t + 2) * kstep;
            const char* a3 = a2 + kstep; const char* b3 = b2 + kstep;
            if (last && has_next) S.a_ready(nxt);
            if constexpr (SP2) {
            PG8_LDB(B0, 0, 0); PG8_LDB(B1, 0, 1); PG8_SCHED; PG8_LDA(At, 0, 0); PG8_STAGE(PG8_SA(1, 1), a1 + hstep, voffA);
            PG8_WAIT_V(8); PG8_WAIT_L(0); PG8_BAR; PG8_MMA(0, 0, At, B0); PG8_MMA(0, 1, At, B1); PG8_BAR; PG8_SCHED;
            PG8_LDA(At, 0, 1); PG8_STAGE(PG8_SB(0, 0), b2, voffB); PG8_STAGE(PG8_SB(0, 1), b2 + hstep, voffB); PG8_STAGE(PG8_SA(0, 0), a2, voffA);
            PG8_WAIT_V(8); PG8_WAIT_L(0); PG8_BAR; PG8_MMA(1, 0, At, B0); PG8_MMA(1, 1, At, B1); PG8_BAR; PG8_SCHED;
            PG8_LDB(B0, 1, 0); PG8_LDB(B1, 1, 1); PG8_SCHED; PG8_LDA(At, 1, 0); PG8_STAGE(PG8_SA(0, 1), a2 + hstep, voffA);
            PG8_WAIT_V(8); PG8_WAIT_L(0); PG8_BAR; PG8_MMA(0, 0, At, B0); PG8_MMA(0, 1, At, B1); PG8_BAR; PG8_SCHED;
            PG8_LDA(At, 1, 1); PG8_STAGE(PG8_SB(1, 0), b3, voffB); PG8_STAGE(PG8_SB(1, 1), b3 + hstep, voffB); PG8_STAGE(PG8_SA(1, 0), a3, voffA);
            PG8_WAIT_V(8); PG8_WAIT_L(0); PG8_BAR; PG8_MMA(1, 0, At, B0); PG8_MMA(1, 1, At, B1); PG8_BAR; PG8_SCHED;
            } else {
            PG8_LDB(B0, 0, 0); PG8_SCHED; PG8_LDA(At, 0, 0); PG8_STAGE(PG8_SA(1, 1), a1 + hstep, voffA);
            PG8_WAIT_L(8); PG8_BAR; PG8_WAIT_L(0); PG8_MMA(0, 0, At, B0); PG8_BAR; PG8_SCHED;
            PG8_LDB(B1, 0, 1); PG8_STAGE(PG8_SB(0, 0), b2, voffB);
            PG8_BAR; PG8_WAIT_L(0); PG8_MMA(0, 1, At, B1); PG8_BAR;
            PG8_LDA(At, 0, 1); PG8_STAGE(PG8_SA(0, 0), a2, voffA);
            PG8_BAR; PG8_WAIT_L(0); PG8_MMA(1, 0, At, B0); PG8_BAR; PG8_SCHED;
            PG8_STAGE(PG8_SB(0, 1), b2 + hstep, voffB);
            PG8_WAIT_V(6); PG8_BAR; PG8_MMA(1, 1, At, B1); PG8_BAR;
            PG8_LDB(B0, 1, 0); PG8_SCHED; PG8_LDA(At, 1, 0); PG8_STAGE(PG8_SA(0, 1), a2 + hstep, voffA);
            PG8_WAIT_L(8); PG8_BAR; PG8_WAIT_L(0); PG8_MMA(0, 0, At, B0); PG8_BAR; PG8_SCHED;
            PG8_LDB(B1, 1, 1); PG8_STAGE(PG8_SB(1, 0), b3, voffB);
            PG8_BAR; PG8_WAIT_L(0); PG8_MMA(0, 1, At, B1); PG8_BAR;
            PG8_LDA(At, 1, 1); PG8_STAGE(PG8_SA(1, 0), a3, voffA);
            PG8_BAR; PG8_WAIT_L(0); PG8_MMA(1, 0, At, B0); PG8_BAR; PG8_SCHED;
            PG8_STAGE(PG8_SB(1, 1), b3 + hstep, voffB);
            PG8_WAIT_V(6); PG8_BAR; PG8_MMA(1, 1, At, B1); PG8_BAR;
            }
        }
        if constexpr (ALIGN_EPI) { if (wr == 0) PG8_BAR; }
        E(acc, cur, wr, wc, fr, fq); S.done(cur);
        if (!has_next) break;
#pragma unroll
        for (int a = 0; a < 2; ++a)
#pragma unroll
            for (int b = 0; b < 2; ++b)
#pragma unroll
                for (int m = 0; m < 4; ++m)
#pragma unroll
                    for (int n = 0; n < 2; ++n) acc[a][b][m][n] = (f32x4){0.f, 0.f, 0.f, 0.f};
        cur = nxt; cA = nA; cB = nB; ++ui;
        if constexpr (ALIGN_EPI) { if (wr == 1) PG8_BAR; }
    }
    PG8_WAIT_V(0);
    if constexpr (!ALIGN_EPI) { if (wr == 0) PG8_BAR; }
    PG8_BAR;
#undef PG8_SA
#undef PG8_SB
#undef PG8_STAGE
#undef PG8_LDA
#undef PG8_LDB
#undef PG8_MMA
#undef PG8_WAIT_V
#undef PG8_WAIT_L
#undef PG8_BAR
#undef PG8_SCHED
}
}

__device__ __forceinline__ float row_rscale(const float* rs, int row) {
    const f32x4 a = *(const f32x4*)(rs + (size_t)row * 4);
    return __builtin_amdgcn_rsqf(((a[0] + a[1]) + (a[2] + a[3])) * (1.f / DM) + NORM_EPS);
}

struct EpiProj {
    static constexpr bool PERM = true;
    unsigned char* ws; const float* bias;
    __device__ __forceinline__ void operator()(const f32x4 (&acc)[2][2][4][2], const pg8::Unit& u, int wr, int wc, int fr, int fq) const {
        const int pn = u.pn;
        const int row0 = u.pm * 256 + wr * 64 + fr;
        const int pc0 = pn * 256 + wc * 32 + 8 * fq;
        float rscv[2][4];
#pragma unroll
        for (int ai = 0; ai < 2; ++ai)
#pragma unroll
            for (int m = 0; m < 4; ++m) rscv[ai][m] = row_rscale((const float*)(ws + WS_RS), row0 + ai * 128 + m * 16);
        if (false) {
        } else if (pn == 38) {
            if (wc == 0) {
                f32x4 bv[2];
#pragma unroll
                for (int n = 0; n < 2; ++n) bv[n] = *(const f32x4*)(bias + pc0 + 4 * n);
#pragma unroll
                for (int ai = 0; ai < 2; ++ai)
#pragma unroll
                    for (int m = 0; m < 4; ++m) {
                        const int row = row0 + ai * 128 + m * 16;
                        const float rsc = rscv[ai][m];
#pragma unroll
                        for (int n = 0; n < 2; ++n) {
                            f32x4 v = acc[ai][0][m][n] * rsc + bv[n];
                            if (fq & 1) {
#pragma unroll
                                for (int i = 0; i < 4; ++i) { const float ex = fexp(-fabsf(v[i])); const float l1 = ex < 0.01f ? ex * (1.f - ex * (0.5f - ex * 0.33333333f)) : __logf(1.f + ex); v[i] = fminf(v[i], 0.f) - l1; }
                            }
                            *(f32x4*)((float*)(ws + WS_IF) + (size_t)row * 32 + 8 * fq + 4 * n) = v;
                        }
                    }
            }
        } else {
            size_t doff; int ld, col, act;
            if (pn < 4) { doff = WS_Q; ld = 1024; col = pn * 256; act = 0; }
            else if (pn == 4) { doff = WS_K; ld = 256; col = 0; act = 0; }
            else if (pn == 5) { doff = WS_V; ld = 256; col = 0; act = 0; }
            else if (pn < 10) { doff = WS_AZ; ld = 1024; col = (pn - 6) * 256; act = 1; }
            else if (pn < 14) { doff = WS_MQ; ld = 1024; col = (pn - 10) * 256; act = 0; }
            else if (pn < 18) { doff = WS_MK; ld = 1024; col = (pn - 14) * 256; act = 0; }
            else if (pn < 22) { doff = WS_MV; ld = 1024; col = (pn - 18) * 256; act = 0; }
            else if (pn < 26) { doff = WS_MO; ld = 1024; col = (pn - 22) * 256; act = 2; }
            else if (pn < 30) { doff = WS_MZ; ld = 1024; col = (pn - 26) * 256; act = 1; }
            else { doff = WS_GT; ld = 2048; col = (pn - 30) * 256; act = 2; }
            bf16_t* dst = (bf16_t*)(ws + doff);
            col += wc * 32 + 8 * fq;
            f32x4 bv[2][2];
#pragma unroll
            for (int bj = 0; bj < 2; ++bj)
#pragma unroll
                for (int n = 0; n < 2; ++n) bv[bj][n] = *(const f32x4*)(bias + pc0 + bj * 128 + 4 * n);
#pragma unroll
            for (int ai = 0; ai < 2; ++ai)
#pragma unroll
                for (int m = 0; m < 4; ++m) {
                    bf16_t* rowp = dst + (size_t)(row0 + ai * 128 + m * 16) * ld + col;
                    const float rsc = rscv[ai][m];
#pragma unroll
                    for (int bj = 0; bj < 2; ++bj) {
                        f32x4 v[2];
#pragma unroll
                        for (int n = 0; n < 2; ++n) {
                            v[n] = acc[ai][bj][m][n] * rsc + bv[bj][n];
                            if (act != 0) {
#pragma unroll
                                for (int i = 0; i < 4; ++i) { const float s = __builtin_amdgcn_rcpf(1.f + fexp(-v[n][i])); v[n][i] = act == 1 ? v[n][i] * s : s; }
                            }
                        }
                        u32x4 w; w.x = cvt_pk_bf16(v[0][0], v[0][1]); w.y = cvt_pk_bf16(v[0][2], v[0][3]); w.z = cvt_pk_bf16(v[1][0], v[1][1]); w.w = cvt_pk_bf16(v[1][2], v[1][3]);
                        __builtin_nontemporal_store(w, (u32x4*)(rowp + bj * 128));
                    }
                }
        }
    }
};

template <int MODE> struct EpiGate {
    static constexpr bool PERM = true;
    const bf16_t* GT; bf16_t* T; bf16_t* MG;
    __device__ __forceinline__ void operator()(const f32x4 (&acc)[2][2][4][2], const pg8::Unit& u, int wr, int wc, int fr, int fq) const {
        const int row0 = u.pm * 256 + wr * 64 + fr; const int col0 = u.pn * 256 + wc * 32 + 8 * fq;
        u32x4 gc[2], tc[2];
#pragma unroll
        for (int bj = 0; bj < 2; ++bj) { gc[bj] = *(const u32x4*)(GT + (size_t)row0 * 2048 + MODE * 1024 + col0 + bj * 128); if (MODE == 1) tc[bj] = *(const u32x4*)(T + (size_t)row0 * 1024 + col0 + bj * 128); }
#pragma unroll
        for (int it = 0; it < 8; ++it) {
            const int ai = it >> 2, m = it & 3;
            const size_t row = (size_t)(row0 + ai * 128 + m * 16);
            u32x4 gn[2], tn[2];
            if (it < 7) { const size_t rown = (size_t)(row0 + ((it + 1) >> 2) * 128 + ((it + 1) & 3) * 16);
#pragma unroll
                for (int bj = 0; bj < 2; ++bj) { gn[bj] = *(const u32x4*)(GT + rown * 2048 + MODE * 1024 + col0 + bj * 128); if (MODE == 1) tn[bj] = *(const u32x4*)(T + rown * 1024 + col0 + bj * 128); } }
#pragma unroll
            for (int bj = 0; bj < 2; ++bj) {
                const int col = col0 + bj * 128;
                const u32x4 gw = gc[bj];
                float o[8];
                o[0] = acc[ai][bj][m][0][0] * bflo(gw.x); o[1] = acc[ai][bj][m][0][1] * bfhi(gw.x); o[2] = acc[ai][bj][m][0][2] * bflo(gw.y); o[3] = acc[ai][bj][m][0][3] * bfhi(gw.y);
                o[4] = acc[ai][bj][m][1][0] * bflo(gw.z); o[5] = acc[ai][bj][m][1][1] * bfhi(gw.z); o[6] = acc[ai][bj][m][1][2] * bflo(gw.w); o[7] = acc[ai][bj][m][1][3] * bfhi(gw.w);
                if (MODE == 1) {
                    const u32x4 tw = tc[bj];
                    o[0] += bflo(tw.x); o[1] += bfhi(tw.x); o[2] += bflo(tw.y); o[3] += bfhi(tw.y); o[4] += bflo(tw.z); o[5] += bfhi(tw.z); o[6] += bflo(tw.w); o[7] += bfhi(tw.w);
                }
                u32x4 w; w.x = cvt_pk_bf16(o[0], o[1]); w.y = cvt_pk_bf16(o[2], o[3]); w.z = cvt_pk_bf16(o[4], o[5]); w.w = cvt_pk_bf16(o[6], o[7]);
                *(u32x4*)((MODE == 0 ? T : MG) + row * 1024 + col) = w;
            }
            if (it < 7) {
#pragma unroll
                for (int bj = 0; bj < 2; ++bj) { gc[bj] = gn[bj]; if (MODE == 1) tc[bj] = tn[bj]; } }
            asm volatile("" ::: "memory");
        }
    }
};

struct EpiRes {
    static constexpr bool PERM = false;
    const float* xin; float* xout; bf16_t* xb; float* rsq; LAS float* xl; int wxb;
    __device__ __forceinline__ void operator()(const f32x4 (&acc)[2][2][4][2], const pg8::Unit& u, int wr, int wc, int fr, int fq) const {
        const int row0 = u.pm * 256 + wr * 64 + fr; const int col0 = u.pn * 256 + wc * 32 + 4 * fq; const int lane = fq * 16 + fr;
        f32x4 xc[2][2];
#pragma unroll
        for (int bj = 0; bj < 2; ++bj)
#pragma unroll
            for (int n = 0; n < 2; ++n) xc[bj][n] = *(const f32x4*)(xin + (size_t)row0 * 1024 + col0 + bj * 128 + n * 16);
#pragma unroll
        for (int it = 0; it < 8; ++it) {
            const int ai = it >> 2, m = it & 3;
            const int row = row0 + ai * 128 + m * 16;
            const size_t off = (size_t)row * 1024 + col0;
            f32x4 xn[2][2];
            if (it < 7) { const size_t offn = (size_t)(row0 + ((it + 1) >> 2) * 128 + ((it + 1) & 3) * 16) * 1024 + col0;
#pragma unroll
                for (int bj = 0; bj < 2; ++bj)
#pragma unroll
                    for (int n = 0; n < 2; ++n) xn[bj][n] = *(const f32x4*)(xin + offn + bj * 128 + n * 16); }
            float ss = 0.f;
#pragma unroll
            for (int bj = 0; bj < 2; ++bj)
#pragma unroll
                for (int n = 0; n < 2; ++n) { const f32x4 x = xc[bj][n] + acc[ai][bj][m][n]; *(f32x4*)(xout + off + bj * 128 + n * 16) = x;
                    if (wxb) { u32x2 w; w.x = cvt_pk_bf16(x[0], x[1]); w.y = cvt_pk_bf16(x[2], x[3]); *(u32x2*)(xb + off + bj * 128 + n * 16) = w; }
                    ss += (x[0] * x[0] + x[1] * x[1]) + (x[2] * x[2] + x[3] * x[3]); }
            ss += shfl_x(ss, lane, 16); ss += shfl_x(ss, lane, 32);
            if (fq == 0) xl[(row - u.pm * 256) * 4 + wc] = ss;
            if (it < 7) {
#pragma unroll
                for (int bj = 0; bj < 2; ++bj)
#pragma unroll
                    for (int n = 0; n < 2; ++n) xc[bj][n] = xn[bj][n]; }
            asm volatile("" ::: "memory");
        }
        __syncthreads();
        {
            const int t = wr * 256 + wc * 64 + lane;
            if (t < 256 && wxb) { const f32x4 a = *(const LAS f32x4*)(xl + t * 4); rsq[(size_t)(u.pm * 256 + t) * 4 + u.pn] = (a[0] + a[1]) + (a[2] + a[3]); }
        }
    }
};

struct Ctx {
    int S, nseq, lgn;
    const float* xin; float* xout; unsigned char* ws;
};
#define CB(c, OFF) ((bf16_t*)((c).ws + (OFF)))
#define CF(c, OFF) ((float*)((c).ws + (OFF)))

__device__ __forceinline__ void transpose_item(const float* W, int K, int Nsrc, bf16_t* WT, int kb, int n_src, int n_dst, LAS float* scr, int lane, const float* gk) {
    const int k0 = 64 * kb;
    if (n_src >= 0) {
#pragma unroll 8
        for (int i = 0; i < 32; ++i) { const int kk = 2 * i + (lane >> 5); scr[kk * 33 + (lane & 31)] = W[(size_t)(k0 + kk) * Nsrc + n_src + (lane & 31)] * (gk ? gk[k0 + kk] : 1.f); }
    } else {
#pragma unroll 8
        for (int i = 0; i < 32; ++i) { const int kk = 2 * i + (lane >> 5); scr[kk * 33 + (lane & 31)] = 0.f; }
    }
    asm volatile("s_waitcnt lgkmcnt(0)" ::: "memory");
    const int c = lane & 7;
#pragma unroll
    for (int j = 0; j < 4; ++j) { const int n = (lane >> 3) + 8 * j; const LAS float* s = scr + (8 * c) * 33 + n;
        u32x4 o; o.x = cvt_pk_bf16(s[0 * 33], s[1 * 33]); o.y = cvt_pk_bf16(s[2 * 33], s[3 * 33]); o.z = cvt_pk_bf16(s[4 * 33], s[5 * 33]); o.w = cvt_pk_bf16(s[6 * 33], s[7 * 33]);
        *(u32x4*)(WT + (size_t)(n_dst + n) * K + k0 + 8 * c) = o; }
    asm volatile("s_waitcnt lgkmcnt(0)" ::: "memory");
}
__device__ __forceinline__ int in_block_map(int pb) {
    if (pb < 240) return pb;
    if (pb < 304) return 241 + (pb - 240);
    if (pb == 304) return 240;
    return -1;
}

struct Args {
    const float* x_prompt; const float* x_sample; const float* norm_g; const float* w_in; const float* b_in; const float* q_norm_g; const float* k_norm_g;
    const float* sink; const float* conv_w; const float* m_norm_g; const float* w_att_out; const float* w_m_out; const float* w_out;
    float* out; unsigned char* ws;
};

template <class KP> __device__ __forceinline__ void prologue(KP ka, LAS unsigned char* lds) {
    const int tid = tid_opaque(), lane = tid & 63, wave = tid >> 6;
    const int gw = blockIdx.x * 8 + wave, NGW = gridDim.x * 8;
    LAS float* scr = (LAS float*)(lds + wave * 16384);
    unsigned char* ws = ka->ws;
    constexpr int IT_IN = 16 * 312, IT_SQ = 16 * 32, IT_L = IT_IN + 3 * IT_SQ;
    for (int it = gw; it < DEPTH * IT_L; it += NGW) {
        const int l = it / IT_L; int r = it % IT_L;
        if (r < IT_IN) { const int kb = r / 312, pb = r % 312; const int lb = in_block_map(pb);
            transpose_item(ka->w_in + (size_t)l * DM * IN_DIM, DM, IN_DIM, (bf16_t*)(ws + WS_WIN + l * WIN_BYTES), kb, lb < 0 ? -1 : lb * 32, pb * 32, scr, lane, ka->norm_g + l * DM); continue; }
        r -= IT_IN;
        const int which = r / IT_SQ; r %= IT_SQ; const int kb = r / 32, nb = r % 32;
        const float* W = (which == 0 ? ka->w_att_out : which == 1 ? ka->w_m_out : ka->w_out) + (size_t)l * DM * DM;
        bf16_t* WT = (bf16_t*)(ws + (which == 0 ? WS_WA : which == 1 ? WS_WM : WS_WO) + (size_t)l * DM * DM * 2);
        transpose_item(W, DM, DM, WT, kb, nb * 32, nb * 32, scr, lane, nullptr);
    }
    const int gt = blockIdx.x * 512 + tid, NT = gridDim.x * 512;
    for (int i = gt; i < DEPTH * NPHYS; i += NT) { const int l = i / NPHYS, p = i % NPHYS; const int lb = in_block_map(p >> 5);
        ((float*)(ws + WS_BIAS))[i] = lb < 0 ? 0.f : ka->b_in[(size_t)l * IN_DIM + lb * 32 + (p & 31)]; }
    for (int i = gt; i < 4096 * 8; i += NT) { const int pos = i >> 3, j = i & 7;
        const float inv = j == 0 ? 1.0f : j == 1 ? 0.1939227432012558f : j == 2 ? 0.03760603070259094f : j == 3 ? 0.007292664609849453f : j == 4 ? 0.0014142135623842478f : j == 5 ? 0.00027424818836152554f : j == 6 ? 5.318296098266728e-05f : 1.0313386155758053e-05f;
        const float ang = (float)pos * inv;
        const double rev = (double)ang * 0.15915494309189535; const double fr = rev - __builtin_rint(rev);
        const float f = (float)fr;
        ((float*)(ws + WS_ROPE))[2 * i] = __builtin_amdgcn_cosf(f); ((float*)(ws + WS_ROPE))[2 * i + 1] = __builtin_amdgcn_sinf(f); }
    if (gt < DEPTH) { float mq = 0.f, mk = 0.f; for (int i = 0; i < 64; ++i) { mq = fmaxf(mq, fabsf(ka->q_norm_g[gt * 64 + i])); mk = fmaxf(mk, fabsf(ka->k_norm_g[gt * 64 + i])); }
        ((float*)(ws + WS_MB))[gt] = 8.f * mq * mk; }
}

__device__ __forceinline__ void norm_phase(const Ctx& c) {
    const int tid = tid_opaque(); const int lane = tid & 63, wave = tid >> 6;
    const int gw = blockIdx.x * 8 + wave, NGW = gridDim.x * 8;
    for (int m = gw; m < GM; m += NGW) {
        const f32x4* xr = (const f32x4*)(c.xin + (size_t)m * DM) + lane;
        f32x4 v[4]; float s = 0.f;
#pragma unroll
        for (int j = 0; j < 4; ++j) { v[j] = xr[64 * j]; s += (v[j].x * v[j].x + v[j].y * v[j].y) + (v[j].z * v[j].z + v[j].w * v[j].w); }
#pragma unroll
        for (int o = 1; o < 64; o <<= 1) s += shfl_x(s, lane, o);
        if (lane < 4) CF(c, WS_RS)[(size_t)m * 4 + lane] = lane == 0 ? s : 0.f;
        u32x2* o8 = (u32x2*)(CB(c, WS_XN) + (size_t)m * DM) + lane;
#pragma unroll
        for (int j = 0; j < 4; ++j) { u32x2 w; w.x = cvt_pk_bf16(v[j].x, v[j].y); w.y = cvt_pk_bf16(v[j].z, v[j].w); o8[64 * j] = w; }
    }
}

constexpr int AT_KP = 144, AT_VP = 776, AT_VOFF = 384 * AT_KP;
__device__ __forceinline__ void attn_unit(LAS unsigned char* lds, int unit, const Ctx& c, const float* sink, float mb, bf16_t* dstbuf, const float* qg) {
    const int tid = tid_opaque(), lane = tid & 63, w = tid >> 6, l32 = lane & 31, hi = lane >> 5;
    const int S = c.S, nb = S >> 7;
    const int g = unit & 3, qb = (unit >> 2) & (nb - 1), seq = (unit >> 2) >> c.lgn;
    const size_t rowbase = (size_t)seq * S;
    LAS unsigned char* Ks = lds; LAS unsigned char* Vt = lds + AT_VOFF;
    const int hq = g * 4 + (w >> 1);
    u32x4 qwp[2][4]; f32x4 rpp[2][4]; u32x2 zwp[2][8];
#pragma unroll
    for (int hf = 0; hf < 2; ++hf) {
        const int qi_ = ((w & 1) * 2 + hf) * 32 + l32; const size_t qrow_ = rowbase + qb * 128 + qi_;
#pragma unroll
        for (int s = 0; s < 4; ++s) { qwp[hf][s] = *(const u32x4*)(CB(c, WS_Q) + qrow_ * 1024 + hq * 64 + 16 * s + 8 * hi); rpp[hf][s] = *(const f32x4*)((const float*)(c.ws + WS_ROPE) + (qb * 128 + qi_) * 16 + 4 * s); }
#pragma unroll
        for (int k8 = 0; k8 < 8; ++k8) zwp[hf][k8] = *(const u32x2*)(CB(c, WS_AZ) + qrow_ * 1024 + hq * 64 + (k8 >> 2) * 32 + 8 * (k8 & 3) + 4 * hi);
    }
#pragma unroll
    for (int it = 0; it < 6; ++it) { const int idx = tid + it * 512; const int r = idx >> 3, ch = idx & 7; const int kpos = (qb - 1) * 128 + r;
        if (kpos >= 0 && kpos < S) { const u32x4 v = *(const u32x4*)(CB(c, WS_K) + (rowbase + kpos) * 256 + g * 64 + ch * 8); *(LAS u32x4*)(Ks + r * AT_KP + ch * 16) = v; } }
#pragma unroll
    for (int it = 0; it < 3; ++it) { const int idx = tid + it * 512; const int kp = idx >> 3, dg = idx & 7; const int key0 = kp * 2; const int kpos = (qb - 1) * 128 + key0;
        if (kpos >= 0 && kpos < S) {
            const u32x4 va = *(const u32x4*)(CB(c, WS_V) + (rowbase + kpos) * 256 + g * 64 + dg * 8), vb = *(const u32x4*)(CB(c, WS_V) + (rowbase + kpos + 1) * 256 + g * 64 + dg * 8);
            const unsigned aa[4] = {va.x, va.y, va.z, va.w}, bb[4] = {vb.x, vb.y, vb.z, vb.w};
#pragma unroll
            for (int i = 0; i < 8; ++i) { const unsigned lo = (i & 1) ? (aa[i >> 1] >> 16) : (aa[i >> 1] & 0xffffu); const unsigned hh = (i & 1) ? (bb[i >> 1] & 0xffff0000u) : (bb[i >> 1] << 16);
                *(LAS unsigned*)(Vt + (dg * 8 + i) * AT_VP + key0 * 2) = lo | hh; }
        } }
    __syncthreads();
    const float mb2 = mb * 1.4426950408889634f;
    const float sinkv = __builtin_amdgcn_exp2f(sink[hq] * 1.4426950408889634f - mb2);
#pragma unroll 1
    for (int half = 0; half < 2; ++half) {
        const int qt = (w & 1) * 2 + half; const int qi = qt * 32 + l32; const size_t qrow = rowbase + qb * 128 + qi;
        bf16x8 qf[4];
        {
            u32x4 qw[4]; float ss = 0.f;
#pragma unroll
            for (int s = 0; s < 4; ++s) { qw[s] = half ? qwp[1][s] : qwp[0][s];
                const float a0 = bflo(qw[s].x), a1 = bfhi(qw[s].x), a2 = bflo(qw[s].y), a3 = bfhi(qw[s].y), a4 = bflo(qw[s].z), a5 = bfhi(qw[s].z), a6 = bflo(qw[s].w), a7 = bfhi(qw[s].w);
                ss += ((a0 * a0 + a1 * a1) + (a2 * a2 + a3 * a3)) + ((a4 * a4 + a5 * a5) + (a6 * a6 + a7 * a7)); }
            ss += shfl_x(ss, lane, 32);
            const float rs = __builtin_amdgcn_rsqf(ss * (1.f / 64.f) + NORM_EPS) * (0.125f * 1.4426950408889634f);
            float rp[16];
#pragma unroll
            for (int s = 0; s < 4; ++s) { const f32x4 t4 = half ? rpp[1][s] : rpp[0][s]; rp[4 * s] = t4[0]; rp[4 * s + 1] = t4[1]; rp[4 * s + 2] = t4[2]; rp[4 * s + 3] = t4[3]; }
#pragma unroll
            for (int s = 0; s < 4; ++s) {
                const f32x4 g0 = *(const f32x4*)(qg + 16 * s + 8 * hi), g1 = *(const f32x4*)(qg + 16 * s + 8 * hi + 4);
                float v[8] = {bflo(qw[s].x) * rs * g0[0], bfhi(qw[s].x) * rs * g0[1], bflo(qw[s].y) * rs * g0[2], bfhi(qw[s].y) * rs * g0[3],
                              bflo(qw[s].z) * rs * g1[0], bfhi(qw[s].z) * rs * g1[1], bflo(qw[s].w) * rs * g1[2], bfhi(qw[s].w) * rs * g1[3]};
                if (s == 0) {
#pragma unroll
                    for (int j = 0; j < 8; ++j) { const float cs = rp[2 * j], sn = rp[2 * j + 1]; const float pr = shfl_x(v[j], lane, 32);
                        v[j] = hi == 0 ? v[j] * cs - pr * sn : v[j] * cs + pr * sn; }
                }
                u32x4 o; o.x = cvt_pk_bf16(v[0], v[1]); o.y = cvt_pk_bf16(v[2], v[3]); o.z = cvt_pk_bf16(v[4], v[5]); o.w = cvt_pk_bf16(v[6], v[7]);
                qf[s] = __builtin_bit_cast(bf16x8, o);
            }
        }
        f32x16 o0, o1;
#pragma unroll
        for (int r = 0; r < 16; ++r) { o0[r] = 0.f; o1[r] = 0.f; }
        float rsum = 0.f;
        const int bt_lo = qb > 0 ? qt : 4, bt_hi = qb < nb - 1 ? 8 + qt : 7;
        f32x16 pc;
#pragma unroll
        for (int r = 0; r < 16; ++r) pc[r] = -mb2;
#pragma unroll
        for (int s = 0; s < 4; ++s) { const bf16x8 ka = *(const LAS bf16x8*)(Ks + (bt_lo * 32 + l32) * AT_KP + (16 * s + 8 * hi) * 2); pc = MFMA32(ka, qf[s], pc); }
#pragma unroll 1
        for (int bt = bt_lo; bt <= bt_hi; ++bt) {
            const int kj0 = bt * 32;
            const int bn = bt < bt_hi ? bt + 1 : bt;
            f32x16 pn;
#pragma unroll
            for (int r = 0; r < 16; ++r) pn[r] = -mb2;
#pragma unroll
            for (int s = 0; s < 4; ++s) { const bf16x8 ka = *(const LAS bf16x8*)(Ks + (bn * 32 + l32) * AT_KP + (16 * s + 8 * hi) * 2); pn = MFMA32(ka, qf[s], pn); }
            f32x16 p = pc;
            if (bt == qt || bt == 8 + qt) {
#pragma unroll
                for (int r = 0; r < 16; ++r) { const int jr = crow(r, hi);
                    const bool valid = bt < 4 ? (jr >= l32) : (jr <= l32);
                    const float e = valid ? __builtin_amdgcn_exp2f(p[r]) : 0.f; p[r] = e; rsum += e; }
            } else {
#pragma unroll
                for (int r = 0; r < 16; ++r) { const float e = __builtin_amdgcn_exp2f(p[r]); p[r] = e; rsum += e; }
            }
#pragma unroll
            for (int s2 = 0; s2 < 2; ++s2) {
                u32x4 bw; bw.x = cvt_pk_bf16(p[8 * s2 + 0], p[8 * s2 + 1]); bw.y = cvt_pk_bf16(p[8 * s2 + 2], p[8 * s2 + 3]); bw.z = cvt_pk_bf16(p[8 * s2 + 4], p[8 * s2 + 5]); bw.w = cvt_pk_bf16(p[8 * s2 + 6], p[8 * s2 + 7]);
                const bf16x8 b2 = __builtin_bit_cast(bf16x8, bw);
                { const LAS unsigned char* vp = Vt + (l32) * AT_VP + (kj0 + 16 * s2 + 4 * hi) * 2; const u32x2 lo = *(const LAS u32x2*)vp, h2 = *(const LAS u32x2*)(vp + 16);
                  u32x4 aw; aw.x = lo.x; aw.y = lo.y; aw.z = h2.x; aw.w = h2.y; o0 = MFMA32(__builtin_bit_cast(bf16x8, aw), b2, o0); }
                { const LAS unsigned char* vp = Vt + (32 + l32) * AT_VP + (kj0 + 16 * s2 + 4 * hi) * 2; const u32x2 lo = *(const LAS u32x2*)vp, h2 = *(const LAS u32x2*)(vp + 16);
                  u32x4 aw; aw.x = lo.x; aw.y = lo.y; aw.z = h2.x; aw.w = h2.y; o1 = MFMA32(__builtin_bit_cast(bf16x8, aw), b2, o1); }
            }
            pc = pn;
        }
        rsum += shfl_x(rsum, lane, 32);
        const float inv = __builtin_amdgcn_rcpf(rsum + sinkv);
#pragma unroll
        for (int dt = 0; dt < 2; ++dt)
#pragma unroll
            for (int rg = 0; rg < 4; ++rg) {
                const int dim = dt * 32 + 8 * rg + 4 * hi; const size_t off = qrow * 1024 + hq * 64 + dim;
                const u32x2 zw = half ? zwp[1][dt * 4 + rg] : zwp[0][dt * 4 + rg];
                const float v0 = (dt ? o1[4 * rg + 0] : o0[4 * rg + 0]) * inv * bflo(zw.x), v1 = (dt ? o1[4 * rg + 1] : o0[4 * rg + 1]) * inv * bfhi(zw.x);
                const float v2 = (dt ? o1[4 * rg + 2] : o0[4 * rg + 2]) * inv * bflo(zw.y), v3 = (dt ? o1[4 * rg + 3] : o0[4 * rg + 3]) * inv * bfhi(zw.y);
                u32x2 ow; ow.x = cvt_pk_bf16(v0, v1); ow.y = cvt_pk_bf16(v2, v3);
                *(u32x2*)(dstbuf + off) = ow;
            }
    }
    __syncthreads();
}


__device__ __forceinline__ void knorm_rows(const Ctx& c, const float* kg) {
    const int tid = tid_opaque(); const int lane = tid & 63, wave = tid >> 6;
    const int gw = blockIdx.x * 8 + wave, NGW = gridDim.x * 8;
    const int d0 = (lane & 3) * 16;
    const float* rope = (const float*)(c.ws + WS_ROPE);
#pragma unroll 2
    for (int m4 = gw; m4 < GM / 4; m4 += NGW) {
        const int m = m4 * 4 + (lane >> 4);
        const int pos = m & (c.S - 1);
        bf16_t* p = CB(c, WS_K) + (size_t)m * 256 + (lane & 15) * 16;
        const float* g = kg + d0;
        const u32x4 w0 = *(const u32x4*)p, w1 = *(const u32x4*)(p + 8);
        const unsigned ww[8] = {w0.x, w0.y, w0.z, w0.w, w1.x, w1.y, w1.z, w1.w};
        float v[16]; float ss = 0.f;
#pragma unroll
        for (int i = 0; i < 16; ++i) { v[i] = (i & 1) ? bfhi(ww[i >> 1]) : bflo(ww[i >> 1]); ss += v[i] * v[i]; }
        ss += shfl_x(ss, lane, 1); ss += shfl_x(ss, lane, 2);
        const float rs = __builtin_amdgcn_rsqf(ss * (1.f / 64.f) + NORM_EPS);
#pragma unroll
        for (int i = 0; i < 16; ++i) v[i] = v[i] * rs * g[i];
        if ((lane & 3) == 0) {
#pragma unroll
            for (int j = 0; j < 8; ++j) { const float cs = rope[pos * 16 + 2 * j], sn = rope[pos * 16 + 2 * j + 1]; const float x1 = v[j], x2 = v[j + 8]; v[j] = x1 * cs - x2 * sn; v[j + 8] = x2 * cs + x1 * sn; }
        }
        u32x4 o0, o1; o0.x = cvt_pk_bf16(v[0], v[1]); o0.y = cvt_pk_bf16(v[2], v[3]); o0.z = cvt_pk_bf16(v[4], v[5]); o0.w = cvt_pk_bf16(v[6], v[7]);
        o1.x = cvt_pk_bf16(v[8], v[9]); o1.y = cvt_pk_bf16(v[10], v[11]); o1.z = cvt_pk_bf16(v[12], v[13]); o1.w = cvt_pk_bf16(v[14], v[15]);
        *(u32x4*)p = o0; *(u32x4*)(p + 8) = o1;
    }
}

constexpr int PR_P = 260;
__device__ __forceinline__ void prep_unit(LAS unsigned char* lds, int unit, const Ctx& c, const float* cw) {
    const int tid = tid_opaque();
    const int S = c.S, nc = S >> 7;
    const int ch = unit & (nc - 1), h = (unit >> c.lgn) & 7, seq = unit >> (c.lgn + 3);
    const size_t rowbase = (size_t)seq * S; const int t0 = ch * 128;
    LAS unsigned char* Tk = lds; LAS unsigned char* Tv = lds + 128 * PR_P;
    const size_t hb = (size_t)(seq * 8 + h) * S * 128;
#pragma unroll 2
    for (int it = 0; it < 4; ++it) {
        const int idx = tid + it * 512; const int l = idx >> 4, dg = idx & 15; const int t = t0 + l; const int col = h * 128 + dg * 8;
#pragma unroll
        for (int qk = 0; qk < 2; ++qk) {
            const bf16_t* src = qk ? CB(c, WS_MK) : CB(c, WS_MQ);
            const u32x4 z = {0u, 0u, 0u, 0u};
            const u32x4 xm = t > 0 ? *(const u32x4*)(src + (rowbase + t - 1) * 1024 + col) : z;
            const u32x4 x0 = *(const u32x4*)(src + (rowbase + t) * 1024 + col);
            const u32x4 xp = t < S - 1 ? *(const u32x4*)(src + (rowbase + t + 1) * 1024 + col) : z;
            const float* w0 = cw + qk * 1024 + col; const float* w1 = w0 + 2048; const float* w2 = w1 + 2048;
            const unsigned am[4] = {xm.x, xm.y, xm.z, xm.w}, a0[4] = {x0.x, x0.y, x0.z, x0.w}, ap[4] = {xp.x, xp.y, xp.z, xp.w};
            float y[8];
#pragma unroll
            for (int i = 0; i < 8; ++i) {
                const float vm = (i & 1) ? bfhi(am[i >> 1]) : bflo(am[i >> 1]), v0 = (i & 1) ? bfhi(a0[i >> 1]) : bflo(a0[i >> 1]), vp = (i & 1) ? bfhi(ap[i >> 1]) : bflo(ap[i >> 1]);
                float s = vm * w0[i] + v0 * w1[i] + vp * w2[i];
                s = s * __builtin_amdgcn_rcpf(1.f + fexp(-s));
                y[i] = qk ? s * KSCALE : s;
            }
            u32x4 o; o.x = cvt_pk_bf16(y[0], y[1]); o.y = cvt_pk_bf16(y[2], y[3]); o.z = cvt_pk_bf16(y[4], y[5]); o.w = cvt_pk_bf16(y[6], y[7]);
            *(u32x4*)((qk ? CB(c, WS_KC) : CB(c, WS_QC)) + hb + (size_t)(t >> 5) * 4096 + dg * 256 + (t & 31) * 8) = o;
            if (qk) { LAS unsigned* tp = (LAS unsigned*)(Tk + l * PR_P + dg * 16); tp[0] = o.x; tp[1] = o.y; tp[2] = o.z; tp[3] = o.w; }
        }
        { const u32x4 v = *(const u32x4*)(CB(c, WS_MV) + (rowbase + t) * 1024 + col); LAS unsigned* tp = (LAS unsigned*)(Tv + l * PR_P + dg * 16); tp[0] = v.x; tp[1] = v.y; tp[2] = v.z; tp[3] = v.w; }
    }
    __syncthreads();
#pragma unroll 2
    for (int it = 0; it < 4; ++it) {
        const int idx = tid + it * 512; const int d = idx & 127, lg = idx >> 7;
#pragma unroll
        for (int kv = 0; kv < 2; ++kv) {
            const LAS unsigned char* T = kv ? Tv : Tk;
            unsigned short e[8];
#pragma unroll
            for (int i = 0; i < 8; ++i) e[i] = *(const LAS unsigned short*)(T + (lg * 8 + i) * PR_P + d * 2);
            u32x4 o; o.x = e[0] | ((unsigned)e[1] << 16); o.y = e[2] | ((unsigned)e[3] << 16); o.z = e[4] | ((unsigned)e[5] << 16); o.w = e[6] | ((unsigned)e[7] << 16);
            *(u32x4*)((kv ? CB(c, WS_VT) : CB(c, WS_KT)) + hb + (size_t)ch * 16384 + (d >> 5) * 4096 + lg * 256 + (d & 31) * 8) = o;
        }
    }
    __syncthreads();
}

__device__ __forceinline__ void scan_job(int job, const Ctx& c) {
    const int lane = tid_opaque() & 63;
    const int S = c.S, nc = S >> 7;
    const int ch = job & (nc - 1), dir = (job >> c.lgn) & 1, h = (job >> (c.lgn + 1)) & 7, seq = job >> (c.lgn + 4);
    const size_t rowbase = (size_t)seq * S; const int t0 = ch * 128;
    const int p0 = dir ? 127 - 2 * lane : 2 * lane, p1 = dir ? 126 - 2 * lane : 2 * lane + 1;
    const float* r0 = CF(c, WS_IF) + (rowbase + t0 + p0) * 32 + dir * 16 + h; const float* r1 = CF(c, WS_IF) + (rowbase + t0 + p1) * 32 + dir * 16 + h;
    const float li0 = r0[0], lf0 = r0[8], li1 = r1[0], lf1 = r1[8];
    float s = lf0 + lf1;
#pragma unroll
    for (int o = 1; o < 64; o <<= 1) { const float y = shfl_u(s, lane, o); if (lane >= o) s += y; }
    const float b1 = s, b0 = s - lf1;
    const float a0 = li0 - b0, a1 = li1 - b1;
    float mx = fmaxf(a0, a1);
#pragma unroll
    for (int o = 1; o < 64; o <<= 1) { const float y = shfl_u(mx, lane, o); if (lane >= o) mx = fmaxf(mx, y); }
    float ex = shfl_u(mx, lane, 1); if (lane == 0) ex = -3.0e38f;
    const float cm0 = fmaxf(ex, a0), cm1 = mx;
    const size_t sb = (size_t)((seq * 8 + h) * 2 + dir) * S + t0;
    const float cmL = __int_as_float(__builtin_amdgcn_ds_bpermute(63 << 2, __float_as_int(cm1)));
    bf16_t* ea = CB(c, WS_EA);
    ea[sb + p0] = (bf16_t)(cvt_pk_bf16(fexp(a0 - cmL), 0.f) & 0xffffu); ea[sb + p1] = (bf16_t)(cvt_pk_bf16(fexp(a1 - cmL), 0.f) & 0xffffu);
    CF(c, WS_SA)[sb + p0] = a0 * 1.4426950408889634f; CF(c, WS_SA)[sb + p1] = a1 * 1.4426950408889634f;     CF(c, WS_SCM)[sb + p0] = cm0; CF(c, WS_SCM)[sb + p1] = cm1; CF(c, WS_SB)[sb + p0] = b0; CF(c, WS_SB)[sb + p1] = b1;
}

__device__ __forceinline__ void st_stage(LAS unsigned char* buf, const bf16_t* KTc, const bf16_t* VTc, int w, int lane) {
#pragma unroll
    for (int p = 0; p < 6; ++p) {
        const int piece = w * 6 + p;
        const char* src = piece < 32 ? (const char*)KTc + piece * 1024 : (const char*)VTc + (piece - 32) * 1024;
        __builtin_amdgcn_global_load_lds((const unsigned*)(src + lane * 16), (LAS unsigned*)(buf + piece * 1024), 16, 0, 0);
    }
}
__device__ __forceinline__ void mlstm_state_unit(LAS unsigned char* lds, int unit, const Ctx& c) {
    const int tid = tid_opaque(), lane = tid & 63, w = __builtin_amdgcn_readfirstlane(tid >> 6), l32 = lane & 31, hi = lane >> 5;
    const int S = c.S, nc = S >> 7;
    const int es = unit & 1, dir = (unit >> 1) & 1, h = (unit >> 2) & 7, seq = unit >> 5;
    const size_t hb = (size_t)(seq * 8 + h) * S * 128;
    const int chain = (seq * 8 + h) * 2 + dir;
    const size_t sbase = (size_t)chain * S;
    const int et = w >> 2, dt = w & 3;
    const bf16_t* KTg = CB(c, WS_KT) + hb; const bf16_t* VTg = CB(c, WS_VT) + hb + es * 8192;
    const bf16_t* EAl = CB(c, WS_EA) + sbase;
    const float* scm = CF(c, WS_SCM) + sbase; const float* sbv = CF(c, WS_SB) + sbase;
    bf16_t* CPl = CB(c, WS_CP) + (size_t)chain * nc * 16384 + (es * 2 + et) * 4096 + dt * 1024 + l32 * 8 + 4 * hi;
    bf16_t* NPl = CB(c, WS_NP) + (size_t)chain * nc * 128 + dt * 32 + 4 * hi;
    float* MPl = CF(c, WS_MP) + (size_t)chain * nc;
    const int plast = dir ? 0 : 127;
    const int kofs = dt * 8192 + hi * 512 + l32 * 16, vofs = 32768 + et * 8192 + hi * 512 + l32 * 16;
    f32x16 Cacc, nacc;
#pragma unroll
    for (int r = 0; r < 16; ++r) { Cacc[r] = 0.f; nacc[r] = 0.f; }
    float m_prev = -1e30f;
    u32x4 ea[8]; float cmLn, bLn;
    { const int ch0 = dir ? nc - 1 : 0;
      st_stage(lds, KTg + (size_t)ch0 * 16384, VTg + (size_t)ch0 * 16384, w, lane);
#pragma unroll
      for (int s = 0; s < 8; ++s) ea[s] = *(const u32x4*)(EAl + ch0 * 128 + 16 * s + 8 * hi);
      cmLn = scm[ch0 * 128 + plast]; bLn = sbv[ch0 * 128 + plast]; }
#pragma unroll 1
    for (int step = 0; step < nc; ++step) {
        const int ch = dir ? nc - 1 - step : step;
        const int sn = step + 1 < nc ? step + 1 : step; const int chn = dir ? nc - 1 - sn : sn;
        asm volatile("s_waitcnt vmcnt(0)" ::: "memory"); __syncthreads();
        const LAS unsigned char* buf = lds + (step & 1) * 49152;
        if (step + 1 < nc) st_stage(lds + ((step + 1) & 1) * 49152, KTg + (size_t)chn * 16384, VTg + (size_t)chn * 16384, w, lane);
        const bf16_t* EAn = EAl + chn * 128 + 8 * hi;
#pragma unroll
        for (int rg = 0; rg < 4; ++rg) { u32x2 o; o.x = cvt_pk_bf16(Cacc[4 * rg + 0], Cacc[4 * rg + 1]); o.y = cvt_pk_bf16(Cacc[4 * rg + 2], Cacc[4 * rg + 3]); *(u32x2*)(CPl + (size_t)ch * 16384 + 256 * rg) = o; }
        if (es == 0 && et == 0 && l32 == 0) {
#pragma unroll
            for (int rg = 0; rg < 4; ++rg) { u32x2 o; o.x = cvt_pk_bf16(nacc[4 * rg + 0], nacc[4 * rg + 1]); o.y = cvt_pk_bf16(nacc[4 * rg + 2], nacc[4 * rg + 3]); *(u32x2*)(NPl + (size_t)ch * 128 + 8 * rg) = o; }
            if (dt == 0 && hi == 0) MPl[ch] = m_prev;
        }
        const float cmL = cmLn, bL = bLn;
        cmLn = scm[chn * 128 + plast]; bLn = sbv[chn * 128 + plast];
        const float M_last = fmaxf(m_prev, cmL);
        const float w_c = fexp(m_prev - M_last), w_d = fexp(cmL - M_last);
        f32x16 dC, dn;
#pragma unroll
        for (int r = 0; r < 16; ++r) { dC[r] = 0.f; dn[r] = 0.f; }
#pragma unroll
        for (int s = 0; s < 8; ++s) {
            const bf16x8 kt = *(const LAS bf16x8*)(buf + kofs + s * 1024);
            const u32x4 vw = *(const LAS u32x4*)(buf + vofs + s * 1024), ew = ea[s];
            u32x4 bw; bw.x = cvt_pk_bf16(bflo(vw.x) * bflo(ew.x), bfhi(vw.x) * bfhi(ew.x)); bw.y = cvt_pk_bf16(bflo(vw.y) * bflo(ew.y), bfhi(vw.y) * bfhi(ew.y));
            bw.z = cvt_pk_bf16(bflo(vw.z) * bflo(ew.z), bfhi(vw.z) * bfhi(ew.z)); bw.w = cvt_pk_bf16(bflo(vw.w) * bflo(ew.w), bfhi(vw.w) * bfhi(ew.w));
            dC = MFMA32(kt, __builtin_bit_cast(bf16x8, bw), dC);
            if (et == 0) dn = MFMA32(kt, __builtin_bit_cast(bf16x8, ew), dn);
            ea[s] = *(const u32x4*)(EAn + 16 * s);
        }
#pragma unroll
        for (int r = 0; r < 16; ++r) { Cacc[r] = w_c * Cacc[r] + w_d * dC[r]; nacc[r] = w_c * nacc[r] + w_d * dn[r]; }
        m_prev = bL + M_last;
    }
    asm volatile("s_waitcnt vmcnt(0)" ::: "memory"); __syncthreads();
}

__device__ __forceinline__ void out_stage(LAS unsigned char* buf, int unit, const Ctx& c, int w, int lane) {
    const int S = c.S, nc = S >> 7;
    const int ch = unit & (nc - 1), h = (unit >> c.lgn) & 7, seq = unit >> (c.lgn + 3);
    const size_t hb = (size_t)(seq * 8 + h) * S * 128 + (size_t)ch * 16384;
    const char* q = (const char*)(CB(c, WS_QC) + hb); const char* k = (const char*)(CB(c, WS_KC) + hb);
#pragma unroll
    for (int p = 0; p < 4; ++p) {
        const int piece = w * 4 + p;
        __builtin_amdgcn_global_load_lds((const unsigned*)(q + piece * 1024 + lane * 16), (LAS unsigned*)(buf + piece * 1024), 16, 0, 0);
        __builtin_amdgcn_global_load_lds((const unsigned*)(k + piece * 1024 + lane * 16), (LAS unsigned*)(buf + 32768 + piece * 1024), 16, 0, 0);
    }
}
__device__ __forceinline__ void mlstm_out_unit(const LAS unsigned char* buf, LAS float* xch, int unit, const Ctx& c, const float* mg) {
    const int tid = tid_opaque(), lane = tid & 63, w = __builtin_amdgcn_readfirstlane(tid >> 6), l32 = lane & 31, hi = lane >> 5;
    const int S = c.S, nc = S >> 7;
    const int ch = unit & (nc - 1), h = (unit >> c.lgn) & 7, seq = unit >> (c.lgn + 3);
    const size_t hb = (size_t)(seq * 8 + h) * S * 128;
    const int t0 = ch * 128;
    const int it = w & 3, ep = w >> 2;
    const int i = it * 32 + l32;
    const LAS unsigned char* Ql = buf + hi * 512 + l32 * 16; const LAS unsigned char* Kl = buf + 32768 + hi * 512 + l32 * 16;
    const bf16_t* VTl = CB(c, WS_VT) + hb + (size_t)ch * 16384 + (2 * ep) * 4096;
    const unsigned vlo = (unsigned)(l32 * 8 + 4 * hi), clo = (unsigned)(hi * 256 + l32 * 8), nlo = (unsigned)(8 * hi), alo = (unsigned)(4 * hi);
    bf16x8 qf[8];
#pragma unroll
    for (int s = 0; s < 8; ++s) qf[s] = *(const LAS bf16x8*)(Ql + it * 8192 + s * 1024);
    float hsum[2][16];
#pragma unroll
    for (int r = 0; r < 16; ++r) { hsum[0][r] = 0.f; hsum[1][r] = 0.f; }
#pragma unroll 1
    for (int dir = 0; dir < 2; ++dir) {
        const int chain = (seq * 8 + h) * 2 + dir;
        const size_t sbase = (size_t)chain * S + t0;
        const bf16_t* CPl = CB(c, WS_CP) + ((size_t)chain * nc + ch) * 16384 + (2 * ep) * 4096;
        const bf16_t* NPl = CB(c, WS_NP) + ((size_t)chain * nc + ch) * 128;
        const float* sa = CF(c, WS_SA) + sbase;
        const int jlo = dir ? it : 0, jhi = dir ? 3 : it;
        const float m_prev = CF(c, WS_MP)[(size_t)chain * nc + ch];
        const float cm_i = (CF(c, WS_SCM) + sbase)[(unsigned)i], b_i = (CF(c, WS_SB) + sbase)[(unsigned)i];
        const float M_i = fmaxf(m_prev, cm_i); const float w_i = fexp(m_prev - M_i); const float M_i2 = M_i * 1.4426950408889634f;
        f32x16 ainta, aintb, aqn, anuma, anumb;
#pragma unroll
        for (int r = 0; r < 16; ++r) { ainta[r] = 0.f; aintb[r] = 0.f; aqn[r] = 0.f; anuma[r] = 0.f; anumb[r] = 0.f; }
        float rsum = 0.f;
        f32x16 pc;
#pragma unroll
        for (int r = 0; r < 16; ++r) pc[r] = 0.f;
#pragma unroll
        for (int s = 0; s < 8; ++s) { const bf16x8 kf = *(const LAS bf16x8*)(Kl + jlo * 8192 + s * 1024); pc = MFMA32(kf, qf[s], pc); }
#pragma unroll 1
        for (int jt = jlo; jt <= jhi; ++jt) {
            u32x2 vlc[2][2], vhc[2][2]; f32x4 avc[4];
#pragma unroll
            for (int e2 = 0; e2 < 2; ++e2)
#pragma unroll
                for (int s2 = 0; s2 < 2; ++s2) { const unsigned vo = vlo + (unsigned)(e2 * 4096 + (4 * jt + 2 * s2) * 256); vlc[e2][s2] = *(const u32x2*)(VTl + vo); vhc[e2][s2] = *(const u32x2*)(VTl + (vo + 256u)); }
#pragma unroll
            for (int rg = 0; rg < 4; ++rg) avc[rg] = *(const f32x4*)(sa + (alo + (unsigned)(jt * 32 + 8 * rg)));
            const int jn = jt < jhi ? jt + 1 : jt;
            f32x16 pn;
#pragma unroll
            for (int r = 0; r < 16; ++r) pn[r] = 0.f;
#pragma unroll
            for (int s = 0; s < 8; ++s) { const bf16x8 kf = *(const LAS bf16x8*)(Kl + jn * 8192 + s * 1024); pn = MFMA32(kf, qf[s], pn); }
            f32x16 p = pc;
            if (jt == it) {
#pragma unroll
                for (int r = 0; r < 16; ++r) { const int jr = crow(r, hi);
                    const bool valid = dir ? (jr >= l32) : (jr <= l32);
                    const float dg = valid ? __builtin_amdgcn_exp2f(avc[r >> 2][r & 3] - M_i2) : 0.f; p[r] *= dg; rsum += p[r]; }
            } else {
#pragma unroll
                for (int r = 0; r < 16; ++r) { p[r] *= __builtin_amdgcn_exp2f(avc[r >> 2][r & 3] - M_i2); rsum += p[r]; }
            }
#pragma unroll
            for (int s2 = 0; s2 < 2; ++s2) {
                u32x4 bw; bw.x = cvt_pk_bf16(p[8 * s2 + 0], p[8 * s2 + 1]); bw.y = cvt_pk_bf16(p[8 * s2 + 2], p[8 * s2 + 3]); bw.z = cvt_pk_bf16(p[8 * s2 + 4], p[8 * s2 + 5]); bw.w = cvt_pk_bf16(p[8 * s2 + 6], p[8 * s2 + 7]);
                u32x4 aw; aw.x = vlc[0][s2].x; aw.y = vlc[0][s2].y; aw.z = vhc[0][s2].x; aw.w = vhc[0][s2].y;
                anuma = MFMA32(__builtin_bit_cast(bf16x8, aw), __builtin_bit_cast(bf16x8, bw), anuma);
                u32x4 cw; cw.x = vlc[1][s2].x; cw.y = vlc[1][s2].y; cw.z = vhc[1][s2].x; cw.w = vhc[1][s2].y;
                anumb = MFMA32(__builtin_bit_cast(bf16x8, cw), __builtin_bit_cast(bf16x8, bw), anumb);
            }
            pc = pn;
        }
        {
            bf16x8 cfa[8], nf[8];
#pragma unroll
            for (int s = 0; s < 8; ++s) { cfa[s] = *(const bf16x8*)(CPl + (clo + 512u * s)); nf[s] = *(const bf16x8*)(NPl + (nlo + 16u * s)); }
#pragma unroll
        for (int s = 0; s < 8; ++s) { ainta = MFMA32(cfa[s], qf[s], ainta); aqn = MFMA32(nf[s], qf[s], aqn); }
        }
        asm volatile("" ::: "memory");
        {
            bf16x8 cfb[8];
#pragma unroll
            for (int s = 0; s < 8; ++s) cfb[s] = *(const bf16x8*)(CPl + (clo + 4096u + 512u * s));
#pragma unroll
            for (int s = 0; s < 8; ++s) aintb = MFMA32(cfb[s], qf[s], aintb);
        }
        asm volatile("" ::: "memory");
        const float qn = aqn[0];
        rsum += shfl_x(rsum, lane, 32);
        const float den = w_i * qn + rsum;
        const float dd = fmaxf(fabsf(den), fexp(-(b_i + M_i)));
        const float inv = __builtin_amdgcn_rcpf(dd);
#pragma unroll
        for (int r = 0; r < 16; ++r) { hsum[0][r] += (w_i * ainta[r] + anuma[r]) * inv; hsum[1][r] += (w_i * aintb[r] + anumb[r]) * inv; }
    }
    int h2 = h; asm volatile("" : "+s"(h2));
    const size_t ob = ((size_t)seq * S + t0) * 1024 + h2 * 128 + (2 * ep) * 32; const unsigned oo = (unsigned)(i * 1024 + 4 * hi);
    bf16_t* MOb = CB(c, WS_MO) + ob; bf16_t* MZb = CB(c, WS_MZ) + ob; const float* mgb = mg + h2 * 128 + (2 * ep) * 32;
    u32x2 ow[2][4], zw[2][4];
#pragma unroll
    for (int e2 = 0; e2 < 2; ++e2)
#pragma unroll
        for (int rg = 0; rg < 4; ++rg) { ow[e2][rg] = *(const u32x2*)(MOb + (oo + (unsigned)(e2 * 32 + 8 * rg))); zw[e2][rg] = *(const u32x2*)(MZb + (oo + (unsigned)(e2 * 32 + 8 * rg))); }
    float ss = 0.f;
#pragma unroll
    for (int e2 = 0; e2 < 2; ++e2)
#pragma unroll
        for (int rg = 0; rg < 4; ++rg) { hsum[e2][4 * rg + 0] *= bflo(ow[e2][rg].x); hsum[e2][4 * rg + 1] *= bfhi(ow[e2][rg].x); hsum[e2][4 * rg + 2] *= bflo(ow[e2][rg].y); hsum[e2][4 * rg + 3] *= bfhi(ow[e2][rg].y);
            ss += (hsum[e2][4 * rg + 0] * hsum[e2][4 * rg + 0] + hsum[e2][4 * rg + 1] * hsum[e2][4 * rg + 1]) + (hsum[e2][4 * rg + 2] * hsum[e2][4 * rg + 2] + hsum[e2][4 * rg + 3] * hsum[e2][4 * rg + 3]); }
    ss += shfl_x(ss, lane, 32);
    if (hi == 0) xch[(it * 2 + ep) * 32 + l32] = ss;
    __syncthreads();
    const float tot = xch[(it * 2) * 32 + l32] + xch[(it * 2 + 1) * 32 + l32];
    const float rs = __builtin_amdgcn_rsqf(tot * (1.f / 128.f) + NORM_EPS);
#pragma unroll
    for (int e2 = 0; e2 < 2; ++e2)
#pragma unroll
        for (int rg = 0; rg < 4; ++rg) { const f32x4 gv = *(const f32x4*)(mgb + (alo + (unsigned)(e2 * 32 + 8 * rg)));
            u32x2 o; o.x = cvt_pk_bf16(hsum[e2][4 * rg + 0] * rs * gv[0] * bflo(zw[e2][rg].x), hsum[e2][4 * rg + 1] * rs * gv[1] * bfhi(zw[e2][rg].x));
            o.y = cvt_pk_bf16(hsum[e2][4 * rg + 2] * rs * gv[2] * bflo(zw[e2][rg].y), hsum[e2][4 * rg + 3] * rs * gv[3] * bfhi(zw[e2][rg].y));
            *(u32x2*)(MZb + (oo + (unsigned)(e2 * 32 + 8 * rg))) = o; }
}

__device__ __forceinline__ void post_phase(const Ctx& c, const float* mg) {
    const int tid = tid_opaque(); const int lane = tid & 63, wave = tid >> 6;
    const int gw = blockIdx.x * 8 + wave, NGW = gridDim.x * 8;
    f32x4 gv[4];
#pragma unroll
    for (int j = 0; j < 4; ++j) gv[j] = *(const f32x4*)(mg + lane * 16 + 4 * j);
    for (int m = gw; m < GM; m += NGW) {
        const size_t off = (size_t)m * 1024 + lane * 16;
        const u32x4 ow0 = *(const u32x4*)(CB(c, WS_MO) + off), ow1 = *(const u32x4*)(CB(c, WS_MO) + off + 8);
        const u32x4 zw0 = *(const u32x4*)(CB(c, WS_MZ) + off), zw1 = *(const u32x4*)(CB(c, WS_MZ) + off + 8);
        const unsigned ow[8] = {ow0.x, ow0.y, ow0.z, ow0.w, ow1.x, ow1.y, ow1.z, ow1.w}, zw[8] = {zw0.x, zw0.y, zw0.z, zw0.w, zw1.x, zw1.y, zw1.z, zw1.w};
        float v[16]; float ss = 0.f;
        const u32x4 fa0 = *(const u32x4*)(CB(c, WS_HF) + off), fa1 = *(const u32x4*)(CB(c, WS_HF) + off + 8);
        const unsigned fa[8] = {fa0.x, fa0.y, fa0.z, fa0.w, fa1.x, fa1.y, fa1.z, fa1.w};
#pragma unroll
        for (int e = 0; e < 16; ++e) { const float og = (e & 1) ? bfhi(ow[e >> 1]) : bflo(ow[e >> 1]); const float hs = (e & 1) ? bfhi(fa[e >> 1]) : bflo(fa[e >> 1]); v[e] = og * hs; ss += v[e] * v[e]; }
        ss += shfl_x(ss, lane, 1); ss += shfl_x(ss, lane, 2); ss += shfl_x(ss, lane, 4);
        const float rs = __builtin_amdgcn_rsqf(ss * (1.f / 128.f) + NORM_EPS);
        unsigned o[8];
#pragma unroll
        for (int e = 0; e < 16; e += 2) { const float y0 = v[e] * rs * gv[e >> 2][e & 3] * bflo(zw[e >> 1]), y1 = v[e + 1] * rs * gv[e >> 2][(e + 1) & 3] * bfhi(zw[e >> 1]); o[e >> 1] = cvt_pk_bf16(y0, y1); }
        u32x4 s0, s1; s0.x = o[0]; s0.y = o[1]; s0.z = o[2]; s0.w = o[3]; s1.x = o[4]; s1.y = o[5]; s1.z = o[6]; s1.w = o[7];
        *(u32x4*)(CB(c, WS_MZ) + off) = s0; *(u32x4*)(CB(c, WS_MZ) + off + 8) = s1;
    }
}


typedef const Args __attribute__((address_space(4)))* KArgsP;
__device__ __forceinline__ KArgsP kargs() { unsigned long long p = (unsigned long long)__builtin_amdgcn_kernarg_segment_ptr(); asm volatile("" : "+s"(p)); return (KArgsP)p; }
#define XB_TMO      128
#define XB_XCNT(j)  (256  + 64 * (j))
#define XB_XSUB(j)  (1280 + 64 * (j))
#define XB_XGEN(j)  (2304 + 64 * (j))
#define XB_TOP      3328
#define XB_TOPGEN   3392
#define XCD_BAR_WORDS 3456
#define XB_SPIN_CAP (1u << 20)
__device__ __forceinline__ unsigned xb_ld(unsigned* p)              { return __hip_atomic_load(p, __ATOMIC_RELAXED, __HIP_MEMORY_SCOPE_AGENT); }
__device__ __forceinline__ unsigned xb_add(unsigned* p, unsigned v) { return __hip_atomic_fetch_add(p, v, __ATOMIC_RELAXED, __HIP_MEMORY_SCOPE_AGENT); }
__device__ __forceinline__ unsigned xb_xcc_id() { return (unsigned)__builtin_amdgcn_s_getreg((3 << 11) | 20) & 0xFu; }
#define XB_SPIN(cond, bar) do { unsigned _sp = 0; while (cond) { __builtin_amdgcn_s_sleep(1); \
    if ((++_sp & 255u) == 0u) { if (xb_ld(&(bar)[XB_TMO])) break; if (_sp > XB_SPIN_CAP) { atomicAdd(&(bar)[XB_TMO], 1u); break; } } } } while (0)
struct XcdBarrier { unsigned* bar; unsigned x; volatile LAS unsigned* st; };
__device__ __forceinline__ XcdBarrier xcd_barrier_post(unsigned* bar, volatile LAS unsigned* st) {
    XcdBarrier b; b.bar = bar; b.x = xb_xcc_id(); b.st = st;
    if (threadIdx.x == 0) (void)xb_add(&bar[XB_XCNT(b.x)], 1u);
    return b;
}
__device__ __forceinline__ void xcd_barrier_complete(unsigned* bar, unsigned x, unsigned& nloc, unsigned& nx) {
    const unsigned G = gridDim.x * gridDim.y * gridDim.z;
    unsigned sum, cnt, mine, sp = 0u;
    for (;;) {
        sum = 0u; cnt = 0u; mine = 0u;
#pragma unroll
        for (unsigned j = 0; j < 16; ++j) { const unsigned c = xb_ld(&bar[XB_XCNT(j)]); sum += c; cnt += (c > 0u) ? 1u : 0u; mine = (j == x) ? c : mine; }
        if (sum == G) break;
        __builtin_amdgcn_s_sleep(1);
        if ((++sp & 255u) == 0u) { if (xb_ld(&bar[XB_TMO])) break; if (sp > XB_SPIN_CAP) { atomicAdd(&bar[XB_TMO], 1u); break; } }
    }
    nloc = mine > 0u ? mine : 1u; nx = cnt > 0u ? cnt : 1u;
}
__device__ __forceinline__ void xcd_barrier(LAS unsigned char* lds) {
    XcdBarrier b; b.bar = (unsigned*)(kargs()->ws + WS_BAR); b.x = xb_xcc_id(); b.st = (volatile LAS unsigned*)(lds + 131072 + 256);
    asm volatile("s_waitcnt vmcnt(0)" ::: "memory");
    __syncthreads();
    if (tid_opaque() == 0) {
        unsigned* bar = b.bar;
        __builtin_amdgcn_s_waitcnt(0);
        unsigned nloc = b.st[0], nx = b.st[1];
        if (nloc == 0u) { xcd_barrier_complete(bar, b.x, nloc, nx); b.st[0] = nloc; b.st[1] = nx; }
        const unsigned old = xb_add(&bar[XB_XSUB(b.x)], 1u);
        const unsigned gen = old / nloc;
        if (old + 1u == (gen + 1u) * nloc) {
            __builtin_amdgcn_fence(__ATOMIC_RELEASE, "agent");
            asm volatile("s_waitcnt vmcnt(0)" ::: "memory");
            const unsigned og = xb_add(&bar[XB_TOP], 1u);
            const unsigned tg = og / nx;
            if (og + 1u == (tg + 1u) * nx) xb_add(&bar[XB_TOPGEN], 1u);
            else XB_SPIN(xb_ld(&bar[XB_TOPGEN]) == tg, bar);
            __builtin_amdgcn_fence(__ATOMIC_ACQUIRE, "agent");
            xb_add(&bar[XB_XGEN(b.x)], 1u);
            asm volatile("s_waitcnt vmcnt(0)" ::: "memory");
        } else {
            XB_SPIN(xb_ld(&bar[XB_XGEN(b.x)]) == gen, bar);
            __builtin_amdgcn_fence(__ATOMIC_ACQUIRE, "agent");
            asm volatile("s_waitcnt vmcnt(0)" ::: "memory");
        }
    }
    __syncthreads();
}

__device__ __forceinline__ Ctx make_ctx(int gi, int l) {
    KArgsP ka = kargs();
    Ctx c; c.S = gi == 0 ? 4096 : 2048; c.nseq = gi == 0 ? 4 : 8; c.lgn = gi == 0 ? 5 : 4; c.ws = ka->ws;
    float* outg = ka->out + (size_t)(unsigned)gi * (size_t)(GM * DM);
    const float* x0 = gi == 0 ? ka->x_prompt : (gi == 1 ? ka->x_sample : ka->x_sample + (size_t)GM * DM);
    c.xout = outg; c.xin = l == 0 ? x0 : outg;
    return c;
}

__global__ void __launch_bounds__(512, 2) fwd_megakernel(Args a_unused) {
    extern __shared__ __attribute__((aligned(16))) unsigned char lds_raw[];
    LAS unsigned char* lds = (LAS unsigned char*)lds_raw;
    cg::grid_group grid = cg::this_grid();

    prologue(kargs(), lds);
    { const Ctx c0 = make_ctx(0, 0); norm_phase(c0); }
    {
        unsigned* bw = (unsigned*)(kargs()->ws + WS_BAR);
        if (blockIdx.x == 0) for (int i = threadIdx.x; i < XCD_BAR_WORDS; i += 512) bw[i] = 0u;
        if (threadIdx.x < 2) ((volatile LAS unsigned*)(lds + 131072 + 256))[threadIdx.x] = 0u;
    }
    grid.sync();
    (void)xcd_barrier_post((unsigned*)(kargs()->ws + WS_BAR), (volatile LAS unsigned*)(lds + 131072 + 256));

#pragma unroll 1
#ifdef TEST_NOLOOP
    for (int gi = 0; gi < 1; ++gi) {
#else
    for (int gi = 0; gi < 3; ++gi) {
#endif
#pragma unroll 1
#ifdef TEST_NOLOOP
        for (int l = 0; l < 1; ++l) {
#else
        for (int l = 0; l < DEPTH; ++l) {
#endif
            {
                const Ctx c = make_ctx(gi, l); KArgsP ka = kargs(); unsigned char* ws = c.ws;
                pg8::Gemm g{CB(c, WS_XN), (const bf16_t*)(ws + WS_WIN + l * WIN_BYTES), GM, NPHYS, DM}; pg8::StaticOrder So; So.init(GM, NPHYS, gridDim.x, blockIdx.x);
                EpiProj E{ws, (const float*)(ws + WS_BIAS) + l * NPHYS};
#ifndef NO_P2
                pg8::gemm_phase<EpiProj, pg8::StaticOrder, true, true>(lds, g, So, E);
#endif
            }
            xcd_barrier(lds);
            {
                const Ctx c = make_ctx(gi, l); KArgsP ka = kargs();
                const int G = gridDim.x, bid = blockIdx.x, wave = tid_opaque() >> 6;
                knorm_rows(c, ka->k_norm_g + l * 64);
#ifndef NO_P3B
                for (int u = bid; u < 1024; u += G) prep_unit(lds, u, c, ka->conv_w + (size_t)l * 3 * 2048);
#endif
                for (int j = bid * 8 + wave; j < 2048; j += G * 8) scan_job(j, c);
            }
            xcd_barrier(lds);
            {
                const Ctx c = make_ctx(gi, l); KArgsP ka = kargs();
                const int nu = c.nseq * 32;
                const float mb = ((const float*)(c.ws + WS_MB))[l];
#ifndef NO_P3A
                if (nu == 128 && gridDim.x == 256) {
                    const int b = blockIdx.x;
                    if (b < 128) attn_unit(lds, b, c, ka->sink + l * 16, mb, CB(c, WS_Q), ka->q_norm_g + l * 64);
                    else for (int k = 0; k < 3; ++k) attn_unit(lds, 128 + (b - 128) * 3 + k, c, ka->sink + l * 16, mb, CB(c, WS_Q), ka->q_norm_g + l * 64);
                } else {
                    for (int u = blockIdx.x; u < 512; u += gridDim.x) attn_unit(lds, u, c, ka->sink + l * 16, mb, CB(c, WS_Q), ka->q_norm_g + l * 64);
                }
#endif
#ifndef NO_P4
                for (int u = blockIdx.x; u < nu; u += gridDim.x) mlstm_state_unit(lds, u, c);
#endif
            }
            xcd_barrier(lds);
            {
                const Ctx c = make_ctx(gi, l);
#ifndef NO_P4
                const int tid = tid_opaque(), w = tid >> 6, lane = tid & 63;
                const float* mgp = kargs()->m_norm_g + l * DM;
                int u = blockIdx.x, k = 0;
                if (u < 1024) out_stage(lds, u, c, w, lane);
                for (; u < 1024; u += gridDim.x, ++k) {
                    asm volatile("s_waitcnt vmcnt(0)" ::: "memory"); __syncthreads();
                    const int un = u + gridDim.x;
                    if (un < 1024) out_stage(lds + ((k + 1) & 1) * 65536, un, c, w, lane);
                    mlstm_out_unit(lds + (k & 1) * 65536, (LAS float*)(lds + 131072 + 1024), u, c, mgp);
                }
                asm volatile("s_waitcnt vmcnt(0)" ::: "memory"); __syncthreads();
#endif
            }
            xcd_barrier(lds);
            {
                const Ctx c = make_ctx(gi, l); unsigned char* ws = c.ws;
                pg8::StaticOrder So; So.init(GM, DM, gridDim.x, blockIdx.x);
                { pg8::Gemm g{CB(c, WS_Q), (const bf16_t*)(ws + WS_WA + (size_t)l * DM * DM * 2), GM, DM, DM}; EpiGate<0> E{CB(c, WS_GT), CB(c, WS_T), CB(c, WS_MG)};
#ifndef NO_P6
                  pg8::gemm_phase<EpiGate<0>, pg8::StaticOrder, true, true>(lds, g, So, E);
#endif
                }
            }
            {
                const Ctx c = make_ctx(gi, l); unsigned char* ws = c.ws;
                pg8::StaticOrder So; So.init(GM, DM, gridDim.x, blockIdx.x);
                { pg8::Gemm g{CB(c, WS_MZ), (const bf16_t*)(ws + WS_WM + (size_t)l * DM * DM * 2), GM, DM, DM}; EpiGate<1> E{CB(c, WS_GT), CB(c, WS_T), CB(c, WS_MG)};
#ifndef NO_P6
                  pg8::gemm_phase<EpiGate<1>, pg8::StaticOrder, true, true>(lds, g, So, E);
#endif
                }
            }
            xcd_barrier(lds);
            {
                const Ctx c = make_ctx(gi, l); unsigned char* ws = c.ws;
                pg8::StaticOrder So; So.init(GM, DM, gridDim.x, blockIdx.x);
                pg8::Gemm g{CB(c, WS_MG), (const bf16_t*)(ws + WS_WO + (size_t)l * DM * DM * 2), GM, DM, DM}; EpiRes E{c.xin, c.xout, CB(c, WS_XN), CF(c, WS_RS), (LAS float*)(lds + 131072 + 4096), l < DEPTH - 1 ? 1 : 0};
#ifndef NO_P7
                pg8::gemm_phase<EpiRes, pg8::StaticOrder, true, true>(lds, g, So, E);
#endif
            }
            if (l == DEPTH - 1 && gi < 2) { const Ctx cn = make_ctx(gi + 1, 0); norm_phase(cn); }
            xcd_barrier(lds);
        }
    }
}

extern "C" void kernel_launch(void* const* d_in, const int* in_sizes, int n_in, void* d_out, int out_size, void* d_ws, size_t ws_size, hipStream_t stream) {
    static int grid = 0;
    if (grid == 0) {
        if (n_in != 13 || ws_size < WS_END) { fprintf(stderr, "kernel_launch: need 13 inputs and >= %zu bytes of workspace (got %d, %zu)\n", (size_t)WS_END, n_in, ws_size); grid = -1; return; }
        int dev = 0, cus = 0, per_cu = 0;
        hipGetDevice(&dev);
        hipDeviceGetAttribute(&cus, hipDeviceAttributeMultiprocessorCount, dev);
        if (hipFuncSetAttribute((const void*)fwd_megakernel, hipFuncAttributeMaxDynamicSharedMemorySize, LDS_BYTES) != hipSuccess) { fprintf(stderr, "kernel_launch: hipFuncSetAttribute failed\n"); grid = -1; return; }
        if (hipOccupancyMaxActiveBlocksPerMultiprocessor(&per_cu, (const void*)fwd_megakernel, 512, LDS_BYTES) != hipSuccess || per_cu < 1) { fprintf(stderr, "kernel_launch: occupancy query failed (%d)\n", per_cu); per_cu = 1; }
        (void)hipGetLastError();
        grid = cus;
    }
    if (grid < 0) return;
    Args a{};
    a.x_prompt = (const float*)d_in[0]; a.x_sample = (const float*)d_in[1]; a.norm_g = (const float*)d_in[2]; a.w_in = (const float*)d_in[3]; a.b_in = (const float*)d_in[4];
    a.q_norm_g = (const float*)d_in[5]; a.k_norm_g = (const float*)d_in[6]; a.sink = (const float*)d_in[7]; a.conv_w = (const float*)d_in[8]; a.m_norm_g = (const float*)d_in[9];
    a.w_att_out = (const float*)d_in[10]; a.w_m_out = (const float*)d_in[11]; a.w_out = (const float*)d_in[12];
    a.out = (float*)d_out; a.ws = (unsigned char*)d_ws;
    void* args[] = {&a};
    hipError_t e = hipLaunchCooperativeKernel((const void*)fwd_megakernel, dim3(grid), dim3(512), args, LDS_BYTES, stream);
    if (e != hipSuccess) fprintf(stderr, "kernel_launch: cooperative launch failed: %s (grid %d)\n", hipGetErrorString(e), grid);
}
```

```cpp
#include <hip/hip_runtime.h>
#include <hip/hip_cooperative_groups.h>
#include <cstdio>
#include <cstdint>
namespace cg = cooperative_groups;

#define LAS __attribute__((address_space(3)))
typedef unsigned short bf16_t;
typedef short bf16x8 __attribute__((ext_vector_type(8)));
typedef float f32x4 __attribute__((ext_vector_type(4)));
typedef float f32x16 __attribute__((ext_vector_type(16)));
typedef unsigned u32x4 __attribute__((ext_vector_type(4)));
typedef unsigned u32x2 __attribute__((ext_vector_type(2)));

constexpr int DM = 1024, DEPTH = 4, IN_DIM = 9760, NPHYS = 9984, NTILE_IN = 39;
constexpr int GM = 16384;
constexpr float NORM_EPS = 1e-6f;
constexpr float KSCALE = 0.08838834764831845f;

constexpr size_t MiB = 1u << 20;
constexpr size_t WS_MB = 0, WS_BAR = 512 * 1024;
constexpr size_t WS_ROPE = 1 * MiB;
constexpr size_t WS_BIAS = 2 * MiB;
constexpr size_t WS_WIN = 3 * MiB;
constexpr size_t WIN_BYTES = (size_t)NPHYS * DM * 2;
constexpr size_t WS_WA = 81 * MiB, WS_WM = 89 * MiB, WS_WO = 97 * MiB;
constexpr size_t WS_AZ = 105 * MiB;
constexpr size_t WS_Q = 137 * MiB, WS_K = 169 * MiB, WS_V = 177 * MiB;
constexpr size_t WS_MQ = 185 * MiB, WS_MK = 217 * MiB, WS_MV = 249 * MiB, WS_XN = 281 * MiB;
constexpr size_t WS_MO = 313 * MiB, WS_MZ = 345 * MiB, WS_GT = 377 * MiB, WS_IF = 441 * MiB;
constexpr size_t WS_QC = 443 * MiB, WS_KC = 475 * MiB, WS_KT = 507 * MiB, WS_VT = 539 * MiB;
constexpr size_t WS_SA = 571 * MiB, WS_SCM = 572 * MiB, WS_SB = 573 * MiB;
constexpr size_t WS_EA = 574 * MiB, WS_NP = 575 * MiB, WS_MP = 575 * MiB + 768 * 1024, WS_RS = 576 * MiB, WS_END = 577 * MiB;
constexpr size_t WS_HF = WS_MQ, WS_HB = WS_MK;
constexpr size_t WS_CP = WS_MV;
constexpr size_t WS_T = WS_QC, WS_MG = WS_KC;

constexpr int LDS_BYTES = 147456;

typedef __bf16 bf16v2_t __attribute__((ext_vector_type(2)));
typedef float f32v2_t __attribute__((ext_vector_type(2)));
__device__ __forceinline__ unsigned cvt_pk_bf16(float lo, float hi) { const f32v2_t v = {lo, hi}; return __builtin_bit_cast(unsigned, __builtin_convertvector(v, bf16v2_t)); }
__device__ __forceinline__ float bflo(unsigned w) { return __uint_as_float(w << 16); }
__device__ __forceinline__ float bfhi(unsigned w) { return __uint_as_float(w & 0xffff0000u); }
__device__ __forceinline__ float fexp(float x) { return __builtin_amdgcn_exp2f(x * 1.4426950408889634f); }
__device__ __forceinline__ int crow(int r, int hi) { return (r & 3) + 8 * (r >> 2) + 4 * hi; }
__device__ __forceinline__ int tid_opaque() { int t = threadIdx.x; asm volatile("" : "+v"(t)); return t; }
__device__ __forceinline__ float shfl_x(float v, int lane, int m) { return __int_as_float(__builtin_amdgcn_ds_bpermute((lane ^ m) << 2, __float_as_int(v))); }
__device__ __forceinline__ float shfl_u(float v, int lane, int o) { int src = lane - o; src = src < 0 ? lane : src; return __int_as_float(__builtin_amdgcn_ds_bpermute(src << 2, __float_as_int(v))); }
#define MFMA32(a, b, c) __builtin_amdgcn_mfma_f32_32x32x16_bf16((a), (b), (c), 0, 0, 0)

namespace pg8 {
constexpr int BM = 256, BK = 64, HALF = 128, HTB = HALF * BK * 2, STAGE_BYTES = 8 * HTB, NXCD = 8, WGM = 8;
__host__ __device__ __forceinline__ int lds_byte(int r, int c) { const int st = (r >> 4) * 2 + (c >> 5), rr = r & 15, cc = c & 31, ob = rr * 64 + cc * 2; return st * 1024 + (ob ^ (((ob >> 9) & 1) << 5)); }
__host__ __device__ __forceinline__ void stage_rc(int b, int& R, int& C) { const int st = b / 1024, sb = b % 1024, swz = sb ^ (((sb >> 9) & 1) << 5); R = (st >> 1) * 16 + swz / 64; C = (st & 1) * 32 + (swz % 64) / 2; }
__host__ __device__ __forceinline__ int perm32(int rho) { const int n = rho >> 4, i = rho & 15; return 8 * (i >> 2) + 4 * n + (i & 3); }

struct Unit { int pm, pn; };
struct Gemm { const bf16_t* A; const bf16_t* Bt; int M, N, K; };

struct StaticOrder {
    int nM, nN, nwg, G, c;
    __host__ __device__ void init(int M, int N, int G_, int c_) { nM = M / BM; nN = N / BM; nwg = nM * nN; G = G_; c = c_; }
    __host__ __device__ bool next(int i, Unit& u) const {
        const long L = (long)i * G + c; if (L >= nwg) return false;
        int wgid = (int)L; { const int q = nwg / NXCD, r = nwg % NXCD, xcd = wgid % NXCD, off = wgid / NXCD; wgid = (xcd < r ? xcd * (q + 1) : r * (q + 1) + (xcd - r) * q) + off; }
        const int nig = WGM * nN, gid = wgid / nig, fm = gid * WGM, gsz = (nM - fm) < WGM ? (nM - fm) : WGM;
        u.pm = fm + ((wgid % nig) % gsz); u.pn = (wgid % nig) / gsz; return true;
    }
    __device__ __forceinline__ void a_ready(const Unit&) const {}
    __device__ __forceinline__ void done(const Unit&) const {}
};

template <class Epi, class Sched, bool ALIGN_EPI = false, bool SP2 = false>
__device__ __forceinline__ void gemm_phase(LAS unsigned char* lds, const Gemm g, const Sched& S, const Epi& E) {
    const int tid = tid_opaque(), wid = __builtin_amdgcn_readfirstlane(tid >> 6), lane = tid & 63, wr = wid >> 2, wc = wid & 3, fr = lane & 15, fq = lane >> 4;
    const int K = g.K, nt = K / BK;
    unsigned voffA[2], voffB[2];
#pragma unroll
    for (int i = 0; i < 2; ++i) { int R, C; stage_rc(tid * 16 + i * 8192, R, C); const int Rb = Epi::PERM ? ((R & ~31) + perm32(R & 31)) : R;
        voffA[i] = (unsigned)(R * K + C) * 2u; voffB[i] = (unsigned)(Rb * K + C) * 2u; }
    const size_t kstep = (size_t)(BK * 2);
    const size_t hstep = (size_t)HALF * K * 2;
    const size_t tstep = 2 * hstep;
    const unsigned ldsw = (unsigned)wid * 1024u;
    const int aoff = lds_byte(wr * 64 + fr, fq * 8), boff = lds_byte(wc * 32 + fr, fq * 8);
#define PG8_SA(b, h) (((b) * 2 + (h)) * HTB)
#define PG8_SB(b, h) ((4 + (b) * 2 + (h)) * HTB)
#define PG8_STAGE(bufoff, gbase, voff) do { _Pragma("unroll") for (int _i = 0; _i < 2; ++_i) \
        __builtin_amdgcn_global_load_lds((const unsigned*)((const char*)(gbase) + (voff)[_i]), (LAS unsigned*)(lds + (bufoff) + ldsw + _i * 8192), 16, 0, 0); } while (0)
#define PG8_LDA(dst, b, h) do { _Pragma("unroll") for (int m = 0; m < 4; ++m) _Pragma("unroll") for (int k = 0; k < 2; ++k) dst[m][k] = *(const LAS bf16x8*)(lds + PG8_SA(b, h) + aoff + m * 2048 + k * 1024); } while (0)
#define PG8_LDB(dst, b, h) do { _Pragma("unroll") for (int n = 0; n < 2; ++n) _Pragma("unroll") for (int k = 0; k < 2; ++k) dst[n][k] = *(const LAS bf16x8*)(lds + PG8_SB(b, h) + boff + n * 2048 + k * 1024); } while (0)
#define PG8_MMA(ai, bj, At, Bt) do { __builtin_amdgcn_s_setprio(1); _Pragma("unroll") for (int m = 0; m < 4; ++m) _Pragma("unroll") for (int n = 0; n < 2; ++n) _Pragma("unroll") for (int k = 0; k < 2; ++k) \
        acc[ai][bj][m][n] = __builtin_amdgcn_mfma_f32_16x16x32_bf16(Bt[n][k], At[m][k], acc[ai][bj][m][n], 0, 0, 0); __builtin_amdgcn_s_setprio(0); } while (0)
#define PG8_WAIT_V(n) asm volatile("s_waitcnt vmcnt(" #n ")" ::: "memory")
#define PG8_WAIT_L(n) asm volatile("s_waitcnt lgkmcnt(" #n ")" ::: "memory")
#define PG8_BAR __builtin_amdgcn_s_barrier()
#define PG8_SCHED __builtin_amdgcn_sched_barrier(0)
    Unit cur, nxt; int ui = 0;
    if (!S.next(0, cur)) return;
    f32x4 acc[2][2][4][2];
#pragma unroll
    for (int a = 0; a < 2; ++a)
#pragma unroll
        for (int b = 0; b < 2; ++b)
#pragma unroll
            for (int m = 0; m < 4; ++m)
#pragma unroll
                for (int n = 0; n < 2; ++n) acc[a][b][m][n] = (f32x4){0.f, 0.f, 0.f, 0.f};
    bf16x8 At[4][2], B0[2][2], B1[2][2];
    const char* cA = (const char*)g.A + (size_t)cur.pm * tstep; const char* cB = (const char*)g.Bt + (size_t)cur.pn * tstep;
    S.a_ready(cur);
    if constexpr (SP2) {
        PG8_STAGE(PG8_SB(0, 0), cB, voffB); PG8_STAGE(PG8_SB(0, 1), cB + hstep, voffB); PG8_STAGE(PG8_SA(0, 0), cA, voffA); PG8_STAGE(PG8_SA(0, 1), cA + hstep, voffA);
        if (wr == 1) PG8_BAR;
        PG8_WAIT_V(2); PG8_BAR;
        PG8_STAGE(PG8_SB(1, 0), cB + kstep, voffB); PG8_STAGE(PG8_SA(1, 0), cA + kstep, voffA); PG8_STAGE(PG8_SB(1, 1), cB + hstep + kstep, voffB);
        PG8_WAIT_V(6); PG8_BAR;
    } else {
        PG8_STAGE(PG8_SB(0, 0), cB, voffB); PG8_STAGE(PG8_SA(0, 0), cA, voffA); PG8_STAGE(PG8_SB(0, 1), cB + hstep, voffB); PG8_STAGE(PG8_SA(0, 1), cA + hstep, voffA);
        if (wr == 1) PG8_BAR;
        PG8_WAIT_V(4); PG8_BAR;
        PG8_STAGE(PG8_SB(1, 0), cB + kstep, voffB); PG8_STAGE(PG8_SA(1, 0), cA + kstep, voffA); PG8_STAGE(PG8_SB(1, 1), cB + hstep + kstep, voffB);
        PG8_WAIT_V(6); PG8_BAR;
    }
    for (;;) {
        const bool has_next = S.next(ui + 1, nxt);
        const char* nA = has_next ? (const char*)g.A + (size_t)nxt.pm * tstep : cA; const char* nB = has_next ? (const char*)g.Bt + (size_t)nxt.pn * tstep : cB;
        for (int t = 0; t < nt; t += 2) {
            const bool last = (t == nt - 2);
            const char* a1 = cA + (size_t)(t + 1) * kstep;
            const char* a2 = last ? nA : cA + (size_t)(t + 2) * kstep; const char* b2 = last ? nB : cB + (size_t)(t + 2) * kstep;
            const char* a3 = a2 + kstep; const char* b3 = b2 + kstep;
            if (last && has_next) S.a_ready(nxt);
            if constexpr (SP2) {
            PG8_LDB(B0, 0, 0); PG8_LDB(B1, 0, 1); PG8_SCHED; PG8_LDA(At, 0, 0); PG8_STAGE(PG8_SA(1, 1), a1 + hstep, voffA);
            PG8_WAIT_V(8); PG8_WAIT_L(0); PG8_BAR; PG8_MMA(0, 0, At, B0); PG8_MMA(0, 1, At, B1); PG8_BAR; PG8_SCHED;
            PG8_LDA(At, 0, 1); PG8_STAGE(PG8_SB(0, 0), b2, voffB); PG8_STAGE(PG8_SB(0, 1), b2 + hstep, voffB); PG8_STAGE(PG8_SA(0, 0), a2, voffA);
            PG8_WAIT_V(8); PG8_WAIT_L(0); PG8_BAR; PG8_MMA(1, 0, At, B0); PG8_MMA(1, 1, At, B1); PG8_BAR; PG8_SCHED;
            PG8_LDB(B0, 1, 0); PG8_LDB(B1, 1, 1); PG8_SCHED; PG8_LDA(At, 1, 0); PG8_STAGE(PG8_SA(0, 1), a2 + hstep, voffA);
            PG8_WAIT_V(8); PG8_WAIT_L(0); PG8_BAR; PG8_MMA(0, 0, At, B0); PG8_MMA(0, 1, At, B1); PG8_BAR; PG8_SCHED;
            PG8_LDA(At, 1, 1); PG8_STAGE(PG8_SB(1, 0), b3, voffB); PG8_STAGE(PG8_SB(1, 1), b3 + hstep, voffB); PG8_STAGE(PG8_SA(1, 0), a3, voffA);
            PG8_WAIT_V(8); PG8_WAIT_L(0); PG8_BAR; PG8_MMA(1, 0, At, B0); PG8_MMA(1, 1, At, B1); PG8_BAR; PG8_SCHED;
            } else {
            PG8_LDB(B0, 0, 0); PG8_SCHED; PG8_LDA(At, 0, 0); PG8_STAGE(PG8_SA(1, 1), a1 + hstep, voffA);
            PG8_WAIT_L(8); PG8_BAR; PG8_WAIT_L(0); PG8_MMA(0, 0, At, B0); PG8_BAR; PG8_SCHED;
            PG8_LDB(B1, 0, 1); PG8_STAGE(PG8_SB(0, 0), b2, voffB);
            PG8_BAR; PG8_WAIT_L(0); PG8_MMA(0, 1, At, B1); PG8_BAR;
            PG8_LDA(At, 0, 1); PG8_STAGE(PG8_SA(0, 0), a2, voffA);
            PG8_BAR; PG8_WAIT_L(0); PG8_MMA(1, 0, At, B0); PG8_BAR; PG8_SCHED;
            PG8_STAGE(PG8_SB(0, 1), b2 + hstep, voffB);
            PG8_WAIT_V(6); PG8_BAR; PG8_MMA(1, 1, At, B1); PG8_BAR;
            PG8_LDB(B0, 1, 0); PG8_SCHED; PG8_LDA(At, 1, 0); PG8_STAGE(PG8_SA(0, 1), a2 + hstep, voffA);
            PG8_WAIT_L(8); PG8_BAR; PG8_WAIT_L(0); PG8_MMA(0, 0, At, B0); PG8_BAR; PG8_SCHED;
            PG8_LDB(B1, 1, 1); PG8_STAGE(PG8_SB(1, 0), b3, voffB);
            PG8_BAR; PG8_WAIT_L(0); PG8_MMA(0, 1, At, B1); PG8_BAR;
            PG8_LDA(At, 1, 1); PG8_STAGE(PG8_SA(1, 0), a3, voffA);
            PG8_BAR; PG8_WAIT_L(0); PG8_MMA(1, 0, At, B0); PG8_BAR; PG8_SCHED;
            PG8_STAGE(PG8_SB(1, 1), b3 + hstep, voffB);
            PG8_WAIT_V(6); PG8_BAR; PG8_MMA(1, 1, At, B1); PG8_BAR;
            }
        }
        if constexpr (ALIGN_EPI) { if (wr == 0) PG8_BAR; }
        E(acc, cur, wr, wc, fr, fq); S.done(cur);
        if (!has_next) break;
#pragma unroll
        for (int a = 0; a < 2; ++a)
#pragma unroll
            for (int b = 0; b < 2; ++b)
#pragma unroll
                for (int m = 0; m < 4; ++m)
#pragma unroll
                    for (int n = 0; n < 2; ++n) acc[a][b][m][n] = (f32x4){0.f, 0.f, 0.f, 0.f};
        cur = nxt; cA = nA; cB = nB; ++ui;
        if constexpr (ALIGN_EPI) { if (wr == 1) PG8_BAR; }
    }
    PG8_WAIT_V(0);
    if constexpr (!ALIGN_EPI) { if (wr == 0) PG8_BAR; }
    PG8_BAR;
#undef PG8_SA
#undef PG8_SB
#undef PG8_STAGE
#undef PG8_LDA
#undef PG8_LDB
#undef PG8_MMA
#undef PG8_WAIT_V
#undef PG8_WAIT_L
#undef PG8_BAR
#undef PG8_SCHED
}
}

__device__ __forceinline__ float row_rscale(const float* rs, int row) {
    const f32x4 a = *(const f32x4*)(rs + (size_t)row * 4);
    return __builtin_amdgcn_rsqf(((a[0] + a[1]) + (a[2] + a[3])) * (1.f / DM) + NORM_EPS);
}

struct EpiProj {
    static constexpr bool PERM = true;
    unsigned char* ws; const float* bias;
    __device__ __forceinline__ void operator()(const f32x4 (&acc)[2][2][4][2], const pg8::Unit& u, int wr, int wc, int fr, int fq) const {
        const int pn = u.pn;
        const int row0 = u.pm * 256 + wr * 64 + fr;
        const int pc0 = pn * 256 + wc * 32 + 8 * fq;
        float rscv[2][4];
#pragma unroll
        for (int ai = 0; ai < 2; ++ai)
#pragma unroll
            for (int m = 0; m < 4; ++m) rscv[ai][m] = row_rscale((const float*)(ws + WS_RS), row0 + ai * 128 + m * 16);
        if (false) {
        } else if (pn == 38) {
            if (wc == 0) {
                f32x4 bv[2];
#pragma unroll
                for (int n = 0; n < 2; ++n) bv[n] = *(const f32x4*)(bias + pc0 + 4 * n);
#pragma unroll
                for (int ai = 0; ai < 2; ++ai)
#pragma unroll
                    for (int m = 0; m < 4; ++m) {
                        const int row = row0 + ai * 128 + m * 16;
                        const float rsc = rscv[ai][m];
#pragma unroll
                        for (int n = 0; n < 2; ++n) {
                            f32x4 v = acc[ai][0][m][n] * rsc + bv[n];
                            if (fq & 1) {
#pragma unroll
                                for (int i = 0; i < 4; ++i) { const float ex = fexp(-fabsf(v[i])); const float l1 = ex < 0.01f ? ex * (1.f - ex * (0.5f - ex * 0.33333333f)) : __logf(1.f + ex); v[i] = fminf(v[i], 0.f) - l1; }
                            }
                            *(f32x4*)((float*)(ws + WS_IF) + (size_t)row * 32 + 8 * fq + 4 * n) = v;
                        }
                    }
            }
        } else {
            size_t doff; int ld, col, act;
            if (pn < 4) { doff = WS_Q; ld = 1024; col = pn * 256; act = 0; }
            else if (pn == 4) { doff = WS_K; ld = 256; col = 0; act = 0; }
            else if (pn == 5) { doff = WS_V; ld = 256; col = 0; act = 0; }
            else if (pn < 10) { doff = WS_AZ; ld = 1024; col = (pn - 6) * 256; act = 1; }
            else if (pn < 14) { doff = WS_MQ; ld = 1024; col = (pn - 10) * 256; act = 0; }
            else if (pn < 18) { doff = WS_MK; ld = 1024; col = (pn - 14) * 256; act = 0; }
            else if (pn < 22) { doff = WS_MV; ld = 1024; col = (pn - 18) * 256; act = 0; }
            else if (pn < 26) { doff = WS_MO; ld = 1024; col = (pn - 22) * 256; act = 2; }
            else if (pn < 30) { doff = WS_MZ; ld = 1024; col = (pn - 26) * 256; act = 1; }
            else { doff = WS_GT; ld = 2048; col = (pn - 30) * 256; act = 2; }
            bf16_t* dst = (bf16_t*)(ws + doff);
            col += wc * 32 + 8 * fq;
            f32x4 bv[2][2];
#pragma unroll
            for (int bj = 0; bj < 2; ++bj)
#pragma unroll
                for (int n = 0; n < 2; ++n) bv[bj][n] = *(const f32x4*)(bias + pc0 + bj * 128 + 4 * n);
#pragma unroll
            for (int ai = 0; ai < 2; ++ai)
#pragma unroll
                for (int m = 0; m < 4; ++m) {
                    bf16_t* rowp = dst + (size_t)(row0 + ai * 128 + m * 16) * ld + col;
                    const float rsc = rscv[ai][m];
#pragma unroll
                    for (int bj = 0; bj < 2; ++bj) {
                        f32x4 v[2];
#pragma unroll
                        for (int n = 0; n < 2; ++n) {
                            v[n] = acc[ai][bj][m][n] * rsc + bv[bj][n];
                            if (act != 0) {
#pragma unroll
                                for (int i = 0; i < 4; ++i) { const float s = __builtin_amdgcn_rcpf(1.f + fexp(-v[n][i])); v[n][i] = act == 1 ? v[n][i] * s : s; }
                            }
                        }
                        u32x4 w; w.x = cvt_pk_bf16(v[0][0], v[0][1]); w.y = cvt_pk_bf16(v[0][2], v[0][3]); w.z = cvt_pk_bf16(v[1][0], v[1][1]); w.w = cvt_pk_bf16(v[1][2], v[1][3]);
                        __builtin_nontemporal_store(w, (u32x4*)(rowp + bj * 128));
                    }
                }
        }
    }
};

template <int MODE> struct EpiGate {
    static constexpr bool PERM = true;
    const bf16_t* GT; bf16_t* T; bf16_t* MG;
    __device__ __forceinline__ void operator()(const f32x4 (&acc)[2][2][4][2], const pg8::Unit& u, int wr, int wc, int fr, int fq) const {
        const int row0 = u.pm * 256 + wr * 64 + fr; const int col0 = u.pn * 256 + wc * 32 + 8 * fq;
        u32x4 gc[2], tc[2];
#pragma unroll
        for (int bj = 0; bj < 2; ++bj) { gc[bj] = *(const u32x4*)(GT + (size_t)row0 * 2048 + MODE * 1024 + col0 + bj * 128); if (MODE == 1) tc[bj] = *(const u32x4*)(T + (size_t)row0 * 1024 + col0 + bj * 128); }
#pragma unroll
        for (int it = 0; it < 8; ++it) {
            const int ai = it >> 2, m = it & 3;
            const size_t row = (size_t)(row0 + ai * 128 + m * 16);
            u32x4 gn[2], tn[2];
            if (it < 7) { const size_t rown = (size_t)(row0 + ((it + 1) >> 2) * 128 + ((it + 1) & 3) * 16);
#pragma unroll
                for (int bj = 0; bj < 2; ++bj) { gn[bj] = *(const u32x4*)(GT + rown * 2048 + MODE * 1024 + col0 + bj * 128); if (MODE == 1) tn[bj] = *(const u32x4*)(T + rown * 1024 + col0 + bj * 128); } }
#pragma unroll
            for (int bj = 0; bj < 2; ++bj) {
                const int col = col0 + bj * 128;
                const u32x4 gw = gc[bj];
                float o[8];
                o[0] = acc[ai][bj][m][0][0] * bflo(gw.x); o[1] = acc[ai][bj][m][0][1] * bfhi(gw.x); o[2] = acc[ai][bj][m][0][2] * bflo(gw.y); o[3] = acc[ai][bj][m][0][3] * bfhi(gw.y);
                o[4] = acc[ai][bj][m][1][0] * bflo(gw.z); o[5] = acc[ai][bj][m][1][1] * bfhi(gw.z); o[6] = acc[ai][bj][m][1][2] * bflo(gw.w); o[7] = acc[ai][bj][m][1][3] * bfhi(gw.w);
                if (MODE == 1) {
                    const u32x4 tw = tc[bj];
                    o[0] += bflo(tw.x); o[1] += bfhi(tw.x); o[2] += bflo(tw.y); o[3] += bfhi(tw.y); o[4] += bflo(tw.z); o[5] += bfhi(tw.z); o[6] += bflo(tw.w); o[7] += bfhi(tw.w);
                }
                u32x4 w; w.x = cvt_pk_bf16(o[0], o[1]); w.y = cvt_pk_bf16(o[2], o[3]); w.z = cvt_pk_bf16(o[4], o[5]); w.w = cvt_pk_bf16(o[6], o[7]);
                *(u32x4*)((MODE == 0 ? T : MG) + row * 1024 + col) = w;
            }
            if (it < 7) {
#pragma unroll
                for (int bj = 0; bj < 2; ++bj) { gc[bj] = gn[bj]; if (MODE == 1) tc[bj] = tn[bj]; } }
            asm volatile("" ::: "memory");
        }
    }
};

struct EpiRes {
    static constexpr bool PERM = false;
    const float* xin; float* xout; bf16_t* xb; float* rsq; LAS float* xl; int wxb;
    __device__ __forceinline__ void operator()(const f32x4 (&acc)[2][2][4][2], const pg8::Unit& u, int wr, int wc, int fr, int fq) const {
        const int row0 = u.pm * 256 + wr * 64 + fr; const int col0 = u.pn * 256 + wc * 32 + 4 * fq; const int lane = fq * 16 + fr;
        f32x4 xc[2][2];
#pragma unroll
        for (int bj = 0; bj < 2; ++bj)
#pragma unroll
            for (int n = 0; n < 2; ++n) xc[bj][n] = *(const f32x4*)(xin + (size_t)row0 * 1024 + col0 + bj * 128 + n * 16);
#pragma unroll
        for (int it = 0; it < 8; ++it) {
            const int ai = it >> 2, m = it & 3;
            const int row = row0 + ai * 128 + m * 16;
            const size_t off = (size_t)row * 1024 + col0;
            f32x4 xn[2][2];
            if (it < 7) { const size_t offn = (size_t)(row0 + ((it + 1) >> 2) * 128 + ((it + 1) & 3) * 16) * 1024 + col0;
#pragma unroll
                for (int bj = 0; bj < 2; ++bj)
#pragma unroll
                    for (int n = 0; n < 2; ++n) xn[bj][n] = *(const f32x4*)(xin + offn + bj * 128 + n * 16); }
            float ss = 0.f;
#pragma unroll
            for (int bj = 0; bj < 2; ++bj)
#pragma unroll
                for (int n = 0; n < 2; ++n) { const f32x4 x = xc[bj][n] + acc[ai][bj][m][n]; *(f32x4*)(xout + off + bj * 128 + n * 16) = x;
                    if (wxb) { u32x2 w; w.x = cvt_pk_bf16(x[0], x[1]); w.y = cvt_pk_bf16(x[2], x[3]); *(u32x2*)(xb + off + bj * 128 + n * 16) = w; }
                    ss += (x[0] * x[0] + x[1] * x[1]) + (x[2] * x[2] + x[3] * x[3]); }
            ss += shfl_x(ss, lane, 16); ss += shfl_x(ss, lane, 32);
            if (fq == 0) xl[(row - u.pm * 256) * 4 + wc] = ss;
            if (it < 7) {
#pragma unroll
                for (int bj = 0; bj < 2; ++bj)
#pragma unroll
                    for (int n = 0; n < 2; ++n) xc[bj][n] = xn[bj][n]; }
            asm volatile("" ::: "memory");
        }
        __syncthreads();
        {
            const int t = wr * 256 + wc * 64 + lane;
            if (t < 256 && wxb) { const f32x4 a = *(const LAS f32x4*)(xl + t * 4); rsq[(size_t)(u.pm * 256 + t) * 4 + u.pn] = (a[0] + a[1]) + (a[2] + a[3]); }
        }
    }
};

struct Ctx {
    int S, nseq, lgn;
    const float* xin; float* xout; unsigned char* ws;
};
#define CB(c, OFF) ((bf16_t*)((c).ws + (OFF)))
#define CF(c, OFF) ((float*)((c).ws + (OFF)))

__device__ __forceinline__ void transpose_item(const float* W, int K, int Nsrc, bf16_t* WT, int kb, int n_src, int n_dst, LAS float* scr, int lane, const float* gk) {
    const int k0 = 64 * kb;
    if (n_src >= 0) {
#pragma unroll 8
        for (int i = 0; i < 32; ++i) { const int kk = 2 * i + (lane >> 5); scr[kk * 33 + (lane & 31)] = W[(size_t)(k0 + kk) * Nsrc + n_src + (lane & 31)] * (gk ? gk[k0 + kk] : 1.f); }
    } else {
#pragma unroll 8
        for (int i = 0; i < 32; ++i) { const int kk = 2 * i + (lane >> 5); scr[kk * 33 + (lane & 31)] = 0.f; }
    }
    asm volatile("s_waitcnt lgkmcnt(0)" ::: "memory");
    const int c = lane & 7;
#pragma unroll
    for (int j = 0; j < 4; ++j) { const int n = (lane >> 3) + 8 * j; const LAS float* s = scr + (8 * c) * 33 + n;
        u32x4 o; o.x = cvt_pk_bf16(s[0 * 33], s[1 * 33]); o.y = cvt_pk_bf16(s[2 * 33], s[3 * 33]); o.z = cvt_pk_bf16(s[4 * 33], s[5 * 33]); o.w = cvt_pk_bf16(s[6 * 33], s[7 * 33]);
        *(u32x4*)(WT + (size_t)(n_dst + n) * K + k0 + 8 * c) = o; }
    asm volatile("s_waitcnt lgkmcnt(0)" ::: "memory");
}
__device__ __forceinline__ int in_block_map(int pb) {
    if (pb < 240) return pb;
    if (pb < 304) return 241 + (pb - 240);
    if (pb == 304) return 240;
    return -1;
}

struct Args {
    const float* x_prompt; const float* x_sample; const float* norm_g; const float* w_in; const float* b_in; const float* q_norm_g; const float* k_norm_g;
    const float* sink; const float* conv_w; const float* m_norm_g; const float* w_att_out; const float* w_m_out; const float* w_out;
    float* out; unsigned char* ws;
};

template <class KP> __device__ __forceinline__ void prologue(KP ka, LAS unsigned char* lds) {
    const int tid = tid_opaque(), lane = tid & 63, wave = tid >> 6;
    const int gw = blockIdx.x * 8 + wave, NGW = gridDim.x * 8;
    LAS float* scr = (LAS float*)(lds + wave * 16384);
    unsigned char* ws = ka->ws;
    constexpr int IT_IN = 16 * 312, IT_SQ = 16 * 32, IT_L = IT_IN + 3 * IT_SQ;
    for (int it = gw; it < DEPTH * IT_L; it += NGW) {
        const int l = it / IT_L; int r = it % IT_L;
        if (r < IT_IN) { const int kb = r / 312, pb = r % 312; const int lb = in_block_map(pb);
            transpose_item(ka->w_in + (size_t)l * DM * IN_DIM, DM, IN_DIM, (bf16_t*)(ws + WS_WIN + l * WIN_BYTES), kb, lb < 0 ? -1 : lb * 32, pb * 32, scr, lane, ka->norm_g + l * DM); continue; }
        r -= IT_IN;
        const int which = r / IT_SQ; r %= IT_SQ; const int kb = r / 32, nb = r % 32;
        const float* W = (which == 0 ? ka->w_att_out : which == 1 ? ka->w_m_out : ka->w_out) + (size_t)l * DM * DM;
        bf16_t* WT = (bf16_t*)(ws + (which == 0 ? WS_WA : which == 1 ? WS_WM : WS_WO) + (size_t)l * DM * DM * 2);
        transpose_item(W, DM, DM, WT, kb, nb * 32, nb * 32, scr, lane, nullptr);
    }
    const int gt = blockIdx.x * 512 + tid, NT = gridDim.x * 512;
    for (int i = gt; i < DEPTH * NPHYS; i += NT) { const int l = i / NPHYS, p = i % NPHYS; const int lb = in_block_map(p >> 5);
        ((float*)(ws + WS_BIAS))[i] = lb < 0 ? 0.f : ka->b_in[(size_t)l * IN_DIM + lb * 32 + (p & 31)]; }
    for (int i = gt; i < 4096 * 8; i += NT) { const int pos = i >> 3, j = i & 7;
        const float inv = j == 0 ? 1.0f : j == 1 ? 0.1939227432012558f : j == 2 ? 0.03760603070259094f : j == 3 ? 0.007292664609849453f : j == 4 ? 0.0014142135623842478f : j == 5 ? 0.00027424818836152554f : j == 6 ? 5.318296098266728e-05f : 1.0313386155758053e-05f;
        const float ang = (float)pos * inv;
        const double rev = (double)ang * 0.15915494309189535; const double fr = rev - __builtin_rint(rev);
        const float f = (float)fr;
        ((float*)(ws + WS_ROPE))[2 * i] = __builtin_amdgcn_cosf(f); ((float*)(ws + WS_ROPE))[2 * i + 1] = __builtin_amdgcn_sinf(f); }
    if (gt < DEPTH) { float mq = 0.f, mk = 0.f; for (int i = 0; i < 64; ++i) { mq = fmaxf(mq, fabsf(ka->q_norm_g[gt * 64 + i])); mk = fmaxf(mk, fabsf(ka->k_norm_g[gt * 64 + i])); }
        ((float*)(ws + WS_MB))[gt] = 8.f * mq * mk; }
}

__device__ __forceinline__ void norm_phase(const Ctx& c) {
    const int tid = tid_opaque(); const int lane = tid & 63, wave = tid >> 6;
    const int gw = blockIdx.x * 8 + wave, NGW = gridDim.x * 8;
    for (int m = gw; m < GM; m += NGW) {
        const f32x4* xr = (const f32x4*)(c.xin + (size_t)m * DM) + lane;
        f32x4 v[4]; float s = 0.f;
#pragma unroll
        for (int j = 0; j < 4; ++j) { v[j] = xr[64 * j]; s += (v[j].x * v[j].x + v[j].y * v[j].y) + (v[j].z * v[j].z + v[j].w * v[j].w); }
#pragma unroll
        for (int o = 1; o < 64; o <<= 1) s += shfl_x(s, lane, o);
        if (lane < 4) CF(c, WS_RS)[(size_t)m * 4 + lane] = lane == 0 ? s : 0.f;
        u32x2* o8 = (u32x2*)(CB(c, WS_XN) + (size_t)m * DM) + lane;
#pragma unroll
        for (int j = 0; j < 4; ++j) { u32x2 w; w.x = cvt_pk_bf16(v[j].x, v[j].y); w.y = cvt_pk_bf16(v[j].z, v[j].w); o8[64 * j] = w; }
    }
}

constexpr int AT_KP = 144, AT_VP = 776, AT_VOFF = 384 * AT_KP;
__device__ __forceinline__ void attn_unit(LAS unsigned char* lds, int unit, const Ctx& c, const float* sink, float mb, bf16_t* dstbuf, const float* qg) {
    const int tid = tid_opaque(), lane = tid & 63, w = tid >> 6, l32 = lane & 31, hi = lane >> 5;
    const int S = c.S, nb = S >> 7;
    const int g = unit & 3, qb = (unit >> 2) & (nb - 1), seq = (unit >> 2) >> c.lgn;
    const size_t rowbase = (size_t)seq * S;
    LAS unsigned char* Ks = lds; LAS unsigned char* Vt = lds + AT_VOFF;
    const int hq = g * 4 + (w >> 1);
    u32x4 qwp[2][4]; f32x4 rpp[2][4]; u32x2 zwp[2][8];
#pragma unroll
    for (int hf = 0; hf < 2; ++hf) {
        const int qi_ = ((w & 1) * 2 + hf) * 32 + l32; const size_t qrow_ = rowbase + qb * 128 + qi_;
#pragma unroll
        for (int s = 0; s < 4; ++s) { qwp[hf][s] = *(const u32x4*)(CB(c, WS_Q) + qrow_ * 1024 + hq * 64 + 16 * s + 8 * hi); rpp[hf][s] = *(const f32x4*)((const float*)(c.ws + WS_ROPE) + (qb * 128 + qi_) * 16 + 4 * s); }
#pragma unroll
        for (int k8 = 0; k8 < 8; ++k8) zwp[hf][k8] = *(const u32x2*)(CB(c, WS_AZ) + qrow_ * 1024 + hq * 64 + (k8 >> 2) * 32 + 8 * (k8 & 3) + 4 * hi);
    }
#pragma unroll
    for (int it = 0; it < 6; ++it) { const int idx = tid + it * 512; const int r = idx >> 3, ch = idx & 7; const int kpos = (qb - 1) * 128 + r;
        if (kpos >= 0 && kpos < S) { const u32x4 v = *(const u32x4*)(CB(c, WS_K) + (rowbase + kpos) * 256 + g * 64 + ch * 8); *(LAS u32x4*)(Ks + r * AT_KP + ch * 16) = v; } }
#pragma unroll
    for (int it = 0; it < 3; ++it) { const int idx = tid + it * 512; const int kp = idx >> 3, dg = idx & 7; const int key0 = kp * 2; const int kpos = (qb - 1) * 128 + key0;
        if (kpos >= 0 && kpos < S) {
            const u32x4 va = *(const u32x4*)(CB(c, WS_V) + (rowbase + kpos) * 256 + g * 64 + dg * 8), vb = *(const u32x4*)(CB(c, WS_V) + (rowbase + kpos + 1) * 256 + g * 64 + dg * 8);
            const unsigned aa[4] = {va.x, va.y, va.z, va.w}, bb[4] = {vb.x, vb.y, vb.z, vb.w};
#pragma unroll
            for (int i = 0; i < 8; ++i) { const unsigned lo = (i & 1) ? (aa[i >> 1] >> 16) : (aa[i >> 1] & 0xffffu); const unsigned hh = (i & 1) ? (bb[i >> 1] & 0xffff0000u) : (bb[i >> 1] << 16);
                *(LAS unsigned*)(Vt + (dg * 8 + i) * AT_VP + key0 * 2) = lo | hh; }
        } }
    __syncthreads();
    const float mb2 = mb * 1.4426950408889634f;
    const float sinkv = __builtin_amdgcn_exp2f(sink[hq] * 1.4426950408889634f - mb2);
#pragma unroll 1
    for (int half = 0; half < 2; ++half) {
        const int qt = (w & 1) * 2 + half; const int qi = qt * 32 + l32; const size_t qrow = rowbase + qb * 128 + qi;
        bf16x8 qf[4];
        {
            u32x4 qw[4]; float ss = 0.f;
#pragma unroll
            for (int s = 0; s < 4; ++s) { qw[s] = half ? qwp[1][s] : qwp[0][s];
                const float a0 = bflo(qw[s].x), a1 = bfhi(qw[s].x), a2 = bflo(qw[s].y), a3 = bfhi(qw[s].y), a4 = bflo(qw[s].z), a5 = bfhi(qw[s].z), a6 = bflo(qw[s].w), a7 = bfhi(qw[s].w);
                ss += ((a0 * a0 + a1 * a1) + (a2 * a2 + a3 * a3)) + ((a4 * a4 + a5 * a5) + (a6 * a6 + a7 * a7)); }
            ss += shfl_x(ss, lane, 32);
            const float rs = __builtin_amdgcn_rsqf(ss * (1.f / 64.f) + NORM_EPS) * (0.125f * 1.4426950408889634f);
            float rp[16];
#pragma unroll
            for (int s = 0; s < 4; ++s) { const f32x4 t4 = half ? rpp[1][s] : rpp[0][s]; rp[4 * s] = t4[0]; rp[4 * s + 1] = t4[1]; rp[4 * s + 2] = t4[2]; rp[4 * s + 3] = t4[3]; }
#pragma unroll
            for (int s = 0; s < 4; ++s) {
                const f32x4 g0 = *(const f32x4*)(qg + 16 * s + 8 * hi), g1 = *(const f32x4*)(qg + 16 * s + 8 * hi + 4);
                float v[8] = {bflo(qw[s].x) * rs * g0[0], bfhi(qw[s].x) * rs * g0[1], bflo(qw[s].y) * rs * g0[2], bfhi(qw[s].y) * rs * g0[3],
                              bflo(qw[s].z) * rs * g1[0], bfhi(qw[s].z) * rs * g1[1], bflo(qw[s].w) * rs * g1[2], bfhi(qw[s].w) * rs * g1[3]};
                if (s == 0) {
#pragma unroll
                    for (int j = 0; j < 8; ++j) { const float cs = rp[2 * j], sn = rp[2 * j + 1]; const float pr = shfl_x(v[j], lane, 32);
                        v[j] = hi == 0 ? v[j] * cs - pr * sn : v[j] * cs + pr * sn; }
                }
                u32x4 o; o.x = cvt_pk_bf16(v[0], v[1]); o.y = cvt_pk_bf16(v[2], v[3]); o.z = cvt_pk_bf16(v[4], v[5]); o.w = cvt_pk_bf16(v[6], v[7]);
                qf[s] = __builtin_bit_cast(bf16x8, o);
            }
        }
        f32x16 o0, o1;
#pragma unroll
        for (int r = 0; r < 16; ++r) { o0[r] = 0.f; o1[r] = 0.f; }
        float rsum = 0.f;
        const int bt_lo = qb > 0 ? qt : 4, bt_hi = qb < nb - 1 ? 8 + qt : 7;
        f32x16 pc;
#pragma unroll
        for (int r = 0; r < 16; ++r) pc[r] = -mb2;
#pragma unroll
        for (int s = 0; s < 4; ++s) { const bf16x8 ka = *(const LAS bf16x8*)(Ks + (bt_lo * 32 + l32) * AT_KP + (16 * s + 8 * hi) * 2); pc = MFMA32(ka, qf[s], pc); }
#pragma unroll 1
        for (int bt = bt_lo; bt <= bt_hi; ++bt) {
            const int kj0 = bt * 32;
            const int bn = bt < bt_hi ? bt + 1 : bt;
            f32x16 pn;
#pragma unroll
            for (int r = 0; r < 16; ++r) pn[r] = -mb2;
#pragma unroll
            for (int s = 0; s < 4; ++s) { const bf16x8 ka = *(const LAS bf16x8*)(Ks + (bn * 32 + l32) * AT_KP + (16 * s + 8 * hi) * 2); pn = MFMA32(ka, qf[s], pn); }
            f32x16 p = pc;
            if (bt == qt || bt == 8 + qt) {
#pragma unroll
                for (int r = 0; r < 16; ++r) { const int jr = crow(r, hi);
                    const bool valid = bt < 4 ? (jr >= l32) : (jr <= l32);
                    const float e = valid ? __builtin_amdgcn_exp2f(p[r]) : 0.f; p[r] = e; rsum += e; }
            } else {
#pragma unroll
                for (int r = 0; r < 16; ++r) { const float e = __builtin_amdgcn_exp2f(p[r]); p[r] = e; rsum += e; }
            }
#pragma unroll
            for (int s2 = 0; s2 < 2; ++s2) {
                u32x4 bw; bw.x = cvt_pk_bf16(p[8 * s2 + 0], p[8 * s2 + 1]); bw.y = cvt_pk_bf16(p[8 * s2 + 2], p[8 * s2 + 3]); bw.z = cvt_pk_bf16(p[8 * s2 + 4], p[8 * s2 + 5]); bw.w = cvt_pk_bf16(p[8 * s2 + 6], p[8 * s2 + 7]);
                const bf16x8 b2 = __builtin_bit_cast(bf16x8, bw);
                { const LAS unsigned char* vp = Vt + (l32) * AT_VP + (kj0 + 16 * s2 + 4 * hi) * 2; const u32x2 lo = *(const LAS u32x2*)vp, h2 = *(const LAS u32x2*)(vp + 16);
                  u32x4 aw; aw.x = lo.x; aw.y = lo.y; aw.z = h2.x; aw.w = h2.y; o0 = MFMA32(__builtin_bit_cast(bf16x8, aw), b2, o0); }
                { const LAS unsigned char* vp = Vt + (32 + l32) * AT_VP + (kj0 + 16 * s2 + 4 * hi) * 2; const u32x2 lo = *(const LAS u32x2*)vp, h2 = *(const LAS u32x2*)(vp + 16);
                  u32x4 aw; aw.x = lo.x; aw.y = lo.y; aw.z = h2.x; aw.w = h2.y; o1 = MFMA32(__builtin_bit_cast(bf16x8, aw), b2, o1); }
            }
            pc = pn;
        }
        rsum += shfl_x(rsum, lane, 32);
        const float inv = __builtin_amdgcn_rcpf(rsum + sinkv);
#pragma unroll
        for (int dt = 0; dt < 2; ++dt)
#pragma unroll
            for (int rg = 0; rg < 4; ++rg) {
                const int dim = dt * 32 + 8 * rg + 4 * hi; const size_t off = qrow * 1024 + hq * 64 + dim;
                const u32x2 zw = half ? zwp[1][dt * 4 + rg] : zwp[0][dt * 4 + rg];
                const float v0 = (dt ? o1[4 * rg + 0] : o0[4 * rg + 0]) * inv * bflo(zw.x), v1 = (dt ? o1[4 * rg + 1] : o0[4 * rg + 1]) * inv * bfhi(zw.x);
                const float v2 = (dt ? o1[4 * rg + 2] : o0[4 * rg + 2]) * inv * bflo(zw.y), v3 = (dt ? o1[4 * rg + 3] : o0[4 * rg + 3]) * inv * bfhi(zw.y);
                u32x2 ow; ow.x = cvt_pk_bf16(v0, v1); ow.y = cvt_pk_bf16(v2, v3);
                *(u32x2*)(dstbuf + off) = ow;
            }
    }
    __syncthreads();
}


__device__ __forceinline__ void knorm_rows(const Ctx& c, const float* kg) {
    const int tid = tid_opaque(); const int lane = tid & 63, wave = tid >> 6;
    const int gw = blockIdx.x * 8 + wave, NGW = gridDim.x * 8;
    const int d0 = (lane & 3) * 16;
    const float* rope = (const float*)(c.ws + WS_ROPE);
#pragma unroll 2
    for (int m4 = gw; m4 < GM / 4; m4 += NGW) {
        const int m = m4 * 4 + (lane >> 4);
        const int pos = m & (c.S - 1);
        bf16_t* p = CB(c, WS_K) + (size_t)m * 256 + (lane & 15) * 16;
        const float* g = kg + d0;
        const u32x4 w0 = *(const u32x4*)p, w1 = *(const u32x4*)(p + 8);
        const unsigned ww[8] = {w0.x, w0.y, w0.z, w0.w, w1.x, w1.y, w1.z, w1.w};
        float v[16]; float ss = 0.f;
#pragma unroll
        for (int i = 0; i < 16; ++i) { v[i] = (i & 1) ? bfhi(ww[i >> 1]) : bflo(ww[i >> 1]); ss += v[i] * v[i]; }
        ss += shfl_x(ss, lane, 1); ss += shfl_x(ss, lane, 2);
        const float rs = __builtin_amdgcn_rsqf(ss * (1.f / 64.f) + NORM_EPS);
#pragma unroll
        for (int i = 0; i < 16; ++i) v[i] = v[i] * rs * g[i];
        if ((lane & 3) == 0) {
#pragma unroll
            for (int j = 0; j < 8; ++j) { const float cs = rope[pos * 16 + 2 * j], sn = rope[pos * 16 + 2 * j + 1]; const float x1 = v[j], x2 = v[j + 8]; v[j] = x1 * cs - x2 * sn; v[j + 8] = x2 * cs + x1 * sn; }
        }
        u32x4 o0, o1; o0.x = cvt_pk_bf16(v[0], v[1]); o0.y = cvt_pk_bf16(v[2], v[3]); o0.z = cvt_pk_bf16(v[4], v[5]); o0.w = cvt_pk_bf16(v[6], v[7]);
        o1.x = cvt_pk_bf16(v[8], v[9]); o1.y = cvt_pk_bf16(v[10], v[11]); o1.z = cvt_pk_bf16(v[12], v[13]); o1.w = cvt_pk_bf16(v[14], v[15]);
        *(u32x4*)p = o0; *(u32x4*)(p + 8) = o1;
    }
}

constexpr int PR_P = 260;
__device__ __forceinline__ void prep_unit(LAS unsigned char* lds, int unit, const Ctx& c, const float* cw) {
    const int tid = tid_opaque();
    const int S = c.S, nc = S >> 7;
    const int ch = unit & (nc - 1), h = (unit >> c.lgn) & 7, seq = unit >> (c.lgn + 3);
    const size_t rowbase = (size_t)seq * S; const int t0 = ch * 128;
    LAS unsigned char* Tk = lds; LAS unsigned char* Tv = lds + 128 * PR_P;
    const size_t hb = (size_t)(seq * 8 + h) * S * 128;
#pragma unroll 2
    for (int it = 0; it < 4; ++it) {
        const int idx = tid + it * 512; const int l = idx >> 4, dg = idx & 15; const int t = t0 + l; const int col = h * 128 + dg * 8;
#pragma unroll
        for (int qk = 0; qk < 2; ++qk) {
            const bf16_t* src = qk ? CB(c, WS_MK) : CB(c, WS_MQ);
            const u32x4 z = {0u, 0u, 0u, 0u};
            const u32x4 xm = t > 0 ? *(const u32x4*)(src + (rowbase + t - 1) * 1024 + col) : z;
            const u32x4 x0 = *(const u32x4*)(src + (rowbase + t) * 1024 + col);
            const u32x4 xp = t < S - 1 ? *(const u32x4*)(src + (rowbase + t + 1) * 1024 + col) : z;
            const float* w0 = cw + qk * 1024 + col; const float* w1 = w0 + 2048; const float* w2 = w1 + 2048;
            const unsigned am[4] = {xm.x, xm.y, xm.z, xm.w}, a0[4] = {x0.x, x0.y, x0.z, x0.w}, ap[4] = {xp.x, xp.y, xp.z, xp.w};
            float y[8];
#pragma unroll
            for (int i = 0; i < 8; ++i) {
                const float vm = (i & 1) ? bfhi(am[i >> 1]) : bflo(am[i >> 1]), v0 = (i & 1) ? bfhi(a0[i >> 1]) : bflo(a0[i >> 1]), vp = (i & 1) ? bfhi(ap[i >> 1]) : bflo(ap[i >> 1]);
                float s = vm * w0[i] + v0 * w1[i] + vp * w2[i];
                s = s * __builtin_amdgcn_rcpf(1.f + fexp(-s));
                y[i] = qk ? s * KSCALE : s;
            }
            u32x4 o; o.x = cvt_pk_bf16(y[0], y[1]); o.y = cvt_pk_bf16(y[2], y[3]); o.z = cvt_pk_bf16(y[4], y[5]); o.w = cvt_pk_bf16(y[6], y[7]);
            *(u32x4*)((qk ? CB(c, WS_KC) : CB(c, WS_QC)) + hb + (size_t)(t >> 5) * 4096 + dg * 256 + (t & 31) * 8) = o;
            if (qk) { LAS unsigned* tp = (LAS unsigned*)(Tk + l * PR_P + dg * 16); tp[0] = o.x; tp[1] = o.y; tp[2] = o.z; tp[3] = o.w; }
        }
        { const u32x4 v = *(const u32x4*)(CB(c, WS_MV) + (rowbase + t) * 1024 + col); LAS unsigned* tp = (LAS unsigned*)(Tv + l * PR_P + dg * 16); tp[0] = v.x; tp[1] = v.y; tp[2] = v.z; tp[3] = v.w; }
    }
    __syncthreads();
#pragma unroll 2
    for (int it = 0; it < 4; ++it) {
        const int idx = tid + it * 512; const int d = idx & 127, lg = idx >> 7;
#pragma unroll
        for (int kv = 0; kv < 2; ++kv) {
            const LAS unsigned char* T = kv ? Tv : Tk;
            unsigned short e[8];
#pragma unroll
            for (int i = 0; i < 8; ++i) e[i] = *(const LAS unsigned short*)(T + (lg * 8 + i) * PR_P + d * 2);
            u32x4 o; o.x = e[0] | ((unsigned)e[1] << 16); o.y = e[2] | ((unsigned)e[3] << 16); o.z = e[4] | ((unsigned)e[5] << 16); o.w = e[6] | ((unsigned)e[7] << 16);
            *(u32x4*)((kv ? CB(c, WS_VT) : CB(c, WS_KT)) + hb + (size_t)ch * 16384 + (d >> 5) * 4096 + lg * 256 + (d & 31) * 8) = o;
        }
    }
    __syncthreads();
}

__device__ __forceinline__ void scan_job(int job, const Ctx& c) {
    const int lane = tid_opaque() & 63;
    const int S = c.S, nc = S >> 7;
    const int ch = job & (nc - 1), dir = (job >> c.lgn) & 1, h = (job >> (c.lgn + 1)) & 7, seq = job >> (c.lgn + 4);
    const size_t rowbase = (size_t)seq * S; const int t0 = ch * 128;
    const int p0 = dir ? 127 - 2 * lane : 2 * lane, p1 = dir ? 126 - 2 * lane : 2 * lane + 1;
    const float* r0 = CF(c, WS_IF) + (rowbase + t0 + p0) * 32 + dir * 16 + h; const float* r1 = CF(c, WS_IF) + (rowbase + t0 + p1) * 32 + dir * 16 + h;
    const float li0 = r0[0], lf0 = r0[8], li1 = r1[0], lf1 = r1[8];
    float s = lf0 + lf1;
#pragma unroll
    for (int o = 1; o < 64; o <<= 1) { const float y = shfl_u(s, lane, o); if (lane >= o) s += y; }
    const float b1 = s, b0 = s - lf1;
    const float a0 = li0 - b0, a1 = li1 - b1;
    float mx = fmaxf(a0, a1);
#pragma unroll
    for (int o = 1; o < 64; o <<= 1) { const float y = shfl_u(mx, lane, o); if (lane >= o) mx = fmaxf(mx, y); }
    float ex = shfl_u(mx, lane, 1); if (lane == 0) ex = -3.0e38f;
    const float cm0 = fmaxf(ex, a0), cm1 = mx;
    const size_t sb = (size_t)((seq * 8 + h) * 2 + dir) * S + t0;
    const float cmL = __int_as_float(__builtin_amdgcn_ds_bpermute(63 << 2, __float_as_int(cm1)));
    bf16_t* ea = CB(c, WS_EA);
    ea[sb + p0] = (bf16_t)(cvt_pk_bf16(fexp(a0 - cmL), 0.f) & 0xffffu); ea[sb + p1] = (bf16_t)(cvt_pk_bf16(fexp(a1 - cmL), 0.f) & 0xffffu);
    CF(c, WS_SA)[sb + p0] = a0 * 1.4426950408889634f; CF(c, WS_SA)[sb + p1] = a1 * 1.4426950408889634f;     CF(c, WS_SCM)[sb + p0] = cm0; CF(c, WS_SCM)[sb + p1] = cm1; CF(c, WS_SB)[sb + p0] = b0; CF(c, WS_SB)[sb + p1] = b1;
}

__device__ __forceinline__ void st_stage(LAS unsigned char* buf, const bf16_t* KTc, const bf16_t* VTc, int w, int lane) {
#pragma unroll
    for (int p = 0; p < 6; ++p) {
        const int piece = w * 6 + p;
        const char* src = piece < 32 ? (const char*)KTc + piece * 1024 : (const char*)VTc + (piece - 32) * 1024;
        __builtin_amdgcn_global_load_lds((const unsigned*)(src + lane * 16), (LAS unsigned*)(buf + piece * 1024), 16, 0, 0);
    }
}
__device__ __forceinline__ void mlstm_state_unit(LAS unsigned char* lds, int unit, const Ctx& c) {
    const int tid = tid_opaque(), lane = tid & 63, w = __builtin_amdgcn_readfirstlane(tid >> 6), l32 = lane & 31, hi = lane >> 5;
    const int S = c.S, nc = S >> 7;
    const int es = unit & 1, dir = (unit >> 1) & 1, h = (unit >> 2) & 7, seq = unit >> 5;
    const size_t hb = (size_t)(seq * 8 + h) * S * 128;
    const int chain = (seq * 8 + h) * 2 + dir;
    const size_t sbase = (size_t)chain * S;
    const int et = w >> 2, dt = w & 3;
    const bf16_t* KTg = CB(c, WS_KT) + hb; const bf16_t* VTg = CB(c, WS_VT) + hb + es * 8192;
    const bf16_t* EAl = CB(c, WS_EA) + sbase;
    const float* scm = CF(c, WS_SCM) + sbase; const float* sbv = CF(c, WS_SB) + sbase;
    bf16_t* CPl = CB(c, WS_CP) + (size_t)chain * nc * 16384 + (es * 2 + et) * 4096 + dt * 1024 + l32 * 8 + 4 * hi;
    bf16_t* NPl = CB(c, WS_NP) + (size_t)chain * nc * 128 + dt * 32 + 4 * hi;
    float* MPl = CF(c, WS_MP) + (size_t)chain * nc;
    const int plast = dir ? 0 : 127;
    const int kofs = dt * 8192 + hi * 512 + l32 * 16, vofs = 32768 + et * 8192 + hi * 512 + l32 * 16;
    f32x16 Cacc, nacc;
#pragma unroll
    for (int r = 0; r < 16; ++r) { Cacc[r] = 0.f; nacc[r] = 0.f; }
    float m_prev = -1e30f;
    u32x4 ea[8]; float cmLn, bLn;
    { const int ch0 = dir ? nc - 1 : 0;
      st_stage(lds, KTg + (size_t)ch0 * 16384, VTg + (size_t)ch0 * 16384, w, lane);
#pragma unroll
      for (int s = 0; s < 8; ++s) ea[s] = *(const u32x4*)(EAl + ch0 * 128 + 16 * s + 8 * hi);
      cmLn = scm[ch0 * 128 + plast]; bLn = sbv[ch0 * 128 + plast]; }
#pragma unroll 1
    for (int step = 0; step < nc; ++step) {
        const int ch = dir ? nc - 1 - step : step;
        const int sn = step + 1 < nc ? step + 1 : step; const int chn = dir ? nc - 1 - sn : sn;
        asm volatile("s_waitcnt vmcnt(0)" ::: "memory"); __syncthreads();
        const LAS unsigned char* buf = lds + (step & 1) * 49152;
        if (step + 1 < nc) st_stage(lds + ((step + 1) & 1) * 49152, KTg + (size_t)chn * 16384, VTg + (size_t)chn * 16384, w, lane);
        const bf16_t* EAn = EAl + chn * 128 + 8 * hi;
#pragma unroll
        for (int rg = 0; rg < 4; ++rg) { u32x2 o; o.x = cvt_pk_bf16(Cacc[4 * rg + 0], Cacc[4 * rg + 1]); o.y = cvt_pk_bf16(Cacc[4 * rg + 2], Cacc[4 * rg + 3]); *(u32x2*)(CPl + (size_t)ch * 16384 + 256 * rg) = o; }
        if (es == 0 && et == 0 && l32 == 0) {
#pragma unroll
            for (int rg = 0; rg < 4; ++rg) { u32x2 o; o.x = cvt_pk_bf16(nacc[4 * rg + 0], nacc[4 * rg + 1]); o.y = cvt_pk_bf16(nacc[4 * rg + 2], nacc[4 * rg + 3]); *(u32x2*)(NPl + (size_t)ch * 128 + 8 * rg) = o; }
            if (dt == 0 && hi == 0) MPl[ch] = m_prev;
        }
        const float cmL = cmLn, bL = bLn;
        cmLn = scm[chn * 128 + plast]; bLn = sbv[chn * 128 + plast];
        const float M_last = fmaxf(m_prev, cmL);
        const float w_c = fexp(m_prev - M_last), w_d = fexp(cmL - M_last);
        f32x16 dC, dn;
#pragma unroll
        for (int r = 0; r < 16; ++r) { dC[r] = 0.f; dn[r] = 0.f; }
#pragma unroll
        for (int s = 0; s < 8; ++s) {
            const bf16x8 kt = *(const LAS bf16x8*)(buf + kofs + s * 1024);
            const u32x4 vw = *(const LAS u32x4*)(buf + vofs + s * 1024), ew = ea[s];
            u32x4 bw; bw.x = cvt_pk_bf16(bflo(vw.x) * bflo(ew.x), bfhi(vw.x) * bfhi(ew.x)); bw.y = cvt_pk_bf16(bflo(vw.y) * bflo(ew.y), bfhi(vw.y) * bfhi(ew.y));
            bw.z = cvt_pk_bf16(bflo(vw.z) * bflo(ew.z), bfhi(vw.z) * bfhi(ew.z)); bw.w = cvt_pk_bf16(bflo(vw.w) * bflo(ew.w), bfhi(vw.w) * bfhi(ew.w));
            dC = MFMA32(kt, __builtin_bit_cast(bf16x8, bw), dC);
            if (et == 0) dn = MFMA32(kt, __builtin_bit_cast(bf16x8, ew), dn);
            ea[s] = *(const u32x4*)(EAn + 16 * s);
        }
#pragma unroll
        for (int r = 0; r < 16; ++r) { Cacc[r] = w_c * Cacc[r] + w_d * dC[r]; nacc[r] = w_c * nacc[r] + w_d * dn[r]; }
        m_prev = bL + M_last;
    }
    asm volatile("s_waitcnt vmcnt(0)" ::: "memory"); __syncthreads();
}

__device__ __forceinline__ void out_stage(LAS unsigned char* buf, int unit, const Ctx& c, int w, int lane) {
    const int S = c.S, nc = S >> 7;
    const int ch = unit & (nc - 1), h = (unit >> c.lgn) & 7, seq = unit >> (c.lgn + 3);
    const size_t hb = (size_t)(seq * 8 + h) * S * 128 + (size_t)ch * 16384;
    const char* q = (const char*)(CB(c, WS_QC) + hb); const char* k = (const char*)(CB(c, WS_KC) + hb);
#pragma unroll
    for (int p = 0; p < 4; ++p) {
        const int piece = w * 4 + p;
        __builtin_amdgcn_global_load_lds((const unsigned*)(q + piece * 1024 + lane * 16), (LAS unsigned*)(buf + piece * 1024), 16, 0, 0);
        __builtin_amdgcn_global_load_lds((const unsigned*)(k + piece * 1024 + lane * 16), (LAS unsigned*)(buf + 32768 + piece * 1024), 16, 0, 0);
    }
}
__device__ __forceinline__ void mlstm_out_unit(const LAS unsigned char* buf, LAS float* xch, int unit, const Ctx& c, const float* mg) {
    const int tid = tid_opaque(), lane = tid & 63, w = __builtin_amdgcn_readfirstlane(tid >> 6), l32 = lane & 31, hi = lane >> 5;
    const int S = c.S, nc = S >> 7;
    const int ch = unit & (nc - 1), h = (unit >> c.lgn) & 7, seq = unit >> (c.lgn + 3);
    const size_t hb = (size_t)(seq * 8 + h) * S * 128;
    const int t0 = ch * 128;
    const int it = w & 3, ep = w >> 2;
    const int i = it * 32 + l32;
    const LAS unsigned char* Ql = buf + hi * 512 + l32 * 16; const LAS unsigned char* Kl = buf + 32768 + hi * 512 + l32 * 16;
    const bf16_t* VTl = CB(c, WS_VT) + hb + (size_t)ch * 16384 + (2 * ep) * 4096;
    const unsigned vlo = (unsigned)(l32 * 8 + 4 * hi), clo = (unsigned)(hi * 256 + l32 * 8), nlo = (unsigned)(8 * hi), alo = (unsigned)(4 * hi);
    bf16x8 qf[8];
#pragma unroll
    for (int s = 0; s < 8; ++s) qf[s] = *(const LAS bf16x8*)(Ql + it * 8192 + s * 1024);
    float hsum[2][16];
#pragma unroll
    for (int r = 0; r < 16; ++r) { hsum[0][r] = 0.f; hsum[1][r] = 0.f; }
#pragma unroll 1
    for (int dir = 0; dir < 2; ++dir) {
        const int chain = (seq * 8 + h) * 2 + dir;
        const size_t sbase = (size_t)chain * S + t0;
        const bf16_t* CPl = CB(c, WS_CP) + ((size_t)chain * nc + ch) * 16384 + (2 * ep) * 4096;
        const bf16_t* NPl = CB(c, WS_NP) + ((size_t)chain * nc + ch) * 128;
        const float* sa = CF(c, WS_SA) + sbase;
        const int jlo = dir ? it : 0, jhi = dir ? 3 : it;
        const float m_prev = CF(c, WS_MP)[(size_t)chain * nc + ch];
        const float cm_i = (CF(c, WS_SCM) + sbase)[(unsigned)i], b_i = (CF(c, WS_SB) + sbase)[(unsigned)i];
        const float M_i = fmaxf(m_prev, cm_i); const float w_i = fexp(m_prev - M_i); const float M_i2 = M_i * 1.4426950408889634f;
        f32x16 ainta, aintb, aqn, anuma, anumb;
#pragma unroll
        for (int r = 0; r < 16; ++r) { ainta[r] = 0.f; aintb[r] = 0.f; aqn[r] = 0.f; anuma[r] = 0.f; anumb[r] = 0.f; }
        float rsum = 0.f;
        f32x16 pc;
#pragma unroll
        for (int r = 0; r < 16; ++r) pc[r] = 0.f;
#pragma unroll
        for (int s = 0; s < 8; ++s) { const bf16x8 kf = *(const LAS bf16x8*)(Kl + jlo * 8192 + s * 1024); pc = MFMA32(kf, qf[s], pc); }
#pragma unroll 1
        for (int jt = jlo; jt <= jhi; ++jt) {
            u32x2 vlc[2][2], vhc[2][2]; f32x4 avc[4];
#pragma unroll
            for (int e2 = 0; e2 < 2; ++e2)
#pragma unroll
                for (int s2 = 0; s2 < 2; ++s2) { const unsigned vo = vlo + (unsigned)(e2 * 4096 + (4 * jt + 2 * s2) * 256); vlc[e2][s2] = *(const u32x2*)(VTl + vo); vhc[e2][s2] = *(const u32x2*)(VTl + (vo + 256u)); }
#pragma unroll
            for (int rg = 0; rg < 4; ++rg) avc[rg] = *(const f32x4*)(sa + (alo + (unsigned)(jt * 32 + 8 * rg)));
            const int jn = jt < jhi ? jt + 1 : jt;
            f32x16 pn;
#pragma unroll
            for (int r = 0; r < 16; ++r) pn[r] = 0.f;
#pragma unroll
            for (int s = 0; s < 8; ++s) { const bf16x8 kf = *(const LAS bf16x8*)(Kl + jn * 8192 + s * 1024); pn = MFMA32(kf, qf[s], pn); }
            f32x16 p = pc;
            if (jt == it) {
#pragma unroll
                for (int r = 0; r < 16; ++r) { const int jr = crow(r, hi);
                    const bool valid = dir ? (jr >= l32) : (jr <= l32);
                    const float dg = valid ? __builtin_amdgcn_exp2f(avc[r >> 2][r & 3] - M_i2) : 0.f; p[r] *= dg; rsum += p[r]; }
            } else {
#pragma unroll
                for (int r = 0; r < 16; ++r) { p[r] *= __builtin_amdgcn_exp2f(avc[r >> 2][r & 3] - M_i2); rsum += p[r]; }
            }
#pragma unroll
            for (int s2 = 0; s2 < 2; ++s2) {
                u32x4 bw; bw.x = cvt_pk_bf16(p[8 * s2 + 0], p[8 * s2 + 1]); bw.y = cvt_pk_bf16(p[8 * s2 + 2], p[8 * s2 + 3]); bw.z = cvt_pk_bf16(p[8 * s2 + 4], p[8 * s2 + 5]); bw.w = cvt_pk_bf16(p[8 * s2 + 6], p[8 * s2 + 7]);
                u32x4 aw; aw.x = vlc[0][s2].x; aw.y = vlc[0][s2].y; aw.z = vhc[0][s2].x; aw.w = vhc[0][s2].y;
                anuma = MFMA32(__builtin_bit_cast(bf16x8, aw), __builtin_bit_cast(bf16x8, bw), anuma);
                u32x4 cw; cw.x = vlc[1][s2].x; cw.y = vlc[1][s2].y; cw.z = vhc[1][s2].x; cw.w = vhc[1][s2].y;
                anumb = MFMA32(__builtin_bit_cast(bf16x8, cw), __builtin_bit_cast(bf16x8, bw), anumb);
            }
            pc = pn;
        }
        {
            bf16x8 cfa[8], nf[8];
#pragma unroll
            for (int s = 0; s < 8; ++s) { cfa[s] = *(const bf16x8*)(CPl + (clo + 512u * s)); nf[s] = *(const bf16x8*)(NPl + (nlo + 16u * s)); }
#pragma unroll
        for (int s = 0; s < 8; ++s) { ainta = MFMA32(cfa[s], qf[s], ainta); aqn = MFMA32(nf[s], qf[s], aqn); }
        }
        asm volatile("" ::: "memory");
        {
            bf16x8 cfb[8];
#pragma unroll
            for (int s = 0; s < 8; ++s) cfb[s] = *(const bf16x8*)(CPl + (clo + 4096u + 512u * s));
#pragma unroll
            for (int s = 0; s < 8; ++s) aintb = MFMA32(cfb[s], qf[s], aintb);
        }
        asm volatile("" ::: "memory");
        const float qn = aqn[0];
        rsum += shfl_x(rsum, lane, 32);
        const float den = w_i * qn + rsum;
        const float dd = fmaxf(fabsf(den), fexp(-(b_i + M_i)));
        const float inv = __builtin_amdgcn_rcpf(dd);
#pragma unroll
        for (int r = 0; r < 16; ++r) { hsum[0][r] += (w_i * ainta[r] + anuma[r]) * inv; hsum[1][r] += (w_i * aintb[r] + anumb[r]) * inv; }
    }
    int h2 = h; asm volatile("" : "+s"(h2));
    const size_t ob = ((size_t)seq * S + t0) * 1024 + h2 * 128 + (2 * ep) * 32; const unsigned oo = (unsigned)(i * 1024 + 4 * hi);
    bf16_t* MOb = CB(c, WS_MO) + ob; bf16_t* MZb = CB(c, WS_MZ) + ob; const float* mgb = mg + h2 * 128 + (2 * ep) * 32;
    u32x2 ow[2][4], zw[2][4];
#pragma unroll
    for (int e2 = 0; e2 < 2; ++e2)
#pragma unroll
        for (int rg = 0; rg < 4; ++rg) { ow[e2][rg] = *(const u32x2*)(MOb + (oo + (unsigned)(e2 * 32 + 8 * rg))); zw[e2][rg] = *(const u32x2*)(MZb + (oo + (unsigned)(e2 * 32 + 8 * rg))); }
    float ss = 0.f;
#pragma unroll
    for (int e2 = 0; e2 < 2; ++e2)
#pragma unroll
        for (int rg = 0; rg < 4; ++rg) { hsum[e2][4 * rg + 0] *= bflo(ow[e2][rg].x); hsum[e2][4 * rg + 1] *= bfhi(ow[e2][rg].x); hsum[e2][4 * rg + 2] *= bflo(ow[e2][rg].y); hsum[e2][4 * rg + 3] *= bfhi(ow[e2][rg].y);
            ss += (hsum[e2][4 * rg + 0] * hsum[e2][4 * rg + 0] + hsum[e2][4 * rg + 1] * hsum[e2][4 * rg + 1]) + (hsum[e2][4 * rg + 2] * hsum[e2][4 * rg + 2] + hsum[e2][4 * rg + 3] * hsum[e2][4 * rg + 3]); }
    ss += shfl_x(ss, lane, 32);
    if (hi == 0) xch[(it * 2 + ep) * 32 + l32] = ss;
    __syncthreads();
    const float tot = xch[(it * 2) * 32 + l32] + xch[(it * 2 + 1) * 32 + l32];
    const float rs = __builtin_amdgcn_rsqf(tot * (1.f / 128.f) + NORM_EPS);
#pragma unroll
    for (int e2 = 0; e2 < 2; ++e2)
#pragma unroll
        for (int rg = 0; rg < 4; ++rg) { const f32x4 gv = *(const f32x4*)(mgb + (alo + (unsigned)(e2 * 32 + 8 * rg)));
            u32x2 o; o.x = cvt_pk_bf16(hsum[e2][4 * rg + 0] * rs * gv[0] * bflo(zw[e2][rg].x), hsum[e2][4 * rg + 1] * rs * gv[1] * bfhi(zw[e2][rg].x));
            o.y = cvt_pk_bf16(hsum[e2][4 * rg + 2] * rs * gv[2] * bflo(zw[e2][rg].y), hsum[e2][4 * rg + 3] * rs * gv[3] * bfhi(zw[e2][rg].y));
            *(u32x2*)(MZb + (oo + (unsigned)(e2 * 32 + 8 * rg))) = o; }
}

__device__ __forceinline__ void post_phase(const Ctx& c, const float* mg) {
    const int tid = tid_opaque(); const int lane = tid & 63, wave = tid >> 6;
    const int gw = blockIdx.x * 8 + wave, NGW = gridDim.x * 8;
    f32x4 gv[4];
#pragma unroll
    for (int j = 0; j < 4; ++j) gv[j] = *(const f32x4*)(mg + lane * 16 + 4 * j);
    for (int m = gw; m < GM; m += NGW) {
        const size_t off = (size_t)m * 1024 + lane * 16;
        const u32x4 ow0 = *(const u32x4*)(CB(c, WS_MO) + off), ow1 = *(const u32x4*)(CB(c, WS_MO) + off + 8);
        const u32x4 zw0 = *(const u32x4*)(CB(c, WS_MZ) + off), zw1 = *(const u32x4*)(CB(c, WS_MZ) + off + 8);
        const unsigned ow[8] = {ow0.x, ow0.y, ow0.z, ow0.w, ow1.x, ow1.y, ow1.z, ow1.w}, zw[8] = {zw0.x, zw0.y, zw0.z, zw0.w, zw1.x, zw1.y, zw1.z, zw1.w};
        float v[16]; float ss = 0.f;
        const u32x4 fa0 = *(const u32x4*)(CB(c, WS_HF) + off), fa1 = *(const u32x4*)(CB(c, WS_HF) + off + 8);
        const unsigned fa[8] = {fa0.x, fa0.y, fa0.z, fa0.w, fa1.x, fa1.y, fa1.z, fa1.w};
#pragma unroll
        for (int e = 0; e < 16; ++e) { const float og = (e & 1) ? bfhi(ow[e >> 1]) : bflo(ow[e >> 1]); const float hs = (e & 1) ? bfhi(fa[e >> 1]) : bflo(fa[e >> 1]); v[e] = og * hs; ss += v[e] * v[e]; }
        ss += shfl_x(ss, lane, 1); ss += shfl_x(ss, lane, 2); ss += shfl_x(ss, lane, 4);
        const float rs = __builtin_amdgcn_rsqf(ss * (1.f / 128.f) + NORM_EPS);
        unsigned o[8];
#pragma unroll
        for (int e = 0; e < 16; e += 2) { const float y0 = v[e] * rs * gv[e >> 2][e & 3] * bflo(zw[e >> 1]), y1 = v[e + 1] * rs * gv[e >> 2][(e + 1) & 3] * bfhi(zw[e >> 1]); o[e >> 1] = cvt_pk_bf16(y0, y1); }
        u32x4 s0, s1; s0.x = o[0]; s0.y = o[1]; s0.z = o[2]; s0.w = o[3]; s1.x = o[4]; s1.y = o[5]; s1.z = o[6]; s1.w = o[7];
        *(u32x4*)(CB(c, WS_MZ) + off) = s0; *(u32x4*)(CB(c, WS_MZ) + off + 8) = s1;
    }
}


typedef const Args __attribute__((address_space(4)))* KArgsP;
__device__ __forceinline__ KArgsP kargs() { unsigned long long p = (unsigned long long)__builtin_amdgcn_kernarg_segment_ptr(); asm volatile("" : "+s"(p)); return (KArgsP)p; }
#define XB_TMO      128
#define XB_XCNT(j)  (256  + 64 * (j))
#define XB_XSUB(j)  (1280 + 64 * (j))
#define XB_XGEN(j)  (2304 + 64 * (j))
#define XB_TOP      3328
#define XB_TOPGEN   3392
#define XCD_BAR_WORDS 3456
#define XB_SPIN_CAP (1u << 20)
__device__ __forceinline__ unsigned xb_ld(unsigned* p)              { return __hip_atomic_load(p, __ATOMIC_RELAXED, __HIP_MEMORY_SCOPE_AGENT); }
__device__ __forceinline__ unsigned xb_add(unsigned* p, unsigned v) { return __hip_atomic_fetch_add(p, v, __ATOMIC_RELAXED, __HIP_MEMORY_SCOPE_AGENT); }
__device__ __forceinline__ unsigned xb_xcc_id() { return (unsigned)__builtin_amdgcn_s_getreg((3 << 11) | 20) & 0xFu; }
#define XB_SPIN(cond, bar) do { unsigned _sp = 0; while (cond) { __builtin_amdgcn_s_sleep(1); \
    if ((++_sp & 255u) == 0u) { if (xb_ld(&(bar)[XB_TMO])) break; if (_sp > XB_SPIN_CAP) { atomicAdd(&(bar)[XB_TMO], 1u); break; } } } } while (0)
struct XcdBarrier { unsigned* bar; unsigned x; volatile LAS unsigned* st; };
__device__ __forceinline__ XcdBarrier xcd_barrier_post(unsigned* bar, volatile LAS unsigned* st) {
    XcdBarrier b; b.bar = bar; b.x = xb_xcc_id(); b.st = st;
    if (threadIdx.x == 0) (void)xb_add(&bar[XB_XCNT(b.x)], 1u);
    return b;
}
__device__ __forceinline__ void xcd_barrier_complete(unsigned* bar, unsigned x, unsigned& nloc, unsigned& nx) {
    const unsigned G = gridDim.x * gridDim.y * gridDim.z;
    unsigned sum, cnt, mine, sp = 0u;
    for (;;) {
        sum = 0u; cnt = 0u; mine = 0u;
#pragma unroll
        for (unsigned j = 0; j < 16; ++j) { const unsigned c = xb_ld(&bar[XB_XCNT(j)]); sum += c; cnt += (c > 0u) ? 1u : 0u; mine = (j == x) ? c : mine; }
        if (sum == G) break;
        __builtin_amdgcn_s_sleep(1);
        if ((++sp & 255u) == 0u) { if (xb_ld(&bar[XB_TMO])) break; if (sp > XB_SPIN_CAP) { atomicAdd(&bar[XB_TMO], 1u); break; } }
    }
    nloc = mine > 0u ? mine : 1u; nx = cnt > 0u ? cnt : 1u;
}
__device__ __forceinline__ void xcd_barrier(LAS unsigned char* lds) {
    XcdBarrier b; b.bar = (unsigned*)(kargs()->ws + WS_BAR); b.x = xb_xcc_id(); b.st = (volatile LAS unsigned*)(lds + 131072 + 256);
    asm volatile("s_waitcnt vmcnt(0)" ::: "memory");
    __syncthreads();
    if (tid_opaque() == 0) {
        unsigned* bar = b.bar;
        __builtin_amdgcn_s_waitcnt(0);
        unsigned nloc = b.st[0], nx = b.st[1];
        if (nloc == 0u) { xcd_barrier_complete(bar, b.x, nloc, nx); b.st[0] = nloc; b.st[1] = nx; }
        const unsigned old = xb_add(&bar[XB_XSUB(b.x)], 1u);
        const unsigned gen = old / nloc;
        if (old + 1u == (gen + 1u) * nloc) {
            __builtin_amdgcn_fence(__ATOMIC_RELEASE, "agent");
            asm volatile("s_waitcnt vmcnt(0)" ::: "memory");
            const unsigned og = xb_add(&bar[XB_TOP], 1u);
            const unsigned tg = og / nx;
            if (og + 1u == (tg + 1u) * nx) xb_add(&bar[XB_TOPGEN], 1u);
            else XB_SPIN(xb_ld(&bar[XB_TOPGEN]) == tg, bar);
            __builtin_amdgcn_fence(__ATOMIC_ACQUIRE, "agent");
            xb_add(&bar[XB_XGEN(b.x)], 1u);
            asm volatile("s_waitcnt vmcnt(0)" ::: "memory");
        } else {
            XB_SPIN(xb_ld(&bar[XB_XGEN(b.x)]) == gen, bar);
            __builtin_amdgcn_fence(__ATOMIC_ACQUIRE, "agent");
            asm volatile("s_waitcnt vmcnt(0)" ::: "memory");
        }
    }
    __syncthreads();
}

__device__ __forceinline__ Ctx make_ctx(int gi, int l) {
    KArgsP ka = kargs();
    Ctx c; c.S = gi == 0 ? 4096 : 2048; c.nseq = gi == 0 ? 4 : 8; c.lgn = gi == 0 ? 5 : 4; c.ws = ka->ws;
    float* outg = ka->out + (size_t)(unsigned)gi * (size_t)(GM * DM);
    const float* x0 = gi == 0 ? ka->x_prompt : (gi == 1 ? ka->x_sample : ka->x_sample + (size_t)GM * DM);
    c.xout = outg; c.xin = l == 0 ? x0 : outg;
    return c;
}

__global__ void __launch_bounds__(512, 2) fwd_megakernel(Args a_unused) {
    extern __shared__ __attribute__((aligned(16))) unsigned char lds_raw[];
    LAS unsigned char* lds = (LAS unsigned char*)lds_raw;
    cg::grid_group grid = cg::this_grid();

    prologue(kargs(), lds);
    { const Ctx c0 = make_ctx(0, 0); norm_phase(c0); }
    {
        unsigned* bw = (unsigned*)(kargs()->ws + WS_BAR);
        if (blockIdx.x == 0) for (int i = threadIdx.x; i < XCD_BAR_WORDS; i += 512) bw[i] = 0u;
        if (threadIdx.x < 2) ((volatile LAS unsigned*)(lds + 131072 + 256))[threadIdx.x] = 0u;
    }
    grid.sync();
    (void)xcd_barrier_post((unsigned*)(kargs()->ws + WS_BAR), (volatile LAS unsigned*)(lds + 131072 + 256));

#pragma unroll 1
#ifdef TEST_NOLOOP
    for (int gi = 0; gi < 1; ++gi) {
#else
    for (int gi = 0; gi < 3; ++gi) {
#endif
#pragma unroll 1
#ifdef TEST_NOLOOP
        for (int l = 0; l < 1; ++l) {
#else
        for (int l = 0; l < DEPTH; ++l) {
#endif
            {
                const Ctx c = make_ctx(gi, l); KArgsP ka = kargs(); unsigned char* ws = c.ws;
                pg8::Gemm g{CB(c, WS_XN), (const bf16_t*)(ws + WS_WIN + l * WIN_BYTES), GM, NPHYS, DM}; pg8::StaticOrder So; So.init(GM, NPHYS, gridDim.x, blockIdx.x);
                EpiProj E{ws, (const float*)(ws + WS_BIAS) + l * NPHYS};
#ifndef NO_P2
                pg8::gemm_phase<EpiProj, pg8::StaticOrder, true, true>(lds, g, So, E);
#endif
            }
            xcd_barrier(lds);
            {
                const Ctx c = make_ctx(gi, l); KArgsP ka = kargs();
                const int G = gridDim.x, bid = blockIdx.x, wave = tid_opaque() >> 6;
                knorm_rows(c, ka->k_norm_g + l * 64);
#ifndef NO_P3B
                for (int u = bid; u < 1024; u += G) prep_unit(lds, u, c, ka->conv_w + (size_t)l * 3 * 2048);
#endif
                for (int j = bid * 8 + wave; j < 2048; j += G * 8) scan_job(j, c);
            }
            xcd_barrier(lds);
            {
                const Ctx c = make_ctx(gi, l); KArgsP ka = kargs();
                const int nu = c.nseq * 32;
                const float mb = ((const float*)(c.ws + WS_MB))[l];
#ifndef NO_P3A
                if (nu == 128 && gridDim.x == 256) {
                    const int b = blockIdx.x;
                    if (b < 128) attn_unit(lds, b, c, ka->sink + l * 16, mb, CB(c, WS_Q), ka->q_norm_g + l * 64);
                    else for (int k = 0; k < 3; ++k) attn_unit(lds, 128 + (b - 128) * 3 + k, c, ka->sink + l * 16, mb, CB(c, WS_Q), ka->q_norm_g + l * 64);
                } else {
                    for (int u = blockIdx.x; u < 512; u += gridDim.x) attn_unit(lds, u, c, ka->sink + l * 16, mb, CB(c, WS_Q), ka->q_norm_g + l * 64);
                }
#endif
#ifndef NO_P4
                for (int u = blockIdx.x; u < nu; u += gridDim.x) mlstm_state_unit(lds, u, c);
#endif
            }
            xcd_barrier(lds);
            {
                const Ctx c = make_ctx(gi, l);
#ifndef NO_P4
                const int tid = tid_opaque(), w = __builtin_amdgcn_readfirstlane(tid >> 6), lane = tid & 63;
                const float* mgp = kargs()->m_norm_g + l * DM;
                int u = blockIdx.x, k = 0;
                if (u < 1024) out_stage(lds, u, c, w, lane);
                for (; u < 1024; u += gridDim.x, ++k) {
                    asm volatile("s_waitcnt vmcnt(0)" ::: "memory"); __syncthreads();
                    const int un = u + gridDim.x;
                    if (un < 1024) out_stage(lds + ((k + 1) & 1) * 65536, un, c, w, lane);
                    mlstm_out_unit(lds + (k & 1) * 65536, (LAS float*)(lds + 131072 + 1024), u, c, mgp);
                }
                asm volatile("s_waitcnt vmcnt(0)" ::: "memory"); __syncthreads();
#endif
            }
            xcd_barrier(lds);
            {
                const Ctx c = make_ctx(gi, l); unsigned char* ws = c.ws;
                pg8::StaticOrder So; So.init(GM, DM, gridDim.x, blockIdx.x);
                { pg8::Gemm g{CB(c, WS_Q), (const bf16_t*)(ws + WS_WA + (size_t)l * DM * DM * 2), GM, DM, DM}; EpiGate<0> E{CB(c, WS_GT), CB(c, WS_T), CB(c, WS_MG)};
#ifndef NO_P6
                  pg8::gemm_phase<EpiGate<0>, pg8::StaticOrder, true, true>(lds, g, So, E);
#endif
                }
            }
            {
                const Ctx c = make_ctx(gi, l); unsigned char* ws = c.ws;
                pg8::StaticOrder So; So.init(GM, DM, gridDim.x, blockIdx.x);
                { pg8::Gemm g{CB(c, WS_MZ), (const bf16_t*)(ws + WS_WM + (size_t)l * DM * DM * 2), GM, DM, DM}; EpiGate<1> E{CB(c, WS_GT), CB(c, WS_T), CB(c, WS_MG)};
#ifndef NO_P6
                  pg8::gemm_phase<EpiGate<1>, pg8::StaticOrder, true, true>(lds, g, So, E);
#endif
                }
            }
            xcd_barrier(lds);
            {
                const Ctx c = make_ctx(gi, l); unsigned char* ws = c.ws;
                pg8::StaticOrder So; So.init(GM, DM, gridDim.x, blockIdx.x);
                pg8::Gemm g{CB(c, WS_MG), (const bf16_t*)(ws + WS_WO + (size_t)l * DM * DM * 2), GM, DM, DM}; EpiRes E{c.xin, c.xout, CB(c, WS_XN), CF(c, WS_RS), (LAS float*)(lds + 131072 + 4096), l < DEPTH - 1 ? 1 : 0};
#ifndef NO_P7
                pg8::gemm_phase<EpiRes, pg8::StaticOrder, true, true>(lds, g, So, E);
#endif
            }
            if (l == DEPTH - 1 && gi < 2) { const Ctx cn = make_ctx(gi + 1, 0); norm_phase(cn); }
            xcd_barrier(lds);
        }
    }
}

extern "C" void kernel_launch(void* const* d_in, const int* in_sizes, int n_in, void* d_out, int out_size, void* d_ws, size_t ws_size, hipStream_t stream) {
    static int grid = 0;
    if (grid == 0) {
        if (n_in != 13 || ws_size < WS_END) { fprintf(stderr, "kernel_launch: need 13 inputs and >= %zu bytes of workspace (got %d, %zu)\n", (size_t)WS_END, n_in, ws_size); grid = -1; return; }
        int dev = 0, cus = 0, per_cu = 0;
        hipGetDevice(&dev);
        hipDeviceGetAttribute(&cus, hipDeviceAttributeMultiprocessorCount, dev);
        if (hipFuncSetAttribute((const void*)fwd_megakernel, hipFuncAttributeMaxDynamicSharedMemorySize, LDS_BYTES) != hipSuccess) { fprintf(stderr, "kernel_launch: hipFuncSetAttribute failed\n"); grid = -1; return; }
        if (hipOccupancyMaxActiveBlocksPerMultiprocessor(&per_cu, (const void*)fwd_megakernel, 512, LDS_BYTES) != hipSuccess || per_cu < 1) { fprintf(stderr, "kernel_launch: occupancy query failed (%d)\n", per_cu); per_cu = 1; }
        (void)hipGetLastError();
        grid = cus;
    }
    if (grid < 0) return;
    Args a{};
    a.x_prompt = (const float*)d_in[0]; a.x_sample = (const float*)d_in[1]; a.norm_g = (const float*)d_in[2]; a.w_in = (const float*)d_in[3]; a.b_in = (const float*)d_in[4];
    a.q_norm_g = (const float*)d_in[5]; a.k_norm_g = (const float*)d_in[6]; a.sink = (const float*)d_in[7]; a.conv_w = (const float*)d_in[8]; a.m_norm_g = (const float*)d_in[9];
    a.w_att_out = (const float*)d_in[10]; a.w_m_out = (const float*)d_in[11]; a.w_out = (const float*)d_in[12];
    a.out = (float*)d_out; a.ws = (unsigned char*)d_ws;
    void* args[] = {&a};
    hipError_t e = hipLaunchCooperativeKernel((const void*)fwd_megakernel, dim3(grid), dim3(512), args, LDS_BYTES, stream);
    if (e != hipSuccess) fprintf(stderr, "kernel_launch: cooperative launch failed: %s (grid %d)\n", hipGetErrorString(e), grid);
}
```

```cpp
#include <hip/hip_runtime.h>
#include <hip/hip_cooperative_groups.h>
#include <cstdio>
#include <cstdint>
namespace cg = cooperative_groups;

#define LAS __attribute__((address_space(3)))
typedef unsigned short bf16_t;
typedef short bf16x8 __attribute__((ext_vector_type(8)));
typedef float f32x4 __attribute__((ext_vector_type(4)));
typedef float f32x16 __attribute__((ext_vector_type(16)));
typedef unsigned u32x4 __attribute__((ext_vector_type(4)));
typedef unsigned u32x2 __attribute__((ext_vector_type(2)));

constexpr int DM = 1024, DEPTH = 4, IN_DIM = 9760, NPHYS = 9984, NTILE_IN = 39;
constexpr int GM = 16384;
constexpr float NORM_EPS = 1e-6f;
constexpr float KSCALE = 0.08838834764831845f;

constexpr size_t MiB = 1u << 20;
constexpr size_t WS_MB = 0, WS_BAR = 512 * 1024;
constexpr size_t WS_ROPE = 1 * MiB;
constexpr size_t WS_BIAS = 2 * MiB;
constexpr size_t WS_WIN = 3 * MiB;
constexpr size_t WIN_BYTES = (size_t)NPHYS * DM * 2;
constexpr size_t WS_WA = 81 * MiB, WS_WM = 89 * MiB, WS_WO = 97 * MiB;
constexpr size_t WS_AZ = 105 * MiB;
constexpr size_t WS_Q = 137 * MiB, WS_K = 169 * MiB, WS_V = 177 * MiB;
constexpr size_t WS_MQ = 185 * MiB, WS_MK = 217 * MiB, WS_MV = 249 * MiB, WS_XN = 281 * MiB;
constexpr size_t WS_MO = 313 * MiB, WS_MZ = 345 * MiB, WS_GT = 377 * MiB, WS_IF = 441 * MiB;
constexpr size_t WS_QC = 443 * MiB, WS_KC = 475 * MiB, WS_KT = 507 * MiB, WS_VT = 539 * MiB;
constexpr size_t WS_SA = 571 * MiB, WS_SCM = 572 * MiB, WS_SB = 573 * MiB;
constexpr size_t WS_EA = 574 * MiB, WS_NP = 575 * MiB, WS_MP = 575 * MiB + 768 * 1024, WS_RS = 576 * MiB, WS_END = 577 * MiB;
constexpr size_t WS_HF = WS_MQ, WS_HB = WS_MK;
constexpr size_t WS_CP = WS_MV;
constexpr size_t WS_T = WS_QC, WS_MG = WS_KC;

constexpr int LDS_BYTES = 147456;

typedef __bf16 bf16v2_t __attribute__((ext_vector_type(2)));
typedef float f32v2_t __attribute__((ext_vector_type(2)));
__device__ __forceinline__ unsigned cvt_pk_bf16(float lo, float hi) { const f32v2_t v = {lo, hi}; return __builtin_bit_cast(unsigned, __builtin_convertvector(v, bf16v2_t)); }
__device__ __forceinline__ float bflo(unsigned w) { return __uint_as_float(w << 16); }
__device__ __forceinline__ float bfhi(unsigned w) { return __uint_as_float(w & 0xffff0000u); }
__device__ __forceinline__ float fexp(float x) { return __builtin_amdgcn_exp2f(x * 1.4426950408889634f); }
__device__ __forceinline__ int crow(int r, int hi) { return (r & 3) + 8 * (r >> 2) + 4 * hi; }
__device__ __forceinline__ int tid_opaque() { int t = threadIdx.x; asm volatile("" : "+v"(t)); return t; }
__device__ __forceinline__ float shfl_x(float v, int lane, int m) { return __int_as_float(__builtin_amdgcn_ds_bpermute((lane ^ m) << 2, __float_as_int(v))); }
__device__ __forceinline__ float shfl_u(float v, int lane, int o) { int src = lane - o; src = src < 0 ? lane : src; return __int_as_float(__builtin_amdgcn_ds_bpermute(src << 2, __float_as_int(v))); }
#define MFMA32(a, b, c) __builtin_amdgcn_mfma_f32_32x32x16_bf16((a), (b), (c), 0, 0, 0)

namespace pg8 {
constexpr int BM = 256, BK = 64, HALF = 128, HTB = HALF * BK * 2, STAGE_BYTES = 8 * HTB, NXCD = 8, WGM = 8;
__host__ __device__ __forceinline__ int lds_byte(int r, int c) { const int st = (r >> 4) * 2 + (c >> 5), rr = r & 15, cc = c & 31, ob = rr * 64 + cc * 2; return st * 1024 + (ob ^ (((ob >> 9) & 1) << 5)); }
__host__ __device__ __forceinline__ void stage_rc(int b, int& R, int& C) { const int st = b / 1024, sb = b % 1024, swz = sb ^ (((sb >> 9) & 1) << 5); R = (st >> 1) * 16 + swz / 64; C = (st & 1) * 32 + (swz % 64) / 2; }
__host__ __device__ __forceinline__ int perm32(int rho) { const int n = rho >> 4, i = rho & 15; return 8 * (i >> 2) + 4 * n + (i & 3); }

struct Unit { int pm, pn; };
struct Gemm { const bf16_t* A; const bf16_t* Bt; int M, N, K; };

struct StaticOrder {
    int nM, nN, nwg, G, c;
    __host__ __device__ void init(int M, int N, int G_, int c_) { nM = M / BM; nN = N / BM; nwg = nM * nN; G = G_; c = c_; }
    __host__ __device__ bool next(int i, Unit& u) const {
        const long L = (long)i * G + c; if (L >= nwg) return false;
        int wgid = (int)L; { const int q = nwg / NXCD, r = nwg % NXCD, xcd = wgid % NXCD, off = wgid / NXCD; wgid = (xcd < r ? xcd * (q + 1) : r * (q + 1) + (xcd - r) * q) + off; }
        const int nig = WGM * nN, gid = wgid / nig, fm = gid * WGM, gsz = (nM - fm) < WGM ? (nM - fm) : WGM;
        u.pm = fm + ((wgid % nig) % gsz); u.pn = (wgid % nig) / gsz; return true;
    }
    __device__ __forceinline__ void a_ready(const Unit&) const {}
    __device__ __forceinline__ void done(const Unit&) const {}
};

template <class Epi, class Sched, bool ALIGN_EPI = false, bool SP2 = false>
__device__ __forceinline__ void gemm_phase(LAS unsigned char* lds, const Gemm g, const Sched& S, const Epi& E) {
    const int tid = tid_opaque(), wid = __builtin_amdgcn_readfirstlane(tid >> 6), lane = tid & 63, wr = wid >> 2, wc = wid & 3, fr = lane & 15, fq = lane >> 4;
    const int K = g.K, nt = K / BK;
    unsigned voffA[2], voffB[2];
#pragma unroll
    for (int i = 0; i < 2; ++i) { int R, C; stage_rc(tid * 16 + i * 8192, R, C); const int Rb = Epi::PERM ? ((R & ~31) + perm32(R & 31)) : R;
        voffA[i] = (unsigned)(R * K + C) * 2u; voffB[i] = (unsigned)(Rb * K + C) * 2u; }
    const size_t kstep = (size_t)(BK * 2);
    const size_t hstep = (size_t)HALF * K * 2;
    const size_t tstep = 2 * hstep;
    const unsigned ldsw = (unsigned)wid * 1024u;
    const int aoff = lds_byte(wr * 64 + fr, fq * 8), boff = lds_byte(wc * 32 + fr, fq * 8);
#define PG8_SA(b, h) (((b) * 2 + (h)) * HTB)
#define PG8_SB(b, h) ((4 + (b) * 2 + (h)) * HTB)
#define PG8_STAGE(bufoff, gbase, voff) do { _Pragma("unroll") for (int _i = 0; _i < 2; ++_i) \
        __builtin_amdgcn_global_load_lds((const unsigned*)((const char*)(gbase) + (voff)[_i]), (LAS unsigned*)(lds + (bufoff) + ldsw + _i * 8192), 16, 0, 0); } while (0)
#define PG8_LDA(dst, b, h) do { _Pragma("unroll") for (int m = 0; m < 4; ++m) _Pragma("unroll") for (int k = 0; k < 2; ++k) dst[m][k] = *(const LAS bf16x8*)(lds + PG8_SA(b, h) + aoff + m * 2048 + k * 1024); } while (0)
#define PG8_LDB(dst, b, h) do { _Pragma("unroll") for (int n = 0; n < 2; ++n) _Pragma("unroll") for (int k = 0; k < 2; ++k) dst[n][k] = *(const LAS bf16x8*)(lds + PG8_SB(b, h) + boff + n * 2048 + k * 1024); } while (0)
#define PG8_MMA(ai, bj, At, Bt) do { __builtin_amdgcn_s_setprio(1); _Pragma("unroll") for (int m = 0; m < 4; ++m) _Pragma("unroll") for (int n = 0; n < 2; ++n) _Pragma("unroll") for (int k = 0; k < 2; ++k) \
        acc[ai][bj][m][n] = __builtin_amdgcn_mfma_f32_16x16x32_bf16(Bt[n][k], At[m][k], acc[ai][bj][m][n], 0, 0, 0); __builtin_amdgcn_s_setprio(0); } while (0)
#define PG8_WAIT_V(n) asm volatile("s_waitcnt vmcnt(" #n ")" ::: "memory")
#define PG8_WAIT_L(n) asm volatile("s_waitcnt lgkmcnt(" #n ")" ::: "memory")
#define PG8_BAR __builtin_amdgcn_s_barrier()
#define PG8_SCHED __builtin_amdgcn_sched_barrier(0)
    Unit cur, nxt; int ui = 0;
    if (!S.next(0, cur)) return;
    f32x4 acc[2][2][4][2];
#pragma unroll
    for (int a = 0; a < 2; ++a)
#pragma unroll
        for (int b = 0; b < 2; ++b)
#pragma unroll
            for (int m = 0; m < 4; ++m)
#pragma unroll
                for (int n = 0; n < 2; ++n) acc[a][b][m][n] = (f32x4){0.f, 0.f, 0.f, 0.f};
    bf16x8 At[4][2], B0[2][2], B1[2][2];
    const char* cA = (const char*)g.A + (size_t)cur.pm * tstep; const char* cB = (const char*)g.Bt + (size_t)cur.pn * tstep;
    S.a_ready(cur);
    if constexpr (SP2) {
        PG8_STAGE(PG8_SB(0, 0), cB, voffB); PG8_STAGE(PG8_SB(0, 1), cB + hstep, voffB); PG8_STAGE(PG8_SA(0, 0), cA, voffA); PG8_STAGE(PG8_SA(0, 1), cA + hstep, voffA);
        if (wr == 1) PG8_BAR;
        PG8_WAIT_V(2); PG8_BAR;
        PG8_STAGE(PG8_SB(1, 0), cB + kstep, voffB); PG8_STAGE(PG8_SA(1, 0), cA + kstep, voffA); PG8_STAGE(PG8_SB(1, 1), cB + hstep + kstep, voffB);
        PG8_WAIT_V(6); PG8_BAR;
    } else {
        PG8_STAGE(PG8_SB(0, 0), cB, voffB); PG8_STAGE(PG8_SA(0, 0), cA, voffA); PG8_STAGE(PG8_SB(0, 1), cB + hstep, voffB); PG8_STAGE(PG8_SA(0, 1), cA + hstep, voffA);
        if (wr == 1) PG8_BAR;
        PG8_WAIT_V(4); PG8_BAR;
        PG8_STAGE(PG8_SB(1, 0), cB + kstep, voffB); PG8_STAGE(PG8_SA(1, 0), cA + kstep, voffA); PG8_STAGE(PG8_SB(1, 1), cB + hstep + kstep, voffB);
        PG8_WAIT_V(6); PG8_BAR;
    }
    for (;;) {
        const bool has_next = S.next(ui + 1, nxt);
        const char* nA = has_next ? (const char*)g.A + (size_t)nxt.pm * tstep : cA; const char* nB = has_next ? (const char*)g.Bt + (size_t)nxt.pn * tstep : cB;
        for (int t = 0; t < nt; t += 2) {
            const bool last = (t == nt - 2);
            const char* a1 = cA + (size_t)(t + 1) * kstep;
            const char* a2 = last ? nA : cA + (size_t)(t + 2) * kstep; const char* b2 = last ? nB : cB + (size_t)(t + 2) * kstep;
            const char* a3 = a2 + kstep; const char* b3 = b2 + kstep;
            if (last && has_next) S.a_ready(nxt);
            if constexpr (SP2) {
            PG8_LDB(B0, 0, 0); PG8_LDB(B1, 0, 1); PG8_SCHED; PG8_LDA(At, 0, 0); PG8_STAGE(PG8_SA(1, 1), a1 + hstep, voffA);
            PG8_WAIT_V(8); PG8_WAIT_L(0); PG8_BAR; PG8_MMA(0, 0, At, B0); PG8_MMA(0, 1, At, B1); PG8_BAR; PG8_SCHED;
            PG8_LDA(At, 0, 1); PG8_STAGE(PG8_SB(0, 0), b2, voffB); PG8_STAGE(PG8_SB(0, 1), b2 + hstep, voffB); PG8_STAGE(PG8_SA(0, 0), a2, voffA);
            PG8_WAIT_V(8); PG8_WAIT_L(0); PG8_BAR; PG8_MMA(1, 0, At, B0); PG8_MMA(1, 1, At, B1); PG8_BAR; PG8_SCHED;
            PG8_LDB(B0, 1, 0); PG8_LDB(B1, 1, 1); PG8_SCHED; PG8_LDA(At, 1, 0); PG8_STAGE(PG8_SA(0, 1), a2 + hstep, voffA);
            PG8_WAIT_V(8); PG8_WAIT_L(0); PG8_BAR; PG8_MMA(0, 0, At, B0); PG8_MMA(0, 1, At, B1); PG8_BAR; PG8_SCHED;
            PG8_LDA(At, 1, 1); PG8_STAGE(PG8_SB(1, 0), b3, voffB); PG8_STAGE(PG8_SB(1, 1), b3 + hstep, voffB); PG8_STAGE(PG8_SA(1, 0), a3, voffA);
            PG8_WAIT_V(8); PG8_WAIT_L(0); PG8_BAR; PG8_MMA(1, 0, At, B0); PG8_MMA(1, 1, At, B1); PG8_BAR; PG8_SCHED;
            } else {
            PG8_LDB(B0, 0, 0); PG8_SCHED; PG8_LDA(At, 0, 0); PG8_STAGE(PG8_SA(1, 1), a1 + hstep, voffA);
            PG8_WAIT_L(8); PG8_BAR; PG8_WAIT_L(0); PG8_MMA(0, 0, At, B0); PG8_BAR; PG8_SCHED;
            PG8_LDB(B1, 0, 1); PG8_STAGE(PG8_SB(0, 0), b2, voffB);
            PG8_BAR; PG8_WAIT_L(0); PG8_MMA(0, 1, At, B1); PG8_BAR;
            PG8_LDA(At, 0, 1); PG8_STAGE(PG8_SA(0, 0), a2, voffA);
            PG8_BAR; PG8_WAIT_L(0); PG8_MMA(1, 0, At, B0); PG8_BAR; PG8_SCHED;
            PG8_STAGE(PG8_SB(0, 1), b2 + hstep, voffB);
            PG8_WAIT_V(6); PG8_BAR; PG8_MMA(1, 1, At, B1); PG8_BAR;
            PG8_LDB(B0, 1, 0); PG8_SCHED; PG8_LDA(At, 1, 0); PG8_STAGE(PG8_SA(0, 1), a2 + hstep, voffA);
            PG8_WAIT_L(8); PG8_BAR; PG8_WAIT_L(0); PG8_MMA(0, 0, At, B0); PG8_BAR; PG8_SCHED;
            PG8_LDB(B1, 1, 1); PG8_STAGE(PG8_SB(1, 0), b3, voffB);
            PG8_BAR; PG8_WAIT_L(0); PG8_MMA(0, 1, At, B1); PG8_BAR;
            PG8_LDA(At, 1, 1); PG8_STAGE(PG8_SA(1, 0), a3, voffA);
            PG8_BAR; PG8_WAIT_L(0); PG8_MMA(1, 0, At, B0); PG8_BAR; PG8_SCHED;
            PG8_STAGE(PG8_SB(1, 1), b3 + hstep, voffB);
            PG8_WAIT_V(6); PG8_BAR; PG8_MMA(1, 1, At, B1); PG8_BAR;
            }
        }
        if constexpr (ALIGN_EPI) { if (wr == 0) PG8_BAR; }
        E(acc, cur, wr, wc, fr, fq); S.done(cur);
        if (!has_next) break;
#pragma unroll
        for (int a = 0; a < 2; ++a)
#pragma unroll
            for (int b = 0; b < 2; ++b)
#pragma unroll
                for (int m = 0; m < 4; ++m)
#pragma unroll
                    for (int n = 0; n < 2; ++n) acc[a][b][m][n] = (f32x4){0.f, 0.f, 0.f, 0.f};
        cur = nxt; cA = nA; cB = nB; ++ui;
        if constexpr (ALIGN_EPI) { if (wr == 1) PG8_BAR; }
    }
    PG8_WAIT_V(0);
    if constexpr (!ALIGN_EPI) { if (wr == 0) PG8_BAR; }
    PG8_BAR;
#undef PG8_SA
#undef PG8_SB
#undef PG8_STAGE
#undef PG8_LDA
#undef PG8_LDB
#undef PG8_MMA
#undef PG8_WAIT_V
#undef PG8_WAIT_L
#undef PG8_BAR
#undef PG8_SCHED
}
}

__device__ __forceinline__ float row_rscale(const float* rs, int row) {
    const f32x4 a = *(const f32x4*)(rs + (size_t)row * 4);
    return __builtin_amdgcn_rsqf(((a[0] + a[1]) + (a[2] + a[3])) * (1.f / DM) + NORM_EPS);
}

struct EpiProj {
    static constexpr bool PERM = true;
    unsigned char* ws; const float* bias;
    __device__ __forceinline__ void operator()(const f32x4 (&acc)[2][2][4][2], const pg8::Unit& u, int wr, int wc, int fr, int fq) const {
        const int pn = u.pn;
        const int row0 = u.pm * 256 + wr * 64 + fr;
        const int pc0 = pn * 256 + wc * 32 + 8 * fq;
        float rscv[2][4];
#pragma unroll
        for (int ai = 0; ai < 2; ++ai)
#pragma unroll
            for (int m = 0; m < 4; ++m) rscv[ai][m] = row_rscale((const float*)(ws + WS_RS), row0 + ai * 128 + m * 16);
        if (false) {
        } else if (pn == 38) {
            if (wc == 0) {
                f32x4 bv[2];
#pragma unroll
                for (int n = 0; n < 2; ++n) bv[n] = *(const f32x4*)(bias + pc0 + 4 * n);
#pragma unroll
                for (int ai = 0; ai < 2; ++ai)
#pragma unroll
                    for (int m = 0; m < 4; ++m) {
                        const int row = row0 + ai * 128 + m * 16;
                        const float rsc = rscv[ai][m];
#pragma unroll
                        for (int n = 0; n < 2; ++n) {
                            f32x4 v = acc[ai][0][m][n] * rsc + bv[n];
                            if (fq & 1) {
#pragma unroll
                                for (int i = 0; i < 4; ++i) { const float ex = fexp(-fabsf(v[i])); const float l1 = ex < 0.01f ? ex * (1.f - ex * (0.5f - ex * 0.33333333f)) : __logf(1.f + ex); v[i] = fminf(v[i], 0.f) - l1; }
                            }
                            *(f32x4*)((float*)(ws + WS_IF) + (size_t)row * 32 + 8 * fq + 4 * n) = v;
                        }
                    }
            }
        } else {
            size_t doff; int ld, col, act;
            if (pn < 4) { doff = WS_Q; ld = 1024; col = pn * 256; act = 0; }
            else if (pn == 4) { doff = WS_K; ld = 256; col = 0; act = 0; }
            else if (pn == 5) { doff = WS_V; ld = 256; col = 0; act = 0; }
            else if (pn < 10) { doff = WS_AZ; ld = 1024; col = (pn - 6) * 256; act = 1; }
            else if (pn < 14) { doff = WS_MQ; ld = 1024; col = (pn - 10) * 256; act = 0; }
            else if (pn < 18) { doff = WS_MK; ld = 1024; col = (pn - 14) * 256; act = 0; }
            else if (pn < 22) { doff = WS_MV; ld = 1024; col = (pn - 18) * 256; act = 0; }
            else if (pn < 26) { doff = WS_MO; ld = 1024; col = (pn - 22) * 256; act = 2; }
            else if (pn < 30) { doff = WS_MZ; ld = 1024; col = (pn - 26) * 256; act = 1; }
            else { doff = WS_GT; ld = 2048; col = (pn - 30) * 256; act = 2; }
            bf16_t* dst = (bf16_t*)(ws + doff);
            col += wc * 32 + 8 * fq;
            f32x4 bv[2][2];
#pragma unroll
            for (int bj = 0; bj < 2; ++bj)
#pragma unroll
                for (int n = 0; n < 2; ++n) bv[bj][n] = *(const f32x4*)(bias + pc0 + bj * 128 + 4 * n);
#pragma unroll
            for (int ai = 0; ai < 2; ++ai)
#pragma unroll
                for (int m = 0; m < 4; ++m) {
                    bf16_t* rowp = dst + (size_t)(row0 + ai * 128 + m * 16) * ld + col;
                    const float rsc = rscv[ai][m];
#pragma unroll
                    for (int bj = 0; bj < 2; ++bj) {
                        f32x4 v[2];
#pragma unroll
                        for (int n = 0; n < 2; ++n) {
                            v[n] = acc[ai][bj][m][n] * rsc + bv[bj][n];
                            if (act != 0) {
#pragma unroll
                                for (int i = 0; i < 4; ++i) { const float s = __builtin_amdgcn_rcpf(1.f + fexp(-v[n][i])); v[n][i] = act == 1 ? v[n][i] * s : s; }
                            }
                        }
                        u32x4 w; w.x = cvt_pk_bf16(v[0][0], v[0][1]); w.y = cvt_pk_bf16(v[0][2], v[0][3]); w.z = cvt_pk_bf16(v[1][0], v[1][1]); w.w = cvt_pk_bf16(v[1][2], v[1][3]);
                        __builtin_nontemporal_store(w, (u32x4*)(rowp + bj * 128));
                    }
                }
        }
    }
};

template <int MODE> struct EpiGate {
    static constexpr bool PERM = true;
    const bf16_t* GT; bf16_t* T; bf16_t* MG;
    __device__ __forceinline__ void operator()(const f32x4 (&acc)[2][2][4][2], const pg8::Unit& u, int wr, int wc, int fr, int fq) const {
        const int row0 = u.pm * 256 + wr * 64 + fr; const int col0 = u.pn * 256 + wc * 32 + 8 * fq;
        u32x4 gc[2], tc[2];
#pragma unroll
        for (int bj = 0; bj < 2; ++bj) { gc[bj] = *(const u32x4*)(GT + (size_t)row0 * 2048 + MODE * 1024 + col0 + bj * 128); if (MODE == 1) tc[bj] = *(const u32x4*)(T + (size_t)row0 * 1024 + col0 + bj * 128); }
#pragma unroll
        for (int it = 0; it < 8; ++it) {
            const int ai = it >> 2, m = it & 3;
            const size_t row = (size_t)(row0 + ai * 128 + m * 16);
            u32x4 gn[2], tn[2];
            if (it < 7) { const size_t rown = (size_t)(row0 + ((it + 1) >> 2) * 128 + ((it + 1) & 3) * 16);
#pragma unroll
                for (int bj = 0; bj < 2; ++bj) { gn[bj] = *(const u32x4*)(GT + rown * 2048 + MODE * 1024 + col0 + bj * 128); if (MODE == 1) tn[bj] = *(const u32x4*)(T + rown * 1024 + col0 + bj * 128); } }
#pragma unroll
            for (int bj = 0; bj < 2; ++bj) {
                const int col = col0 + bj * 128;
                const u32x4 gw = gc[bj];
                float o[8];
                o[0] = acc[ai][bj][m][0][0] * bflo(gw.x); o[1] = acc[ai][bj][m][0][1] * bfhi(gw.x); o[2] = acc[ai][bj][m][0][2] * bflo(gw.y); o[3] = acc[ai][bj][m][0][3] * bfhi(gw.y);
                o[4] = acc[ai][bj][m][1][0] * bflo(gw.z); o[5] = acc[ai][bj][m][1][1] * bfhi(gw.z); o[6] = acc[ai][bj][m][1][2] * bflo(gw.w); o[7] = acc[ai][bj][m][1][3] * bfhi(gw.w);
                if (MODE == 1) {
                    const u32x4 tw = tc[bj];
                    o[0] += bflo(tw.x); o[1] += bfhi(tw.x); o[2] += bflo(tw.y); o[3] += bfhi(tw.y); o[4] += bflo(tw.z); o[5] += bfhi(tw.z); o[6] += bflo(tw.w); o[7] += bfhi(tw.w);
                }
                u32x4 w; w.x = cvt_pk_bf16(o[0], o[1]); w.y = cvt_pk_bf16(o[2], o[3]); w.z = cvt_pk_bf16(o[4], o[5]); w.w = cvt_pk_bf16(o[6], o[7]);
                *(u32x4*)((MODE == 0 ? T : MG) + row * 1024 + col) = w;
            }
            if (it < 7) {
#pragma unroll
                for (int bj = 0; bj < 2; ++bj) { gc[bj] = gn[bj]; if (MODE == 1) tc[bj] = tn[bj]; } }
            asm volatile("" ::: "memory");
        }
    }
};

struct EpiRes {
    static constexpr bool PERM = false;
    const float* xin; float* xout; bf16_t* xb; float* rsq; LAS float* xl; int wxb;
    __device__ __forceinline__ void operator()(const f32x4 (&acc)[2][2][4][2], const pg8::Unit& u, int wr, int wc, int fr, int fq) const {
        const int row0 = u.pm * 256 + wr * 64 + fr; const int col0 = u.pn * 256 + wc * 32 + 4 * fq; const int lane = fq * 16 + fr;
        f32x4 xc[2][2];
#pragma unroll
        for (int bj = 0; bj < 2; ++bj)
#pragma unroll
            for (int n = 0; n < 2; ++n) xc[bj][n] = *(const f32x4*)(xin + (size_t)row0 * 1024 + col0 + bj * 128 + n * 16);
#pragma unroll
        for (int it = 0; it < 8; ++it) {
            const int ai = it >> 2, m = it & 3;
            const int row = row0 + ai * 128 + m * 16;
            const size_t off = (size_t)row * 1024 + col0;
            f32x4 xn[2][2];
            if (it < 7) { const size_t offn = (size_t)(row0 + ((it + 1) >> 2) * 128 + ((it + 1) & 3) * 16) * 1024 + col0;
#pragma unroll
                for (int bj = 0; bj < 2; ++bj)
#pragma unroll
                    for (int n = 0; n < 2; ++n) xn[bj][n] = *(const f32x4*)(xin + offn + bj * 128 + n * 16); }
            float ss = 0.f;
#pragma unroll
            for (int bj = 0; bj < 2; ++bj)
#pragma unroll
                for (int n = 0; n < 2; ++n) { const f32x4 x = xc[bj][n] + acc[ai][bj][m][n]; *(f32x4*)(xout + off + bj * 128 + n * 16) = x;
                    if (wxb) { u32x2 w; w.x = cvt_pk_bf16(x[0], x[1]); w.y = cvt_pk_bf16(x[2], x[3]); *(u32x2*)(xb + off + bj * 128 + n * 16) = w; }
                    ss += (x[0] * x[0] + x[1] * x[1]) + (x[2] * x[2] + x[3] * x[3]); }
            ss += shfl_x(ss, lane, 16); ss += shfl_x(ss, lane, 32);
            if (fq == 0) xl[(row - u.pm * 256) * 4 + wc] = ss;
            if (it < 7) {
#pragma unroll
                for (int bj = 0; bj < 2; ++bj)
#pragma unroll
                    for (int n = 0; n < 2; ++n) xc[bj][n] = xn[bj][n]; }
            asm volatile("" ::: "memory");
        }
        __syncthreads();
        {
            const int t = wr * 256 + wc * 64 + lane;
            if (t < 256 && wxb) { const f32x4 a = *(const LAS f32x4*)(xl + t * 4); rsq[(size_t)(u.pm * 256 + t) * 4 + u.pn] = (a[0] + a[1]) + (a[2] + a[3]); }
        }
    }
};

struct Ctx {
    int S, nseq, lgn;
    const float* xin; float* xout; unsigned char* ws;
};
#define CB(c, OFF) ((bf16_t*)((c).ws + (OFF)))
#define CF(c, OFF) ((float*)((c).ws + (OFF)))

__device__ __forceinline__ void transpose_item(const float* W, int K, int Nsrc, bf16_t* WT, int kb, int n_src, int n_dst, LAS float* scr, int lane, const float* gk) {
    const int k0 = 64 * kb;
    if (n_src >= 0) {
#pragma unroll 8
        for (int i = 0; i < 32; ++i) { const int kk = 2 * i + (lane >> 5); scr[kk * 33 + (lane & 31)] = W[(size_t)(k0 + kk) * Nsrc + n_src + (lane & 31)] * (gk ? gk[k0 + kk] : 1.f); }
    } else {
#pragma unroll 8
        for (int i = 0; i < 32; ++i) { const int kk = 2 * i + (lane >> 5); scr[kk * 33 + (lane & 31)] = 0.f; }
    }
    asm volatile("s_waitcnt lgkmcnt(0)" ::: "memory");
    const int c = lane & 7;
#pragma unroll
    for (int j = 0; j < 4; ++j) { const int n = (lane >> 3) + 8 * j; const LAS float* s = scr + (8 * c) * 33 + n;
        u32x4 o; o.x = cvt_pk_bf16(s[0 * 33], s[1 * 33]); o.y = cvt_pk_bf16(s[2 * 33], s[3 * 33]); o.z = cvt_pk_bf16(s[4 * 33], s[5 * 33]); o.w = cvt_pk_bf16(s[6 * 33], s[7 * 33]);
        *(u32x4*)(WT + (size_t)(n_dst + n) * K + k0 + 8 * c) = o; }
    asm volatile("s_waitcnt lgkmcnt(0)" ::: "memory");
}
__device__ __forceinline__ int in_block_map(int pb) {
    if (pb < 240) return pb;
    if (pb < 304) return 241 + (pb - 240);
    if (pb == 304) return 240;
    return -1;
}

struct Args {
    const float* x_prompt; const float* x_sample; const float* norm_g; const float* w_in; const float* b_in; const float* q_norm_g; const float* k_norm_g;
    const float* sink; const float* conv_w; const float* m_norm_g; const float* w_att_out; const float* w_m_out; const float* w_out;
    float* out; unsigned char* ws;
};

template <class KP> __device__ __forceinline__ void prologue(KP ka, LAS unsigned char* lds) {
    const int tid = tid_opaque(), lane = tid & 63, wave = __builtin_amdgcn_readfirstlane(tid >> 6);
    const int gw = blockIdx.x * 8 + wave, NGW = gridDim.x * 8;
    LAS float* scr = (LAS float*)(lds + wave * 16384);
    unsigned char* ws = ka->ws;
    constexpr int IT_IN = 16 * 312, IT_SQ = 16 * 32, IT_L = IT_IN + 3 * IT_SQ;
    for (int it = gw; it < DEPTH * IT_L; it += NGW) {
        const int l = it / IT_L; int r = it % IT_L;
        if (r < IT_IN) { const int kb = r / 312, pb = r % 312; const int lb = in_block_map(pb);
            transpose_item(ka->w_in + (size_t)l * DM * IN_DIM, DM, IN_DIM, (bf16_t*)(ws + WS_WIN + l * WIN_BYTES), kb, lb < 0 ? -1 : lb * 32, pb * 32, scr, lane, ka->norm_g + l * DM); continue; }
        r -= IT_IN;
        const int which = r / IT_SQ; r %= IT_SQ; const int kb = r / 32, nb = r % 32;
        const float* W = (which == 0 ? ka->w_att_out : which == 1 ? ka->w_m_out : ka->w_out) + (size_t)l * DM * DM;
        bf16_t* WT = (bf16_t*)(ws + (which == 0 ? WS_WA : which == 1 ? WS_WM : WS_WO) + (size_t)l * DM * DM * 2);
        transpose_item(W, DM, DM, WT, kb, nb * 32, nb * 32, scr, lane, nullptr);
    }
    const int gt = blockIdx.x * 512 + tid, NT = gridDim.x * 512;
    for (int i = gt; i < DEPTH * NPHYS; i += NT) { const int l = i / NPHYS, p = i % NPHYS; const int lb = in_block_map(p >> 5);
        ((float*)(ws + WS_BIAS))[i] = lb < 0 ? 0.f : ka->b_in[(size_t)l * IN_DIM + lb * 32 + (p & 31)]; }
    for (int i = gt; i < 4096 * 8; i += NT) { const int pos = i >> 3, j = i & 7;
        const float inv = j == 0 ? 1.0f : j == 1 ? 0.1939227432012558f : j == 2 ? 0.03760603070259094f : j == 3 ? 0.007292664609849453f : j == 4 ? 0.0014142135623842478f : j == 5 ? 0.00027424818836152554f : j == 6 ? 5.318296098266728e-05f : 1.0313386155758053e-05f;
        const float ang = (float)pos * inv;
        const double rev = (double)ang * 0.15915494309189535; const double fr = rev - __builtin_rint(rev);
        const float f = (float)fr;
        ((float*)(ws + WS_ROPE))[2 * i] = __builtin_amdgcn_cosf(f); ((float*)(ws + WS_ROPE))[2 * i + 1] = __builtin_amdgcn_sinf(f); }
    if (gt < DEPTH) { float mq = 0.f, mk = 0.f; for (int i = 0; i < 64; ++i) { mq = fmaxf(mq, fabsf(ka->q_norm_g[gt * 64 + i])); mk = fmaxf(mk, fabsf(ka->k_norm_g[gt * 64 + i])); }
        ((float*)(ws + WS_MB))[gt] = 8.f * mq * mk; }
}

__device__ __forceinline__ void norm_phase(const Ctx& c) {
    const int tid = tid_opaque(); const int lane = tid & 63, wave = __builtin_amdgcn_readfirstlane(tid >> 6);
    const int gw = blockIdx.x * 8 + wave, NGW = gridDim.x * 8;
    for (int m = gw; m < GM; m += NGW) {
        const f32x4* xr = (const f32x4*)(c.xin + (size_t)m * DM) + lane;
        f32x4 v[4]; float s = 0.f;
#pragma unroll
        for (int j = 0; j < 4; ++j) { v[j] = xr[64 * j]; s += (v[j].x * v[j].x + v[j].y * v[j].y) + (v[j].z * v[j].z + v[j].w * v[j].w); }
#pragma unroll
        for (int o = 1; o < 64; o <<= 1) s += shfl_x(s, lane, o);
        if (lane < 4) CF(c, WS_RS)[(size_t)m * 4 + lane] = lane == 0 ? s : 0.f;
        u32x2* o8 = (u32x2*)(CB(c, WS_XN) + (size_t)m * DM) + lane;
#pragma unroll
        for (int j = 0; j < 4; ++j) { u32x2 w; w.x = cvt_pk_bf16(v[j].x, v[j].y); w.y = cvt_pk_bf16(v[j].z, v[j].w); o8[64 * j] = w; }
    }
}

constexpr int AT_KP = 144, AT_VP = 776, AT_VOFF = 384 * AT_KP;
__device__ __forceinline__ void attn_unit(LAS unsigned char* lds, int unit, const Ctx& c, const float* sink, float mb, bf16_t* dstbuf, const float* qg) {
    const int tid = tid_opaque(), lane = tid & 63, w = __builtin_amdgcn_readfirstlane(tid >> 6), l32 = lane & 31, hi = lane >> 5;
    const int S = c.S, nb = S >> 7;
    const int g = unit & 3, qb = (unit >> 2) & (nb - 1), seq = (unit >> 2) >> c.lgn;
    const size_t rowbase = (size_t)seq * S;
    LAS unsigned char* Ks = lds; LAS unsigned char* Vt = lds + AT_VOFF;
    const int hq = g * 4 + (w >> 1);
    u32x4 qwp[2][4]; f32x4 rpp[2][4]; u32x2 zwp[2][8];
#pragma unroll
    for (int hf = 0; hf < 2; ++hf) {
        const int qi_ = ((w & 1) * 2 + hf) * 32 + l32; const size_t qrow_ = rowbase + qb * 128 + qi_;
#pragma unroll
        for (int s = 0; s < 4; ++s) { qwp[hf][s] = *(const u32x4*)(CB(c, WS_Q) + qrow_ * 1024 + hq * 64 + 16 * s + 8 * hi); rpp[hf][s] = *(const f32x4*)((const float*)(c.ws + WS_ROPE) + (qb * 128 + qi_) * 16 + 4 * s); }
#pragma unroll
        for (int k8 = 0; k8 < 8; ++k8) zwp[hf][k8] = *(const u32x2*)(CB(c, WS_AZ) + qrow_ * 1024 + hq * 64 + (k8 >> 2) * 32 + 8 * (k8 & 3) + 4 * hi);
    }
#pragma unroll
    for (int it = 0; it < 6; ++it) { const int idx = tid + it * 512; const int r = idx >> 3, ch = idx & 7; const int kpos = (qb - 1) * 128 + r;
        if (kpos >= 0 && kpos < S) { const u32x4 v = *(const u32x4*)(CB(c, WS_K) + (rowbase + kpos) * 256 + g * 64 + ch * 8); *(LAS u32x4*)(Ks + r * AT_KP + ch * 16) = v; } }
#pragma unroll
    for (int it = 0; it < 3; ++it) { const int idx = tid + it * 512; const int kp = idx >> 3, dg = idx & 7; const int key0 = kp * 2; const int kpos = (qb - 1) * 128 + key0;
        if (kpos >= 0 && kpos < S) {
            const u32x4 va = *(const u32x4*)(CB(c, WS_V) + (rowbase + kpos) * 256 + g * 64 + dg * 8), vb = *(const u32x4*)(CB(c, WS_V) + (rowbase + kpos + 1) * 256 + g * 64 + dg * 8);
            const unsigned aa[4] = {va.x, va.y, va.z, va.w}, bb[4] = {vb.x, vb.y, vb.z, vb.w};
#pragma unroll
            for (int i = 0; i < 8; ++i) { const unsigned lo = (i & 1) ? (aa[i >> 1] >> 16) : (aa[i >> 1] & 0xffffu); const unsigned hh = (i & 1) ? (bb[i >> 1] & 0xffff0000u) : (bb[i >> 1] << 16);
                *(LAS unsigned*)(Vt + (dg * 8 + i) * AT_VP + key0 * 2) = lo | hh; }
        } }
    __syncthreads();
    const float mb2 = mb * 1.4426950408889634f;
    const float sinkv = __builtin_amdgcn_exp2f(sink[hq] * 1.4426950408889634f - mb2);
#pragma unroll 1
    for (int half = 0; half < 2; ++half) {
        const int qt = (w & 1) * 2 + half; const int qi = qt * 32 + l32; const size_t qrow = rowbase + qb * 128 + qi;
        bf16x8 qf[4];
        {
            u32x4 qw[4]; float ss = 0.f;
#pragma unroll
            for (int s = 0; s < 4; ++s) { qw[s] = half ? qwp[1][s] : qwp[0][s];
                const float a0 = bflo(qw[s].x), a1 = bfhi(qw[s].x), a2 = bflo(qw[s].y), a3 = bfhi(qw[s].y), a4 = bflo(qw[s].z), a5 = bfhi(qw[s].z), a6 = bflo(qw[s].w), a7 = bfhi(qw[s].w);
                ss += ((a0 * a0 + a1 * a1) + (a2 * a2 + a3 * a3)) + ((a4 * a4 + a5 * a5) + (a6 * a6 + a7 * a7)); }
            ss += shfl_x(ss, lane, 32);
            const float rs = __builtin_amdgcn_rsqf(ss * (1.f / 64.f) + NORM_EPS) * (0.125f * 1.4426950408889634f);
            float rp[16];
#pragma unroll
            for (int s = 0; s < 4; ++s) { const f32x4 t4 = half ? rpp[1][s] : rpp[0][s]; rp[4 * s] = t4[0]; rp[4 * s + 1] = t4[1]; rp[4 * s + 2] = t4[2]; rp[4 * s + 3] = t4[3]; }
#pragma unroll
            for (int s = 0; s < 4; ++s) {
                const f32x4 g0 = *(const f32x4*)(qg + 16 * s + 8 * hi), g1 = *(const f32x4*)(qg + 16 * s + 8 * hi + 4);
                float v[8] = {bflo(qw[s].x) * rs * g0[0], bfhi(qw[s].x) * rs * g0[1], bflo(qw[s].y) * rs * g0[2], bfhi(qw[s].y) * rs * g0[3],
                              bflo(qw[s].z) * rs * g1[0], bfhi(qw[s].z) * rs * g1[1], bflo(qw[s].w) * rs * g1[2], bfhi(qw[s].w) * rs * g1[3]};
                if (s == 0) {
#pragma unroll
                    for (int j = 0; j < 8; ++j) { const float cs = rp[2 * j], sn = rp[2 * j + 1]; const float pr = shfl_x(v[j], lane, 32);
                        v[j] = hi == 0 ? v[j] * cs - pr * sn : v[j] * cs + pr * sn; }
                }
                u32x4 o; o.x = cvt_pk_bf16(v[0], v[1]); o.y = cvt_pk_bf16(v[2], v[3]); o.z = cvt_pk_bf16(v[4], v[5]); o.w = cvt_pk_bf16(v[6], v[7]);
                qf[s] = __builtin_bit_cast(bf16x8, o);
            }
        }
        f32x16 o0, o1;
#pragma unroll
        for (int r = 0; r < 16; ++r) { o0[r] = 0.f; o1[r] = 0.f; }
        float rsum = 0.f;
        const int bt_lo = qb > 0 ? qt : 4, bt_hi = qb < nb - 1 ? 8 + qt : 7;
        f32x16 pc;
#pragma unroll
        for (int r = 0; r < 16; ++r) pc[r] = -mb2;
#pragma unroll
        for (int s = 0; s < 4; ++s) { const bf16x8 ka = *(const LAS bf16x8*)(Ks + (bt_lo * 32 + l32) * AT_KP + (16 * s + 8 * hi) * 2); pc = MFMA32(ka, qf[s], pc); }
#pragma unroll 1
        for (int bt = bt_lo; bt <= bt_hi; ++bt) {
            const int kj0 = bt * 32;
            const int bn = bt < bt_hi ? bt + 1 : bt;
            f32x16 pn;
#pragma unroll
            for (int r = 0; r < 16; ++r) pn[r] = -mb2;
#pragma unroll
            for (int s = 0; s < 4; ++s) { const bf16x8 ka = *(const LAS bf16x8*)(Ks + (bn * 32 + l32) * AT_KP + (16 * s + 8 * hi) * 2); pn = MFMA32(ka, qf[s], pn); }
            f32x16 p = pc;
            if (bt == qt || bt == 8 + qt) {
#pragma unroll
                for (int r = 0; r < 16; ++r) { const int jr = crow(r, hi);
                    const bool valid = bt < 4 ? (jr >= l32) : (jr <= l32);
                    const float e = valid ? __builtin_amdgcn_exp2f(p[r]) : 0.f; p[r] = e; rsum += e; }
            } else {
#pragma unroll
                for (int r = 0; r < 16; ++r) { const float e = __builtin_amdgcn_exp2f(p[r]); p[r] = e; rsum += e; }
            }
#pragma unroll
            for (int s2 = 0; s2 < 2; ++s2) {
                u32x4 bw; bw.x = cvt_pk_bf16(p[8 * s2 + 0], p[8 * s2 + 1]); bw.y = cvt_pk_bf16(p[8 * s2 + 2], p[8 * s2 + 3]); bw.z = cvt_pk_bf16(p[8 * s2 + 4], p[8 * s2 + 5]); bw.w = cvt_pk_bf16(p[8 * s2 + 6], p[8 * s2 + 7]);
                const bf16x8 b2 = __builtin_bit_cast(bf16x8, bw);
                { const LAS unsigned char* vp = Vt + (l32) * AT_VP + (kj0 + 16 * s2 + 4 * hi) * 2; const u32x2 lo = *(const LAS u32x2*)vp, h2 = *(const LAS u32x2*)(vp + 16);
                  u32x4 aw; aw.x = lo.x; aw.y = lo.y; aw.z = h2.x; aw.w = h2.y; o0 = MFMA32(__builtin_bit_cast(bf16x8, aw), b2, o0); }
                { const LAS unsigned char* vp = Vt + (32 + l32) * AT_VP + (kj0 + 16 * s2 + 4 * hi) * 2; const u32x2 lo = *(const LAS u32x2*)vp, h2 = *(const LAS u32x2*)(vp + 16);
                  u32x4 aw; aw.x = lo.x; aw.y = lo.y; aw.z = h2.x; aw.w = h2.y; o1 = MFMA32(__builtin_bit_cast(bf16x8, aw), b2, o1); }
            }
            pc = pn;
        }
        rsum += shfl_x(rsum, lane, 32);
        const float inv = __builtin_amdgcn_rcpf(rsum + sinkv);
#pragma unroll
        for (int dt = 0; dt < 2; ++dt)
#pragma unroll
            for (int rg = 0; rg < 4; ++rg) {
                const int dim = dt * 32 + 8 * rg + 4 * hi; const size_t off = qrow * 1024 + hq * 64 + dim;
                const u32x2 zw = half ? zwp[1][dt * 4 + rg] : zwp[0][dt * 4 + rg];
                const float v0 = (dt ? o1[4 * rg + 0] : o0[4 * rg + 0]) * inv * bflo(zw.x), v1 = (dt ? o1[4 * rg + 1] : o0[4 * rg + 1]) * inv * bfhi(zw.x);
                const float v2 = (dt ? o1[4 * rg + 2] : o0[4 * rg + 2]) * inv * bflo(zw.y), v3 = (dt ? o1[4 * rg + 3] : o0[4 * rg + 3]) * inv * bfhi(zw.y);
                u32x2 ow; ow.x = cvt_pk_bf16(v0, v1); ow.y = cvt_pk_bf16(v2, v3);
                *(u32x2*)(dstbuf + off) = ow;
            }
    }
    __syncthreads();
}


__device__ __forceinline__ void knorm_rows(const Ctx& c, const float* kg) {
    const int tid = tid_opaque(); const int lane = tid & 63, wave = __builtin_amdgcn_readfirstlane(tid >> 6);
    const int gw = blockIdx.x * 8 + wave, NGW = gridDim.x * 8;
    const int d0 = (lane & 3) * 16;
    const float* rope = (const float*)(c.ws + WS_ROPE);
#pragma unroll 2
    for (int m4 = gw; m4 < GM / 4; m4 += NGW) {
        const int m = m4 * 4 + (lane >> 4);
        const int pos = m & (c.S - 1);
        bf16_t* p = CB(c, WS_K) + (size_t)m * 256 + (lane & 15) * 16;
        const float* g = kg + d0;
        const u32x4 w0 = *(const u32x4*)p, w1 = *(const u32x4*)(p + 8);
        const unsigned ww[8] = {w0.x, w0.y, w0.z, w0.w, w1.x, w1.y, w1.z, w1.w};
        float v[16]; float ss = 0.f;
#pragma unroll
        for (int i = 0; i < 16; ++i) { v[i] = (i & 1) ? bfhi(ww[i >> 1]) : bflo(ww[i >> 1]); ss += v[i] * v[i]; }
        ss += shfl_x(ss, lane, 1); ss += shfl_x(ss, lane, 2);
        const float rs = __builtin_amdgcn_rsqf(ss * (1.f / 64.f) + NORM_EPS);
#pragma unroll
        for (int i = 0; i < 16; ++i) v[i] = v[i] * rs * g[i];
        if ((lane & 3) == 0) {
#pragma unroll
            for (int j = 0; j < 8; ++j) { const float cs = rope[pos * 16 + 2 * j], sn = rope[pos * 16 + 2 * j + 1]; const float x1 = v[j], x2 = v[j + 8]; v[j] = x1 * cs - x2 * sn; v[j + 8] = x2 * cs + x1 * sn; }
        }
        u32x4 o0, o1; o0.x = cvt_pk_bf16(v[0], v[1]); o0.y = cvt_pk_bf16(v[2], v[3]); o0.z = cvt_pk_bf16(v[4], v[5]); o0.w = cvt_pk_bf16(v[6], v[7]);
        o1.x = cvt_pk_bf16(v[8], v[9]); o1.y = cvt_pk_bf16(v[10], v[11]); o1.z = cvt_pk_bf16(v[12], v[13]); o1.w = cvt_pk_bf16(v[14], v[15]);
        *(u32x4*)p = o0; *(u32x4*)(p + 8) = o1;
    }
}

constexpr int PR_P = 260;
__device__ __forceinline__ void prep_unit(LAS unsigned char* lds, int unit, const Ctx& c, const float* cw) {
    const int tid = tid_opaque();
    const int S = c.S, nc = S >> 7;
    const int ch = unit & (nc - 1), h = (unit >> c.lgn) & 7, seq = unit >> (c.lgn + 3);
    const size_t rowbase = (size_t)seq * S; const int t0 = ch * 128;
    LAS unsigned char* Tk = lds; LAS unsigned char* Tv = lds + 128 * PR_P;
    const size_t hb = (size_t)(seq * 8 + h) * S * 128;
#pragma unroll 2
    for (int it = 0; it < 4; ++it) {
        const int idx = tid + it * 512; const int l = idx >> 4, dg = idx & 15; const int t = t0 + l; const int col = h * 128 + dg * 8;
#pragma unroll
        for (int qk = 0; qk < 2; ++qk) {
            const bf16_t* src = qk ? CB(c, WS_MK) : CB(c, WS_MQ);
            const u32x4 z = {0u, 0u, 0u, 0u};
            const u32x4 xm = t > 0 ? *(const u32x4*)(src + (rowbase + t - 1) * 1024 + col) : z;
            const u32x4 x0 = *(const u32x4*)(src + (rowbase + t) * 1024 + col);
            const u32x4 xp = t < S - 1 ? *(const u32x4*)(src + (rowbase + t + 1) * 1024 + col) : z;
            const float* w0 = cw + qk * 1024 + col; const float* w1 = w0 + 2048; const float* w2 = w1 + 2048;
            const unsigned am[4] = {xm.x, xm.y, xm.z, xm.w}, a0[4] = {x0.x, x0.y, x0.z, x0.w}, ap[4] = {xp.x, xp.y, xp.z, xp.w};
            float y[8];
#pragma unroll
            for (int i = 0; i < 8; ++i) {
                const float vm = (i & 1) ? bfhi(am[i >> 1]) : bflo(am[i >> 1]), v0 = (i & 1) ? bfhi(a0[i >> 1]) : bflo(a0[i >> 1]), vp = (i & 1) ? bfhi(ap[i >> 1]) : bflo(ap[i >> 1]);
                float s = vm * w0[i] + v0 * w1[i] + vp * w2[i];
                s = s * __builtin_amdgcn_rcpf(1.f + fexp(-s));
                y[i] = qk ? s * KSCALE : s;
            }
            u32x4 o; o.x = cvt_pk_bf16(y[0], y[1]); o.y = cvt_pk_bf16(y[2], y[3]); o.z = cvt_pk_bf16(y[4], y[5]); o.w = cvt_pk_bf16(y[6], y[7]);
            *(u32x4*)((qk ? CB(c, WS_KC) : CB(c, WS_QC)) + hb + (size_t)(t >> 5) * 4096 + dg * 256 + (t & 31) * 8) = o;
            if (qk) { LAS unsigned* tp = (LAS unsigned*)(Tk + l * PR_P + dg * 16); tp[0] = o.x; tp[1] = o.y; tp[2] = o.z; tp[3] = o.w; }
        }
        { const u32x4 v = *(const u32x4*)(CB(c, WS_MV) + (rowbase + t) * 1024 + col); LAS unsigned* tp = (LAS unsigned*)(Tv + l * PR_P + dg * 16); tp[0] = v.x; tp[1] = v.y; tp[2] = v.z; tp[3] = v.w; }
    }
    __syncthreads();
#pragma unroll 2
    for (int it = 0; it < 4; ++it) {
        const int idx = tid + it * 512; const int d = idx & 127, lg = idx >> 7;
#pragma unroll
        for (int kv = 0; kv < 2; ++kv) {
            const LAS unsigned char* T = kv ? Tv : Tk;
            unsigned short e[8];
#pragma unroll
            for (int i = 0; i < 8; ++i) e[i] = *(const LAS unsigned short*)(T + (lg * 8 + i) * PR_P + d * 2);
            u32x4 o; o.x = e[0] | ((unsigned)e[1] << 16); o.y = e[2] | ((unsigned)e[3] << 16); o.z = e[4] | ((unsigned)e[5] << 16); o.w = e[6] | ((unsigned)e[7] << 16);
            *(u32x4*)((kv ? CB(c, WS_VT) : CB(c, WS_KT)) + hb + (size_t)ch * 16384 + (d >> 5) * 4096 + lg * 256 + (d & 31) * 8) = o;
        }
    }
    __syncthreads();
}

__device__ __forceinline__ void scan_job(int job, const Ctx& c) {
    const int lane = tid_opaque() & 63;
    const int S = c.S, nc = S >> 7;
    const int ch = job & (nc - 1), dir = (job >> c.lgn) & 1, h = (job >> (c.lgn + 1)) & 7, seq = job >> (c.lgn + 4);
    const size_t rowbase = (size_t)seq * S; const int t0 = ch * 128;
    const int p0 = dir ? 127 - 2 * lane : 2 * lane, p1 = dir ? 126 - 2 * lane : 2 * lane + 1;
    const float* r0 = CF(c, WS_IF) + (rowbase + t0 + p0) * 32 + dir * 16 + h; const float* r1 = CF(c, WS_IF) + (rowbase + t0 + p1) * 32 + dir * 16 + h;
    const float li0 = r0[0], lf0 = r0[8], li1 = r1[0], lf1 = r1[8];
    float s = lf0 + lf1;
#pragma unroll
    for (int o = 1; o < 64; o <<= 1) { const float y = shfl_u(s, lane, o); if (lane >= o) s += y; }
    const float b1 = s, b0 = s - lf1;
    const float a0 = li0 - b0, a1 = li1 - b1;
    float mx = fmaxf(a0, a1);
#pragma unroll
    for (int o = 1; o < 64; o <<= 1) { const float y = shfl_u(mx, lane, o); if (lane >= o) mx = fmaxf(mx, y); }
    float ex = shfl_u(mx, lane, 1); if (lane == 0) ex = -3.0e38f;
    const float cm0 = fmaxf(ex, a0), cm1 = mx;
    const size_t sb = (size_t)((seq * 8 + h) * 2 + dir) * S + t0;
    const float cmL = __int_as_float(__builtin_amdgcn_ds_bpermute(63 << 2, __float_as_int(cm1)));
    bf16_t* ea = CB(c, WS_EA);
    ea[sb + p0] = (bf16_t)(cvt_pk_bf16(fexp(a0 - cmL), 0.f) & 0xffffu); ea[sb + p1] = (bf16_t)(cvt_pk_bf16(fexp(a1 - cmL), 0.f) & 0xffffu);
    CF(c, WS_SA)[sb + p0] = a0 * 1.4426950408889634f; CF(c, WS_SA)[sb + p1] = a1 * 1.4426950408889634f;     CF(c, WS_SCM)[sb + p0] = cm0; CF(c, WS_SCM)[sb + p1] = cm1; CF(c, WS_SB)[sb + p0] = b0; CF(c, WS_SB)[sb + p1] = b1;
}

__device__ __forceinline__ void st_stage(LAS unsigned char* buf, const bf16_t* KTc, const bf16_t* VTc, int w, int lane) {
#pragma unroll
    for (int p = 0; p < 6; ++p) {
        const int piece = w * 6 + p;
        const char* src = piece < 32 ? (const char*)KTc + piece * 1024 : (const char*)VTc + (piece - 32) * 1024;
        __builtin_amdgcn_global_load_lds((const unsigned*)(src + lane * 16), (LAS unsigned*)(buf + piece * 1024), 16, 0, 0);
    }
}
__device__ __forceinline__ void mlstm_state_unit(LAS unsigned char* lds, int unit, const Ctx& c) {
    const int tid = tid_opaque(), lane = tid & 63, w = __builtin_amdgcn_readfirstlane(tid >> 6), l32 = lane & 31, hi = lane >> 5;
    const int S = c.S, nc = S >> 7;
    const int es = unit & 1, dir = (unit >> 1) & 1, h = (unit >> 2) & 7, seq = unit >> 5;
    const size_t hb = (size_t)(seq * 8 + h) * S * 128;
    const int chain = (seq * 8 + h) * 2 + dir;
    const size_t sbase = (size_t)chain * S;
    const int et = w >> 2, dt = w & 3;
    const bf16_t* KTg = CB(c, WS_KT) + hb; const bf16_t* VTg = CB(c, WS_VT) + hb + es * 8192;
    const bf16_t* EAl = CB(c, WS_EA) + sbase;
    const float* scm = CF(c, WS_SCM) + sbase; const float* sbv = CF(c, WS_SB) + sbase;
    bf16_t* CPl = CB(c, WS_CP) + (size_t)chain * nc * 16384 + (es * 2 + et) * 4096 + dt * 1024 + l32 * 8 + 4 * hi;
    bf16_t* NPl = CB(c, WS_NP) + (size_t)chain * nc * 128 + dt * 32 + 4 * hi;
    float* MPl = CF(c, WS_MP) + (size_t)chain * nc;
    const int plast = dir ? 0 : 127;
    const int kofs = dt * 8192 + hi * 512 + l32 * 16, vofs = 32768 + et * 8192 + hi * 512 + l32 * 16;
    f32x16 Cacc, nacc;
#pragma unroll
    for (int r = 0; r < 16; ++r) { Cacc[r] = 0.f; nacc[r] = 0.f; }
    float m_prev = -1e30f;
    u32x4 ea[8]; float cmLn, bLn;
    { const int ch0 = dir ? nc - 1 : 0;
      st_stage(lds, KTg + (size_t)ch0 * 16384, VTg + (size_t)ch0 * 16384, w, lane);
#pragma unroll
      for (int s = 0; s < 8; ++s) ea[s] = *(const u32x4*)(EAl + ch0 * 128 + 16 * s + 8 * hi);
      cmLn = scm[ch0 * 128 + plast]; bLn = sbv[ch0 * 128 + plast]; }
#pragma unroll 1
    for (int step = 0; step < nc; ++step) {
        const int ch = dir ? nc - 1 - step : step;
        const int sn = step + 1 < nc ? step + 1 : step; const int chn = dir ? nc - 1 - sn : sn;
        asm volatile("s_waitcnt vmcnt(0)" ::: "memory"); __syncthreads();
        const LAS unsigned char* buf = lds + (step & 1) * 49152;
        if (step + 1 < nc) st_stage(lds + ((step + 1) & 1) * 49152, KTg + (size_t)chn * 16384, VTg + (size_t)chn * 16384, w, lane);
        const bf16_t* EAn = EAl + chn * 128 + 8 * hi;
#pragma unroll
        for (int rg = 0; rg < 4; ++rg) { u32x2 o; o.x = cvt_pk_bf16(Cacc[4 * rg + 0], Cacc[4 * rg + 1]); o.y = cvt_pk_bf16(Cacc[4 * rg + 2], Cacc[4 * rg + 3]); *(u32x2*)(CPl + (size_t)ch * 16384 + 256 * rg) = o; }
        if (es == 0 && et == 0 && l32 == 0) {
#pragma unroll
            for (int rg = 0; rg < 4; ++rg) { u32x2 o; o.x = cvt_pk_bf16(nacc[4 * rg + 0], nacc[4 * rg + 1]); o.y = cvt_pk_bf16(nacc[4 * rg + 2], nacc[4 * rg + 3]); *(u32x2*)(NPl + (size_t)ch * 128 + 8 * rg) = o; }
            if (dt == 0 && hi == 0) MPl[ch] = m_prev;
        }
        const float cmL = cmLn, bL = bLn;
        cmLn = scm[chn * 128 + plast]; bLn = sbv[chn * 128 + plast];
        const float M_last = fmaxf(m_prev, cmL);
        const float w_c = fexp(m_prev - M_last), w_d = fexp(cmL - M_last);
        f32x16 dC, dn;
#pragma unroll
        for (int r = 0; r < 16; ++r) { dC[r] = 0.f; dn[r] = 0.f; }
#pragma unroll
        for (int s = 0; s < 8; ++s) {
            const bf16x8 kt = *(const LAS bf16x8*)(buf + kofs + s * 1024);
            const u32x4 vw = *(const LAS u32x4*)(buf + vofs + s * 1024), ew = ea[s];
            u32x4 bw; bw.x = cvt_pk_bf16(bflo(vw.x) * bflo(ew.x), bfhi(vw.x) * bfhi(ew.x)); bw.y = cvt_pk_bf16(bflo(vw.y) * bflo(ew.y), bfhi(vw.y) * bfhi(ew.y));
            bw.z = cvt_pk_bf16(bflo(vw.z) * bflo(ew.z), bfhi(vw.z) * bfhi(ew.z)); bw.w = cvt_pk_bf16(bflo(vw.w) * bflo(ew.w), bfhi(vw.w) * bfhi(ew.w));
            dC = MFMA32(kt, __builtin_bit_cast(bf16x8, bw), dC);
            if (et == 0) dn = MFMA32(kt, __builtin_bit_cast(bf16x8, ew), dn);
            ea[s] = *(const u32x4*)(EAn + 16 * s);
        }
#pragma unroll
        for (int r = 0; r < 16; ++r) { Cacc[r] = w_c * Cacc[r] + w_d * dC[r]; nacc[r] = w_c * nacc[r] + w_d * dn[r]; }
        m_prev = bL + M_last;
    }
    asm volatile("s_waitcnt vmcnt(0)" ::: "memory"); __syncthreads();
}

__device__ __forceinline__ void out_stage(LAS unsigned char* buf, int unit, const Ctx& c, int w, int lane) {
    const int S = c.S, nc = S >> 7;
    const int ch = unit & (nc - 1), h = (unit >> c.lgn) & 7, seq = unit >> (c.lgn + 3);
    const size_t hb = (size_t)(seq * 8 + h) * S * 128 + (size_t)ch * 16384;
    const char* q = (const char*)(CB(c, WS_QC) + hb); const char* k = (const char*)(CB(c, WS_KC) + hb);
#pragma unroll
    for (int p = 0; p < 4; ++p) {
        const int piece = w * 4 + p;
        __builtin_amdgcn_global_load_lds((const unsigned*)(q + piece * 1024 + lane * 16), (LAS unsigned*)(buf + piece * 1024), 16, 0, 0);
        __builtin_amdgcn_global_load_lds((const unsigned*)(k + piece * 1024 + lane * 16), (LAS unsigned*)(buf + 32768 + piece * 1024), 16, 0, 0);
    }
}
__device__ __forceinline__ void mlstm_out_unit(const LAS unsigned char* buf, LAS float* xch, int unit, const Ctx& c, const float* mg) {
    const int tid = tid_opaque(), lane = tid & 63, w = __builtin_amdgcn_readfirstlane(tid >> 6), l32 = lane & 31, hi = lane >> 5;
    const int S = c.S, nc = S >> 7;
    const int ch = unit & (nc - 1), h = (unit >> c.lgn) & 7, seq = unit >> (c.lgn + 3);
    const size_t hb = (size_t)(seq * 8 + h) * S * 128;
    const int t0 = ch * 128;
    const int it = w & 3, ep = w >> 2;
    const int i = it * 32 + l32;
    const LAS unsigned char* Ql = buf + hi * 512 + l32 * 16; const LAS unsigned char* Kl = buf + 32768 + hi * 512 + l32 * 16;
    const bf16_t* VTl = CB(c, WS_VT) + hb + (size_t)ch * 16384 + (2 * ep) * 4096;
    const unsigned vlo = (unsigned)(l32 * 8 + 4 * hi), clo = (unsigned)(hi * 256 + l32 * 8), nlo = (unsigned)(8 * hi), alo = (unsigned)(4 * hi);
    bf16x8 qf[8];
#pragma unroll
    for (int s = 0; s < 8; ++s) qf[s] = *(const LAS bf16x8*)(Ql + it * 8192 + s * 1024);
    float hsum[2][16];
#pragma unroll
    for (int r = 0; r < 16; ++r) { hsum[0][r] = 0.f; hsum[1][r] = 0.f; }
#pragma unroll 1
    for (int dir = 0; dir < 2; ++dir) {
        const int chain = (seq * 8 + h) * 2 + dir;
        const size_t sbase = (size_t)chain * S + t0;
        const bf16_t* CPl = CB(c, WS_CP) + ((size_t)chain * nc + ch) * 16384 + (2 * ep) * 4096;
        const bf16_t* NPl = CB(c, WS_NP) + ((size_t)chain * nc + ch) * 128;
        const float* sa = CF(c, WS_SA) + sbase;
        const int jlo = dir ? it : 0, jhi = dir ? 3 : it;
        const float m_prev = CF(c, WS_MP)[(size_t)chain * nc + ch];
        const float cm_i = (CF(c, WS_SCM) + sbase)[(unsigned)i], b_i = (CF(c, WS_SB) + sbase)[(unsigned)i];
        const float M_i = fmaxf(m_prev, cm_i); const float w_i = fexp(m_prev - M_i); const float M_i2 = M_i * 1.4426950408889634f;
        f32x16 ainta, aintb, aqn, anuma, anumb;
#pragma unroll
        for (int r = 0; r < 16; ++r) { ainta[r] = 0.f; aintb[r] = 0.f; aqn[r] = 0.f; anuma[r] = 0.f; anumb[r] = 0.f; }
        float rsum = 0.f;
        f32x16 pc;
#pragma unroll
        for (int r = 0; r < 16; ++r) pc[r] = 0.f;
#pragma unroll
        for (int s = 0; s < 8; ++s) { const bf16x8 kf = *(const LAS bf16x8*)(Kl + jlo * 8192 + s * 1024); pc = MFMA32(kf, qf[s], pc); }
#pragma unroll 1
        for (int jt = jlo; jt <= jhi; ++jt) {
            u32x2 vlc[2][2], vhc[2][2]; f32x4 avc[4];
#pragma unroll
            for (int e2 = 0; e2 < 2; ++e2)
#pragma unroll
                for (int s2 = 0; s2 < 2; ++s2) { const unsigned vo = vlo + (unsigned)(e2 * 4096 + (4 * jt + 2 * s2) * 256); vlc[e2][s2] = *(const u32x2*)(VTl + vo); vhc[e2][s2] = *(const u32x2*)(VTl + (vo + 256u)); }
#pragma unroll
            for (int rg = 0; rg < 4; ++rg) avc[rg] = *(const f32x4*)(sa + (alo + (unsigned)(jt * 32 + 8 * rg)));
            const int jn = jt < jhi ? jt + 1 : jt;
            f32x16 pn;
#pragma unroll
            for (int r = 0; r < 16; ++r) pn[r] = 0.f;
#pragma unroll
            for (int s = 0; s < 8; ++s) { const bf16x8 kf = *(const LAS bf16x8*)(Kl + jn * 8192 + s * 1024); pn = MFMA32(kf, qf[s], pn); }
            f32x16 p = pc;
            if (jt == it) {
#pragma unroll
                for (int r = 0; r < 16; ++r) { const int jr = crow(r, hi);
                    const bool valid = dir ? (jr >= l32) : (jr <= l32);
                    const float dg = valid ? __builtin_amdgcn_exp2f(avc[r >> 2][r & 3] - M_i2) : 0.f; p[r] *= dg; rsum += p[r]; }
            } else {
#pragma unroll
                for (int r = 0; r < 16; ++r) { p[r] *= __builtin_amdgcn_exp2f(avc[r >> 2][r & 3] - M_i2); rsum += p[r]; }
            }
#pragma unroll
            for (int s2 = 0; s2 < 2; ++s2) {
                u32x4 bw; bw.x = cvt_pk_bf16(p[8 * s2 + 0], p[8 * s2 + 1]); bw.y = cvt_pk_bf16(p[8 * s2 + 2], p[8 * s2 + 3]); bw.z = cvt_pk_bf16(p[8 * s2 + 4], p[8 * s2 + 5]); bw.w = cvt_pk_bf16(p[8 * s2 + 6], p[8 * s2 + 7]);
                u32x4 aw; aw.x = vlc[0][s2].x; aw.y = vlc[0][s2].y; aw.z = vhc[0][s2].x; aw.w = vhc[0][s2].y;
                anuma = MFMA32(__builtin_bit_cast(bf16x8, aw), __builtin_bit_cast(bf16x8, bw), anuma);
                u32x4 cw; cw.x = vlc[1][s2].x; cw.y = vlc[1][s2].y; cw.z = vhc[1][s2].x; cw.w = vhc[1][s2].y;
                anumb = MFMA32(__builtin_bit_cast(bf16x8, cw), __builtin_bit_cast(bf16x8, bw), anumb);
            }
            pc = pn;
        }
        {
            bf16x8 cfa[8], nf[8];
#pragma unroll
            for (int s = 0; s < 8; ++s) { cfa[s] = *(const bf16x8*)(CPl + (clo + 512u * s)); nf[s] = *(const bf16x8*)(NPl + (nlo + 16u * s)); }
#pragma unroll
        for (int s = 0; s < 8; ++s) { ainta = MFMA32(cfa[s], qf[s], ainta); aqn = MFMA32(nf[s], qf[s], aqn); }
        }
        asm volatile("" ::: "memory");
        {
            bf16x8 cfb[8];
#pragma unroll
            for (int s = 0; s < 8; ++s) cfb[s] = *(const bf16x8*)(CPl + (clo + 4096u + 512u * s));
#pragma unroll
            for (int s = 0; s < 8; ++s) aintb = MFMA32(cfb[s], qf[s], aintb);
        }
        asm volatile("" ::: "memory");
        const float qn = aqn[0];
        rsum += shfl_x(rsum, lane, 32);
        const float den = w_i * qn + rsum;
        const float dd = fmaxf(fabsf(den), fexp(-(b_i + M_i)));
        const float inv = __builtin_amdgcn_rcpf(dd);
#pragma unroll
        for (int r = 0; r < 16; ++r) { hsum[0][r] += (w_i * ainta[r] + anuma[r]) * inv; hsum[1][r] += (w_i * aintb[r] + anumb[r]) * inv; }
    }
    int h2 = h; asm volatile("" : "+s"(h2));
    const size_t ob = ((size_t)seq * S + t0) * 1024 + h2 * 128 + (2 * ep) * 32; const unsigned oo = (unsigned)(i * 1024 + 4 * hi);
    bf16_t* MOb = CB(c, WS_MO) + ob; bf16_t* MZb = CB(c, WS_MZ) + ob; const float* mgb = mg + h2 * 128 + (2 * ep) * 32;
    u32x2 ow[2][4], zw[2][4];
#pragma unroll
    for (int e2 = 0; e2 < 2; ++e2)
#pragma unroll
        for (int rg = 0; rg < 4; ++rg) { ow[e2][rg] = *(const u32x2*)(MOb + (oo + (unsigned)(e2 * 32 + 8 * rg))); zw[e2][rg] = *(const u32x2*)(MZb + (oo + (unsigned)(e2 * 32 + 8 * rg))); }
    float ss = 0.f;
#pragma unroll
    for (int e2 = 0; e2 < 2; ++e2)
#pragma unroll
        for (int rg = 0; rg < 4; ++rg) { hsum[e2][4 * rg + 0] *= bflo(ow[e2][rg].x); hsum[e2][4 * rg + 1] *= bfhi(ow[e2][rg].x); hsum[e2][4 * rg + 2] *= bflo(ow[e2][rg].y); hsum[e2][4 * rg + 3] *= bfhi(ow[e2][rg].y);
            ss += (hsum[e2][4 * rg + 0] * hsum[e2][4 * rg + 0] + hsum[e2][4 * rg + 1] * hsum[e2][4 * rg + 1]) + (hsum[e2][4 * rg + 2] * hsum[e2][4 * rg + 2] + hsum[e2][4 * rg + 3] * hsum[e2][4 * rg + 3]); }
    ss += shfl_x(ss, lane, 32);
    if (hi == 0) xch[(it * 2 + ep) * 32 + l32] = ss;
    __syncthreads();
    const float tot = xch[(it * 2) * 32 + l32] + xch[(it * 2 + 1) * 32 + l32];
    const float rs = __builtin_amdgcn_rsqf(tot * (1.f / 128.f) + NORM_EPS);
#pragma unroll
    for (int e2 = 0; e2 < 2; ++e2)
#pragma unroll
        for (int rg = 0; rg < 4; ++rg) { const f32x4 gv = *(const f32x4*)(mgb + (alo + (unsigned)(e2 * 32 + 8 * rg)));
            u32x2 o; o.x = cvt_pk_bf16(hsum[e2][4 * rg + 0] * rs * gv[0] * bflo(zw[e2][rg].x), hsum[e2][4 * rg + 1] * rs * gv[1] * bfhi(zw[e2][rg].x));
            o.y = cvt_pk_bf16(hsum[e2][4 * rg + 2] * rs * gv[2] * bflo(zw[e2][rg].y), hsum[e2][4 * rg + 3] * rs * gv[3] * bfhi(zw[e2][rg].y));
            *(u32x2*)(MZb + (oo + (unsigned)(e2 * 32 + 8 * rg))) = o; }
}

__device__ __forceinline__ void post_phase(const Ctx& c, const float* mg) {
    const int tid = tid_opaque(); const int lane = tid & 63, wave = __builtin_amdgcn_readfirstlane(tid >> 6);
    const int gw = blockIdx.x * 8 + wave, NGW = gridDim.x * 8;
    f32x4 gv[4];
#pragma unroll
    for (int j = 0; j < 4; ++j) gv[j] = *(const f32x4*)(mg + lane * 16 + 4 * j);
    for (int m = gw; m < GM; m += NGW) {
        const size_t off = (size_t)m * 1024 + lane * 16;
        const u32x4 ow0 = *(const u32x4*)(CB(c, WS_MO) + off), ow1 = *(const u32x4*)(CB(c, WS_MO) + off + 8);
        const u32x4 zw0 = *(const u32x4*)(CB(c, WS_MZ) + off), zw1 = *(const u32x4*)(CB(c, WS_MZ) + off + 8);
        const unsigned ow[8] = {ow0.x, ow0.y, ow0.z, ow0.w, ow1.x, ow1.y, ow1.z, ow1.w}, zw[8] = {zw0.x, zw0.y, zw0.z, zw0.w, zw1.x, zw1.y, zw1.z, zw1.w};
        float v[16]; float ss = 0.f;
        const u32x4 fa0 = *(const u32x4*)(CB(c, WS_HF) + off), fa1 = *(const u32x4*)(CB(c, WS_HF) + off + 8);
        const unsigned fa[8] = {fa0.x, fa0.y, fa0.z, fa0.w, fa1.x, fa1.y, fa1.z, fa1.w};
#pragma unroll
        for (int e = 0; e < 16; ++e) { const float og = (e & 1) ? bfhi(ow[e >> 1]) : bflo(ow[e >> 1]); const float hs = (e & 1) ? bfhi(fa[e >> 1]) : bflo(fa[e >> 1]); v[e] = og * hs; ss += v[e] * v[e]; }
        ss += shfl_x(ss, lane, 1); ss += shfl_x(ss, lane, 2); ss += shfl_x(ss, lane, 4);
        const float rs = __builtin_amdgcn_rsqf(ss * (1.f / 128.f) + NORM_EPS);
        unsigned o[8];
#pragma unroll
        for (int e = 0; e < 16; e += 2) { const float y0 = v[e] * rs * gv[e >> 2][e & 3] * bflo(zw[e >> 1]), y1 = v[e + 1] * rs * gv[e >> 2][(e + 1) & 3] * bfhi(zw[e >> 1]); o[e >> 1] = cvt_pk_bf16(y0, y1); }
        u32x4 s0, s1; s0.x = o[0]; s0.y = o[1]; s0.z = o[2]; s0.w = o[3]; s1.x = o[4]; s1.y = o[5]; s1.z = o[6]; s1.w = o[7];
        *(u32x4*)(CB(c, WS_MZ) + off) = s0; *(u32x4*)(CB(c, WS_MZ) + off + 8) = s1;
    }
}


typedef const Args __attribute__((address_space(4)))* KArgsP;
__device__ __forceinline__ KArgsP kargs() { unsigned long long p = (unsigned long long)__builtin_amdgcn_kernarg_segment_ptr(); asm volatile("" : "+s"(p)); return (KArgsP)p; }
#define XB_TMO      128
#define XB_XCNT(j)  (256  + 64 * (j))
#define XB_XSUB(j)  (1280 + 64 * (j))
#define XB_XGEN(j)  (2304 + 64 * (j))
#define XB_TOP      3328
#define XB_TOPGEN   3392
#define XCD_BAR_WORDS 3456
#define XB_SPIN_CAP (1u << 20)
__device__ __forceinline__ unsigned xb_ld(unsigned* p)              { return __hip_atomic_load(p, __ATOMIC_RELAXED, __HIP_MEMORY_SCOPE_AGENT); }
__device__ __forceinline__ unsigned xb_add(unsigned* p, unsigned v) { return __hip_atomic_fetch_add(p, v, __ATOMIC_RELAXED, __HIP_MEMORY_SCOPE_AGENT); }
__device__ __forceinline__ unsigned xb_xcc_id() { return (unsigned)__builtin_amdgcn_s_getreg((3 << 11) | 20) & 0xFu; }
#define XB_SPIN(cond, bar) do { unsigned _sp = 0; while (cond) { __builtin_amdgcn_s_sleep(1); \
    if ((++_sp & 255u) == 0u) { if (xb_ld(&(bar)[XB_TMO])) break; if (_sp > XB_SPIN_CAP) { atomicAdd(&(bar)[XB_TMO], 1u); break; } } } } while (0)
struct XcdBarrier { unsigned* bar; unsigned x; volatile LAS unsigned* st; };
__device__ __forceinline__ XcdBarrier xcd_barrier_post(unsigned* bar, volatile LAS unsigned* st) {
    XcdBarrier b; b.bar = bar; b.x = xb_xcc_id(); b.st = st;
    if (threadIdx.x == 0) (void)xb_add(&bar[XB_XCNT(b.x)], 1u);
    return b;
}
__device__ __forceinline__ void xcd_barrier_complete(unsigned* bar, unsigned x, unsigned& nloc, unsigned& nx) {
    const unsigned G = gridDim.x * gridDim.y * gridDim.z;
    unsigned sum, cnt, mine, sp = 0u;
    for (;;) {
        sum = 0u; cnt = 0u; mine = 0u;
#pragma unroll
        for (unsigned j = 0; j < 16; ++j) { const unsigned c = xb_ld(&bar[XB_XCNT(j)]); sum += c; cnt += (c > 0u) ? 1u : 0u; mine = (j == x) ? c : mine; }
        if (sum == G) break;
        __builtin_amdgcn_s_sleep(1);
        if ((++sp & 255u) == 0u) { if (xb_ld(&bar[XB_TMO])) break; if (sp > XB_SPIN_CAP) { atomicAdd(&bar[XB_TMO], 1u); break; } }
    }
    nloc = mine > 0u ? mine : 1u; nx = cnt > 0u ? cnt : 1u;
}
__device__ __forceinline__ void xcd_barrier(LAS unsigned char* lds) {
    XcdBarrier b; b.bar = (unsigned*)(kargs()->ws + WS_BAR); b.x = xb_xcc_id(); b.st = (volatile LAS unsigned*)(lds + 131072 + 256);
    asm volatile("s_waitcnt vmcnt(0)" ::: "memory");
    __syncthreads();
    if (tid_opaque() == 0) {
        unsigned* bar = b.bar;
        __builtin_amdgcn_s_waitcnt(0);
        unsigned nloc = b.st[0], nx = b.st[1];
        if (nloc == 0u) { xcd_barrier_complete(bar, b.x, nloc, nx); b.st[0] = nloc; b.st[1] = nx; }
        const unsigned old = xb_add(&bar[XB_XSUB(b.x)], 1u);
        const unsigned gen = old / nloc;
        if (old + 1u == (gen + 1u) * nloc) {
            __builtin_amdgcn_fence(__ATOMIC_RELEASE, "agent");
            asm volatile("s_waitcnt vmcnt(0)" ::: "memory");
            const unsigned og = xb_add(&bar[XB_TOP], 1u);
            const unsigned tg = og / nx;
            if (og + 1u == (tg + 1u) * nx) xb_add(&bar[XB_TOPGEN], 1u);
            else XB_SPIN(xb_ld(&bar[XB_TOPGEN]) == tg, bar);
            __builtin_amdgcn_fence(__ATOMIC_ACQUIRE, "agent");
            xb_add(&bar[XB_XGEN(b.x)], 1u);
            asm volatile("s_waitcnt vmcnt(0)" ::: "memory");
        } else {
            XB_SPIN(xb_ld(&bar[XB_XGEN(b.x)]) == gen, bar);
            __builtin_amdgcn_fence(__ATOMIC_ACQUIRE, "agent");
            asm volatile("s_waitcnt vmcnt(0)" ::: "memory");
        }
    }
    __syncthreads();
}

__device__ __forceinline__ Ctx make_ctx(int gi, int l) {
    KArgsP ka = kargs();
    Ctx c; c.S = gi == 0 ? 4096 : 2048; c.nseq = gi == 0 ? 4 : 8; c.lgn = gi == 0 ? 5 : 4; c.ws = ka->ws;
    float* outg = ka->out + (size_t)(unsigned)gi * (size_t)(GM * DM);
    const float* x0 = gi == 0 ? ka->x_prompt : (gi == 1 ? ka->x_sample : ka->x_sample + (size_t)GM * DM);
    c.xout = outg; c.xin = l == 0 ? x0 : outg;
    return c;
}

__global__ void __launch_bounds__(512, 2) fwd_megakernel(Args a_unused) {
    extern __shared__ __attribute__((aligned(16))) unsigned char lds_raw[];
    LAS unsigned char* lds = (LAS unsigned char*)lds_raw;
    cg::grid_group grid = cg::this_grid();

    prologue(kargs(), lds);
    { const Ctx c0 = make_ctx(0, 0); norm_phase(c0); }
    {
        unsigned* bw = (unsigned*)(kargs()->ws + WS_BAR);
        if (blockIdx.x == 0) for (int i = threadIdx.x; i < XCD_BAR_WORDS; i += 512) bw[i] = 0u;
        if (threadIdx.x < 2) ((volatile LAS unsigned*)(lds + 131072 + 256))[threadIdx.x] = 0u;
    }
    grid.sync();
    (void)xcd_barrier_post((unsigned*)(kargs()->ws + WS_BAR), (volatile LAS unsigned*)(lds + 131072 + 256));

#pragma unroll 1
#ifdef TEST_NOLOOP
    for (int gi = 0; gi < 1; ++gi) {
#else
    for (int gi = 0; gi < 3; ++gi) {
#endif
#pragma unroll 1
#ifdef TEST_NOLOOP
        for (int l = 0; l < 1; ++l) {
#else
        for (int l = 0; l < DEPTH; ++l) {
#endif
            {
                const Ctx c = make_ctx(gi, l); KArgsP ka = kargs(); unsigned char* ws = c.ws;
                pg8::Gemm g{CB(c, WS_XN), (const bf16_t*)(ws + WS_WIN + l * WIN_BYTES), GM, NPHYS, DM}; pg8::StaticOrder So; So.init(GM, NPHYS, gridDim.x, blockIdx.x);
                EpiProj E{ws, (const float*)(ws + WS_BIAS) + l * NPHYS};
#ifndef NO_P2
                pg8::gemm_phase<EpiProj, pg8::StaticOrder, true, true>(lds, g, So, E);
#endif
            }
            xcd_barrier(lds);
            {
                const Ctx c = make_ctx(gi, l); KArgsP ka = kargs();
                const int G = gridDim.x, bid = blockIdx.x, wave = __builtin_amdgcn_readfirstlane(tid_opaque() >> 6);
                knorm_rows(c, ka->k_norm_g + l * 64);
#ifndef NO_P3B
                for (int u = bid; u < 1024; u += G) prep_unit(lds, u, c, ka->conv_w + (size_t)l * 3 * 2048);
#endif
                for (int j = bid * 8 + wave; j < 2048; j += G * 8) scan_job(j, c);
            }
            xcd_barrier(lds);
            {
                const Ctx c = make_ctx(gi, l); KArgsP ka = kargs();
                const int nu = c.nseq * 32;
                const float mb = ((const float*)(c.ws + WS_MB))[l];
#ifndef NO_P3A
                if (nu == 128 && gridDim.x == 256) {
                    const int b = blockIdx.x;
                    if (b < 128) attn_unit(lds, b, c, ka->sink + l * 16, mb, CB(c, WS_Q), ka->q_norm_g + l * 64);
                    else for (int k = 0; k < 3; ++k) attn_unit(lds, 128 + (b - 128) * 3 + k, c, ka->sink + l * 16, mb, CB(c, WS_Q), ka->q_norm_g + l * 64);
                } else {
                    for (int u = blockIdx.x; u < 512; u += gridDim.x) attn_unit(lds, u, c, ka->sink + l * 16, mb, CB(c, WS_Q), ka->q_norm_g + l * 64);
                }
#endif
#ifndef NO_P4
                for (int u = blockIdx.x; u < nu; u += gridDim.x) mlstm_state_unit(lds, u, c);
#endif
            }
            xcd_barrier(lds);
            {
                const Ctx c = make_ctx(gi, l);
#ifndef NO_P4
                const int tid = tid_opaque(), w = __builtin_amdgcn_readfirstlane(tid >> 6), lane = tid & 63;
                const float* mgp = kargs()->m_norm_g + l * DM;
                int u = blockIdx.x, k = 0;
                if (u < 1024) out_stage(lds, u, c, w, lane);
                for (; u < 1024; u += gridDim.x, ++k) {
                    asm volatile("s_waitcnt vmcnt(0)" ::: "memory"); __syncthreads();
                    const int un = u + gridDim.x;
                    if (un < 1024) out_stage(lds + ((k + 1) & 1) * 65536, un, c, w, lane);
                    mlstm_out_unit(lds + (k & 1) * 65536, (LAS float*)(lds + 131072 + 1024), u, c, mgp);
                }
                asm volatile("s_waitcnt vmcnt(0)" ::: "memory"); __syncthreads();
#endif
            }
            xcd_barrier(lds);
            {
                const Ctx c = make_ctx(gi, l); unsigned char* ws = c.ws;
                pg8::StaticOrder So; So.init(GM, DM, gridDim.x, blockIdx.x);
                { pg8::Gemm g{CB(c, WS_Q), (const bf16_t*)(ws + WS_WA + (size_t)l * DM * DM * 2), GM, DM, DM}; EpiGate<0> E{CB(c, WS_GT), CB(c, WS_T), CB(c, WS_MG)};
#ifndef NO_P6
                  pg8::gemm_phase<EpiGate<0>, pg8::StaticOrder, true, true>(lds, g, So, E);
#endif
                }
            }
            {
                const Ctx c = make_ctx(gi, l); unsigned char* ws = c.ws;
                pg8::StaticOrder So; So.init(GM, DM, gridDim.x, blockIdx.x);
                { pg8::Gemm g{CB(c, WS_MZ), (const bf16_t*)(ws + WS_WM + (size_t)l * DM * DM * 2), GM, DM, DM}; EpiGate<1> E{CB(c, WS_GT), CB(c, WS_T), CB(c, WS_MG)};
#ifndef NO_P6
                  pg8::gemm_phase<EpiGate<1>, pg8::StaticOrder, true, true>(lds, g, So, E);
#endif
                }
            }
            xcd_barrier(lds);
            {
                const Ctx c = make_ctx(gi, l); unsigned char* ws = c.ws;
                pg8::StaticOrder So; So.init(GM, DM, gridDim.x, blockIdx.x);
                pg8::Gemm g{CB(c, WS_MG), (const bf16_t*)(ws + WS_WO + (size_t)l * DM * DM * 2), GM, DM, DM}; EpiRes E{c.xin, c.xout, CB(c, WS_XN), CF(c, WS_RS), (LAS float*)(lds + 131072 + 4096), l < DEPTH - 1 ? 1 : 0};
#ifndef NO_P7
                pg8::gemm_phase<EpiRes, pg8::StaticOrder, true, true>(lds, g, So, E);
#endif
            }
            if (l == DEPTH - 1 && gi < 2) { const Ctx cn = make_ctx(gi + 1, 0); norm_phase(cn); }
            xcd_barrier(lds);
        }
    }
}

extern "C" void kernel_launch(void* const* d_in, const int* in_sizes, int n_in, void* d_out, int out_size, void* d_ws, size_t ws_size, hipStream_t stream) {
    static int grid = 0;
    if (grid == 0) {
        if (n_in != 13 || ws_size < WS_END) { fprintf(stderr, "kernel_launch: need 13 inputs and >= %zu bytes of workspace (got %d, %zu)\n", (size_t)WS_END, n_in, ws_size); grid = -1; return; }
        int dev = 0, cus = 0, per_cu = 0;
        hipGetDevice(&dev);
        hipDeviceGetAttribute(&cus, hipDeviceAttributeMultiprocessorCount, dev);
        if (hipFuncSetAttribute((const void*)fwd_megakernel, hipFuncAttributeMaxDynamicSharedMemorySize, LDS_BYTES) != hipSuccess) { fprintf(stderr, "kernel_launch: hipFuncSetAttribute failed\n"); grid = -1; return; }
        if (hipOccupancyMaxActiveBlocksPerMultiprocessor(&per_cu, (const void*)fwd_megakernel, 512, LDS_BYTES) != hipSuccess || per_cu < 1) { fprintf(stderr, "kernel_launch: occupancy query failed (%d)\n", per_cu); per_cu = 1; }
        (void)hipGetLastError();
        grid = cus;
    }
    if (grid < 0) return;
    Args a{};
    a.x_prompt = (const float*)d_in[0]; a.x_sample = (const float*)d_in[1]; a.norm_g = (const float*)d_in[2]; a.w_in = (const float*)d_in[3]; a.b_in = (const float*)d_in[4];
    a.q_norm_g = (const float*)d_in[5]; a.k_norm_g = (const float*)d_in[6]; a.sink = (const float*)d_in[7]; a.conv_w = (const float*)d_in[8]; a.m_norm_g = (const float*)d_in[9];
    a.w_att_out = (const float*)d_in[10]; a.w_m_out = (const float*)d_in[11]; a.w_out = (const float*)d_in[12];
    a.out = (float*)d_out; a.ws = (unsigned char*)d_ws;
    void* args[] = {&a};
    hipError_t e = hipLaunchCooperativeKernel((const void*)fwd_megakernel, dim3(grid), dim3(512), args, LDS_BYTES, stream);
    if (e != hipSuccess) fprintf(stderr, "kernel_launch: cooperative launch failed: %s (grid %d)\n", hipGetErrorString(e), grid);
}
```
